# Optimizing an MI355X kernel written in HIP

```python
import jax, jax.numpy as jnp
from jax import lax
import numpy as np

D_MODEL = 1024
BATCH = 16
SEQ = 4096
DEPTH = 2
DEC_BATCH = 16
DEC_SEQ = 64
PAST_LEN = 1024

CHUNK = 64
N_A_LAYERS = DEPTH // 2
N_B_LAYERS = DEPTH - N_A_LAYERS
POOL_WINDOWS = (2, 4, 8, 16)
N_POOL_GROUPS = len(POOL_WINDOWS)
POOL_GROUP_WIDTH = D_MODEL // N_POOL_GROUPS
POOL_HIST = max(POOL_WINDOWS) - 1
HEAD_DIM = 64
N_HEADS = D_MODEL // HEAD_DIM
ATTN_WIDTH = N_HEADS * HEAD_DIM
D_FF = -(-8 * D_MODEL // (3 * 256)) * 256
Q_BLOCK = 128
RMS_EPS = 1e-6
NEG_INF = -1e30
FORGET_BIAS_INIT = 2.0

kernel_name = "yoco_pool_fox_streaming_step"


def rms_norm(x, g):
    xf = x.astype(jnp.float32)
    y = xf * lax.rsqrt(jnp.mean(xf * xf, axis=-1, keepdims=True) + RMS_EPS)
    return (y * g.astype(jnp.float32)).astype(x.dtype)


def swiglu_ffn(h, w_gate, w_up, w_down):
    return (jax.nn.silu(h @ w_gate) * (h @ w_up)) @ w_down


def pool_mixer(h, prev, pos0, w_groups, scale):
    S = h.shape[1]
    ext = jnp.concatenate([prev.astype(h.dtype), h], axis=1)
    cs = jnp.cumsum(ext.astype(jnp.float32), axis=1)
    cs = jnp.pad(cs, ((0, 0), (1, 0), (0, 0)))
    end = cs[:, POOL_HIST + 1:POOL_HIST + 1 + S]
    pos = pos0 + jnp.arange(S, dtype=jnp.int32)
    hf = h.astype(jnp.float32)
    outs = []
    for g, w in enumerate(POOL_WINDOWS):
        sl = slice(g * POOL_GROUP_WIDTH, (g + 1) * POOL_GROUP_WIDTH)
        start = cs[:, POOL_HIST + 1 - w:POOL_HIST + 1 - w + S, sl]
        cnt = jnp.minimum(pos + 1, w).astype(jnp.float32)[None, :, None]
        pooled = (end[..., sl] - start) / cnt - hf[..., sl]
        outs.append(jnp.einsum('bsc,cd->bsd', pooled, w_groups[g].astype(jnp.float32)))
    out = jnp.concatenate(outs, axis=-1) * scale.astype(jnp.float32)
    return out.astype(h.dtype), ext[:, -POOL_HIST:]


def shared_kv(x, g_kv, w_k, w_v, w_f, b_f, g_knorm):
    B, S, _ = x.shape
    h = rms_norm(x, g_kv)
    k = rms_norm((h @ w_k).reshape(B, S, N_HEADS, HEAD_DIM), g_knorm)
    v = (h @ w_v).reshape(B, S, N_HEADS, HEAD_DIM)
    logf = jax.nn.log_sigmoid((h @ w_f + b_f).astype(jnp.float32))
    return k, v, logf


def fox_attend(q, dq, k, dk, v, q_pos, k_pos):
    s = jnp.einsum('bqhd,bkhd->bhqk', q.astype(jnp.float32), k.astype(jnp.float32)) * (HEAD_DIM ** -0.5)
    s = s + (jnp.transpose(dq, (0, 2, 1))[..., :, None] - jnp.transpose(dk, (0, 2, 1))[..., None, :])
    mask = k_pos[None, :] <= q_pos[:, None]
    p = jax.nn.softmax(jnp.where(mask, s, NEG_INF), axis=-1)
    return jnp.einsum('bhqk,bkhd->bqhd', p, v.astype(jnp.float32))


def fox_prompt(q, k, v, logf):
    B, S, H, Dh = q.shape
    d = jnp.cumsum(logf.astype(jnp.float32), axis=1)
    nblk = S // Q_BLOCK
    qb = q.reshape(B, nblk, Q_BLOCK, H, Dh).transpose(1, 0, 2, 3, 4)
    dqb = d.reshape(B, nblk, Q_BLOCK, H).transpose(1, 0, 2, 3)
    starts = jnp.arange(nblk, dtype=jnp.int32) * Q_BLOCK
    k_pos = jnp.arange(S, dtype=jnp.int32)

    def one_block(args):
        qi, dqi, st = args
        return fox_attend(qi, dqi, k, d, v, st + jnp.arange(Q_BLOCK, dtype=jnp.int32), k_pos)

    o = lax.map(one_block, (qb, dqb, starts))
    return o.transpose(1, 0, 2, 3, 4).reshape(B, S, H * Dh)


def fox_sample(q, k_all, v_all, logf_all, past):
    B, T, H, Dh = q.shape
    d = jnp.cumsum(logf_all.astype(jnp.float32), axis=1)
    k_pos = jnp.arange(past + T, dtype=jnp.int32)
    q_pos = past + jnp.arange(T, dtype=jnp.int32)
    o = fox_attend(q, d[:, past:], k_all, d, v_all, q_pos, k_pos)
    return o.reshape(B, T, H * Dh)


def setup_inputs(seed: int = 0) -> dict:
    key = jax.random.key(seed)
    ks = jax.random.split(key, 24)

    def nrm(k, shape, s):
        return jax.random.normal(k, shape, jnp.float32) * s

    return {
        'x_prompt': nrm(ks[0], (BATCH, SEQ, D_MODEL), 1.0),
        'x_sample': nrm(ks[1], (DEC_BATCH, DEC_SEQ, D_MODEL), 1.0),
        'state_pool': nrm(ks[2], (N_A_LAYERS, DEC_BATCH, POOL_HIST, D_MODEL), 1.0),
        'cache_k': nrm(ks[3], (DEC_BATCH, PAST_LEN, N_HEADS, HEAD_DIM), 1.0),
        'cache_v': nrm(ks[4], (DEC_BATCH, PAST_LEN, N_HEADS, HEAD_DIM), 1.0),
        'cache_logf': jax.nn.log_sigmoid(FORGET_BIAS_INIT + nrm(ks[5], (DEC_BATCH, PAST_LEN, N_HEADS), 1.0)),
        'g_mix': 1.0 + nrm(ks[6], (DEPTH, D_MODEL), 0.02),
        'g_ffn': 1.0 + nrm(ks[7], (DEPTH, D_MODEL), 0.02),
        'pool_w': nrm(ks[8], (N_A_LAYERS, N_POOL_GROUPS, POOL_GROUP_WIDTH, POOL_GROUP_WIDTH), POOL_GROUP_WIDTH ** -0.5),
        'pool_scale': 1.0 + nrm(ks[9], (N_A_LAYERS, D_MODEL), 0.02),
        'g_kv': 1.0 + nrm(ks[10], (D_MODEL,), 0.02),
        'w_k': nrm(ks[11], (D_MODEL, ATTN_WIDTH), D_MODEL ** -0.5),
        'w_v': nrm(ks[12], (D_MODEL, ATTN_WIDTH), D_MODEL ** -0.5),
        'w_f': nrm(ks[13], (D_MODEL, N_HEADS), D_MODEL ** -0.5),
        'b_f': FORGET_BIAS_INIT + nrm(ks[14], (N_HEADS,), 0.1),
        'g_knorm': 1.0 + nrm(ks[15], (HEAD_DIM,), 0.02),
        'w_q': nrm(ks[16], (N_B_LAYERS, D_MODEL, ATTN_WIDTH), D_MODEL ** -0.5),
        'g_qnorm': 1.0 + nrm(ks[17], (N_B_LAYERS, HEAD_DIM), 0.02),
        'w_o': nrm(ks[18], (N_B_LAYERS, ATTN_WIDTH, D_MODEL), ATTN_WIDTH ** -0.5),
        'w_gate': nrm(ks[19], (DEPTH, D_MODEL, D_FF), D_MODEL ** -0.5),
        'w_up': nrm(ks[20], (DEPTH, D_MODEL, D_FF), D_MODEL ** -0.5),
        'w_down': nrm(ks[21], (DEPTH, D_FF, D_MODEL), D_FF ** -0.5),
    }


def reference(x_prompt, x_sample, state_pool, cache_k, cache_v, cache_logf,
              g_mix, g_ffn, pool_w, pool_scale,
              g_kv, w_k, w_v, w_f, b_f, g_knorm,
              w_q, g_qnorm, w_o,
              w_gate, w_up, w_down):
    past = cache_k.shape[1]
    B, S, _ = x_prompt.shape
    Bs, Ss, _ = x_sample.shape
    xp, xs = x_prompt, x_sample
    pool_new_p, pool_new_s = [], []
    for l in range(DEPTH):
        if l < N_A_LAYERS:
            hp = rms_norm(xp, g_mix[l])
            hs = rms_norm(xs, g_mix[l])
            yp, stp = pool_mixer(hp, jnp.zeros((B, POOL_HIST, D_MODEL), hp.dtype), 0, pool_w[l], pool_scale[l])
            ys, sts = pool_mixer(hs, state_pool[l], past, pool_w[l], pool_scale[l])
            pool_new_p.append(stp)
            pool_new_s.append(sts)
            xp = xp + yp
            xs = xs + ys
        else:
            j = l - N_A_LAYERS
            if j == 0:
                k_p, v_p, logf_p = shared_kv(xp, g_kv, w_k, w_v, w_f, b_f, g_knorm)
                k_s, v_s, logf_s = shared_kv(xs, g_kv, w_k, w_v, w_f, b_f, g_knorm)
                k_all = jnp.concatenate([cache_k.astype(k_s.dtype), k_s], axis=1)
                v_all = jnp.concatenate([cache_v.astype(v_s.dtype), v_s], axis=1)
                logf_all = jnp.concatenate([cache_logf.astype(jnp.float32), logf_s], axis=1)
            hp = rms_norm(xp, g_mix[l])
            hs = rms_norm(xs, g_mix[l])
            qp = rms_norm((hp @ w_q[j]).reshape(B, S, N_HEADS, HEAD_DIM), g_qnorm[j])
            qs = rms_norm((hs @ w_q[j]).reshape(Bs, Ss, N_HEADS, HEAD_DIM), g_qnorm[j])
            op = fox_prompt(qp, k_p, v_p, logf_p).astype(xp.dtype)
            os_ = fox_sample(qs, k_all, v_all, logf_all, past).astype(xs.dtype)
            xp = xp + op @ w_o[j]
            xs = xs + os_ @ w_o[j]
        xp = xp + swiglu_ffn(rms_norm(xp, g_ffn[l]), w_gate[l], w_up[l], w_down[l])
        xs = xs + swiglu_ffn(rms_norm(xs, g_ffn[l]), w_gate[l], w_up[l], w_down[l])
    pool_state_p = jnp.stack(pool_new_p, axis=0)
    pool_state_s = jnp.stack(pool_new_s, axis=0)
    return (xp, xs, pool_state_p, pool_state_s, k_p, v_p, logf_p, k_s, v_s, logf_s)
```

```cpp
#include <hip/hip_runtime.h>
#include <hip/hip_cooperative_groups.h>
#include <cstdio>
#include <cstdint>
namespace cg = cooperative_groups;
namespace pg8 {
#define PG8_LAS __attribute__((address_space(3)))
typedef unsigned short bf16_t;
typedef short bf16x8 __attribute__((ext_vector_type(8)));
typedef float f32x4 __attribute__((ext_vector_type(4)));
typedef unsigned u32x4 __attribute__((ext_vector_type(4)));
constexpr int BM = 256, BK = 64, HALF = 128, HTB = HALF * BK * 2  , STAGE_BYTES = 8 * HTB, NXCD = 8, WGM = 8;

__host__ __device__ __forceinline__ int lds_byte(int r, int c) { const int st = (r >> 4) * 2 + (c >> 5), rr = r & 15, cc = c & 31, ob = rr * 64 + cc * 2; return st * 1024 + (ob ^ (((ob >> 9) & 1) << 5)); }
__host__ __device__ __forceinline__ void stage_rc(int b, int& R, int& C) { const int st = b / 1024, sb = b % 1024, swz = sb ^ (((sb >> 9) & 1) << 5); R = (st >> 1) * 16 + swz / 64; C = (st & 1) * 32 + (swz % 64) / 2; }
__host__ __device__ __forceinline__ int perm32(int rho) { const int n = rho >> 4, i = rho & 15; return 8 * (i >> 2) + 4 * n + (i & 3); }

struct Unit { int pm, pn; };
struct Gemm { const bf16_t* A; const bf16_t* Bt; int M, N, K; int lda; int acol_pn; };

struct StaticOrder {
    int nM, nN, nwg, G, c;
    __host__ __device__ void init(int M, int N, int G_, int c_) { nM = M / BM; nN = N / BM; nwg = nM * nN; G = G_; c = c_; }
    __host__ __device__ bool next(int i, Unit& u) const {
        const long L = (long)i * G + c; if (L >= nwg) return false;
        int wgid = (int)L; { const int q = nwg / NXCD, r = nwg % NXCD, xcd = wgid % NXCD, off = wgid / NXCD; wgid = (xcd < r ? xcd * (q + 1) : r * (q + 1) + (xcd - r) * q) + off; }
        const int nig = WGM * nN, gid = wgid / nig, fm = gid * WGM, gsz = (nM - fm) < WGM ? (nM - fm) : WGM;
        u.pm = fm + ((wgid % nig) % gsz); u.pn = (wgid % nig) / gsz; return true;
    }
    __device__ __forceinline__ void a_ready(const Unit&) const {}
    __device__ __forceinline__ void done(const Unit&) const {}
};
__device__ __forceinline__ unsigned cvt_pk_bf16(float lo, float hi) { unsigned r; asm volatile("v_cvt_pk_bf16_f32 %0, %1, %2" : "=v"(r) : "v"(lo), "v"(hi)); return r; }
typedef float f32x2 __attribute__((ext_vector_type(2)));
typedef unsigned u32x2 __attribute__((ext_vector_type(2)));
constexpr int EMP = 65536;
constexpr size_t O_YP = 0, O_YS = 67108864, O_PSP = O_YS + 1048576, O_PSS = O_PSP + 245760, O_KP = O_PSS + 245760, O_VP = O_KP + 67108864,
                 O_LP = O_VP + 67108864, O_KS = O_LP + 1048576, O_VS = O_KS + 1048576, O_LS = O_VS + 1048576, O_END = O_LS + 16384;
__device__ __forceinline__ float rstd_from_ssq(const float* ssq, int row, int fq) {
    const f32x4 v = *(const f32x4*)(ssq + (size_t)row * 16 + fq * 4);
    float s = (v[0] + v[1]) + (v[2] + v[3]);
    s += __shfl_xor(s, 16); s += __shfl_xor(s, 32);
    return __builtin_amdgcn_rsqf(s * (1.0f / 1024.0f) + 1e-6f);
}
template <bool HAS_XB, bool SRC_BF16, bool WR_F32> struct EpiRes {
    static constexpr bool HAS_SCALE = false;
    static constexpr bool PERM = false, AFTER_DRAIN = false;
    const float* srcP; const float* srcS; float* dst; bf16_t* xb; float* ssq; const float* cscale;
    __device__ __forceinline__ void operator()(const f32x4 (&acc)[2][2][4][2], const Unit& u, int wr, int wc, int fr_in, int fq_in) const {
        int ln_ = threadIdx.x & 63; asm volatile("" : "+v"(ln_)); const int fr = ln_ & 15, fq = ln_ >> 4; (void)fr_in; (void)fq_in;
        const int col0 = u.pn * BM + wc * 32 + 4 * fq;
        f32x4 sc[2][2];
#pragma unroll
        for (int bj = 0; bj < 2; ++bj)
#pragma unroll
            for (int n = 0; n < 2; ++n) sc[bj][n] = HAS_SCALE ? *(const f32x4*)(cscale + col0 + bj * HALF + n * 16) : (f32x4){1.f, 1.f, 1.f, 1.f};
#pragma unroll
        for (int ai = 0; ai < 2; ++ai)
#pragma unroll
            for (int m = 0; m < 4; ++m) {
                const int row = u.pm * BM + ai * HALF + wr * 64 + m * 16 + fr;
                const float* src = (row < EMP ? srcP + (size_t)row * 1024 : srcS + (size_t)(row - EMP) * 1024) + col0;
                float* d = dst + (size_t)row * 1024 + col0;
                float ss = 0.f;
#pragma unroll
                for (int bj = 0; bj < 2; ++bj)
#pragma unroll
                    for (int n = 0; n < 2; ++n) {
                        f32x4 v = acc[ai][bj][m][n]; if (HAS_SCALE) v = v * sc[bj][n];
                        f32x4 x;
                        if (SRC_BF16) { const u32x2 rb = *(const u32x2*)(xb + (size_t)row * 1024 + col0 + bj * HALF + n * 16);
                            x = (f32x4){__uint_as_float(rb.x << 16), __uint_as_float(rb.x & 0xffff0000u), __uint_as_float(rb.y << 16), __uint_as_float(rb.y & 0xffff0000u)} + v; }
                        else x = *(const f32x4*)(src + bj * HALF + n * 16) + v;
                        if (WR_F32) *(f32x4*)(d + bj * HALF + n * 16) = x;
                        if (HAS_XB) { u32x2 w; w.x = cvt_pk_bf16(x[0], x[1]); w.y = cvt_pk_bf16(x[2], x[3]); *(u32x2*)(xb + (size_t)row * 1024 + col0 + bj * HALF + n * 16) = w;
                            ss += (x[0] * x[0] + x[1] * x[1]) + (x[2] * x[2] + x[3] * x[3]); }
                    }
                if (HAS_XB) { ss += __shfl_xor(ss, 16); ss += __shfl_xor(ss, 32); if (fq == 0) ssq[(size_t)row * 16 + u.pn * 4 + wc] = ss; }
            }
    }
};
struct EpiGU {
    static constexpr bool PERM = true, AFTER_DRAIN = false;
    const float* ssq; bf16_t* act;
    __device__ __forceinline__ void operator()(const f32x4 (&acc)[2][2][4][2], const Unit& u, int wr, int wc, int fr_in, int fq_in) const {
        int ln_ = threadIdx.x & 63; asm volatile("" : "+v"(ln_)); const int fr = ln_ & 15, fq = ln_ >> 4; (void)fr_in; (void)fq_in;
        const int col = u.pn * 128 + wc * 32 + 8 * fq;
#pragma unroll
        for (int ai = 0; ai < 2; ++ai)
#pragma unroll
            for (int m = 0; m < 4; ++m) {
                const int row = u.pm * BM + ai * HALF + wr * 64 + m * 16 + fr;
                const float r = rstd_from_ssq(ssq, row, fq);
                u32x4 w;
#pragma unroll
                for (int n = 0; n < 2; ++n) {
                    const f32x4 g = acc[ai][0][m][n] * r, up = acc[ai][1][m][n] * r; float hh[4];
#pragma unroll
                    for (int e = 0; e < 4; ++e) hh[e] = g[e] * __builtin_amdgcn_rcpf(1.0f + __builtin_amdgcn_exp2f(-1.4426950408889634f * g[e])) * up[e];
                    w[2 * n] = cvt_pk_bf16(hh[0], hh[1]); w[2 * n + 1] = cvt_pk_bf16(hh[2], hh[3]);
                }
                *(u32x4*)(act + (size_t)row * 2816 + col) = w;
            }
    }
};
struct EpiKVQ {
    static constexpr bool PERM = true, AFTER_DRAIN = false;
    const float* ssq; const float* gn; const float* bfp; float* out; bf16_t* kvq; size_t kvq_stride;
    __device__ __forceinline__ void operator()(const f32x4 (&acc)[2][2][4][2], const Unit& u, int wr, int wc, int fr_in, int fq_in) const {
        int ln_ = threadIdx.x & 63; asm volatile("" : "+v"(ln_)); const int fr = ln_ & 15, fq = ln_ >> 4; (void)fr_in; (void)fq_in;
        const int t = u.pn >> 2, j = u.pn & 3;
        if (t == 3) {
            if (wc != 0) return;
            const int h0 = 8 * (fq & 1);
            const f32x4 b0 = *(const f32x4*)(bfp + h0), b1 = *(const f32x4*)(bfp + h0 + 4);
#pragma unroll
            for (int ai = 0; ai < 2; ++ai)
#pragma unroll
                for (int m = 0; m < 4; ++m) {
                    const int row = u.pm * BM + ai * HALF + wr * 64 + m * 16 + fr;
                    const float r = rstd_from_ssq(ssq, row, fq);
                    if (fq < 2) {
                        float* o = (row < EMP ? out + O_LP + (size_t)row * 16 : out + O_LS + (size_t)(row - EMP) * 16) + h0;
#pragma unroll
                        for (int n = 0; n < 2; ++n) { const f32x4 z = acc[ai][0][m][n] * r + (n == 0 ? b0 : b1); f32x4 lf;
#pragma unroll
                            for (int e = 0; e < 4; ++e) lf[e] = fminf(z[e], 0.f) - 0.6931471805599453f * __builtin_amdgcn_logf(1.0f + __builtin_amdgcn_exp2f(-1.4426950408889634f * fabsf(z[e])));
                            *(f32x4*)(o + 4 * n) = lf; }
                    }
                }
            return;
        }
        f32x4 gain[2][2];
#pragma unroll
        for (int bj = 0; bj < 2; ++bj)
#pragma unroll
            for (int n = 0; n < 2; ++n) gain[bj][n] = *(const f32x4*)(gn + 64 * t + 32 * bj + 8 * fq + 4 * n);
        const int cl = 256 * j + 64 * wc + 8 * fq;
        bf16_t* const ob0 = kvq + (size_t)t * kvq_stride;
#pragma unroll
        for (int ai = 0; ai < 2; ++ai)
#pragma unroll
            for (int m = 0; m < 4; ++m) {
                const int row = u.pm * BM + ai * HALF + wr * 64 + m * 16 + fr;
                const float r = rstd_from_ssq(ssq, row, fq);
                f32x4 v[2][2]; float ss = 0.f;
#pragma unroll
                for (int bj = 0; bj < 2; ++bj)
#pragma unroll
                    for (int n = 0; n < 2; ++n) { v[bj][n] = acc[ai][bj][m][n] * r; const f32x4 x = v[bj][n]; ss += (x[0] * x[0] + x[1] * x[1]) + (x[2] * x[2] + x[3] * x[3]); }
                if (t != 1) { ss += __shfl_xor(ss, 16); ss += __shfl_xor(ss, 32); const float rn = __builtin_amdgcn_rsqf(ss * (1.0f / 64.0f) + 1e-6f);
#pragma unroll
                    for (int bj = 0; bj < 2; ++bj)
#pragma unroll
                        for (int n = 0; n < 2; ++n) v[bj][n] = v[bj][n] * rn * gain[bj][n]; }
                if (t < 2) { float* o = (row < EMP ? out + (t == 0 ? O_KP : O_VP) + (size_t)row * 1024 : out + (t == 0 ? O_KS : O_VS) + (size_t)(row - EMP) * 1024) + cl;
#pragma unroll
                    for (int bj = 0; bj < 2; ++bj) { *(f32x4*)(o + 32 * bj) = v[bj][0]; *(f32x4*)(o + 32 * bj + 4) = v[bj][1]; } }
                bf16_t* ob = ob0 + (size_t)row * 1024 + cl;
#pragma unroll
                for (int bj = 0; bj < 2; ++bj) { u32x4 w; w.x = cvt_pk_bf16(v[bj][0][0], v[bj][0][1]); w.y = cvt_pk_bf16(v[bj][0][2], v[bj][0][3]); w.z = cvt_pk_bf16(v[bj][1][0], v[bj][1][1]); w.w = cvt_pk_bf16(v[bj][1][2], v[bj][1][3]);
                    *(u32x4*)(ob + 32 * bj) = w; }
            }
    }
};

struct RangeOrder {
    StaticOrder b; int i0, i1; int xc, xi;
    __device__ __forceinline__ bool next(int i, Unit& u) const {
        if (i0 + i < i1) return b.next(i0 + i, u);
        if (xc >= 0 && i0 + i == i1) { StaticOrder b2 = b; b2.c = xc; return b2.next(xi, u); }
        return false; }
    __device__ __forceinline__ void a_ready(const Unit&) const {}
    __device__ __forceinline__ void done(const Unit&) const {}
};
struct OneUnit {
    int pm, pn;
    __device__ __forceinline__ bool next(int i, Unit& u) const { if (i != 0) return false; u.pm = pm; u.pn = pn; return true; }
    __device__ __forceinline__ void a_ready(const Unit&) const {}
    __device__ __forceinline__ void done(const Unit&) const {}
};
template <class Epi, class Sched, bool ALIGN_EPI = false, bool SP2 = false>
__device__ __forceinline__ void gemm_phase(PG8_LAS unsigned char* lds, const Gemm g, const Sched& S, const Epi& E) {
    int tid_o = threadIdx.x; asm volatile("" : "+v"(tid_o)); const int tid = tid_o, wid = __builtin_amdgcn_readfirstlane(tid >> 6), lane = tid & 63, wr = wid >> 2, wc = wid & 3, fr = lane & 15, fq = lane >> 4;
    const int K = g.K, nt = K / BK;
    unsigned voffA[2], voffB[2];
#pragma unroll
    for (int i = 0; i < 2; ++i) { int R, C; stage_rc(tid * 16 + i * 8192, R, C); const int Rb = Epi::PERM ? ((R & ~31) + perm32(R & 31)) : R;
        voffA[i] = (unsigned)(R * g.lda + C) * 2u; voffB[i] = (unsigned)(Rb * K + C) * 2u; }
    const size_t kstep = (size_t)(BK * 2);
    const size_t hstepB = (size_t)HALF * K * 2, hstepA = (size_t)HALF * g.lda * 2;
    const size_t tstepB = 2 * hstepB, tstepA = 2 * hstepA;
    const unsigned ldsw = (unsigned)wid * 1024u;
    const int aoff = lds_byte(wr * 64 + fr, fq * 8), boff = lds_byte(wc * 32 + fr, fq * 8);
#define PG8_SA(b, h) (((b) * 2 + (h)) * HTB)
#define PG8_SB(b, h) ((4 + (b) * 2 + (h)) * HTB)
#define PG8_STAGE(bufoff, gbase, voff) do { _Pragma("unroll") for (int _i = 0; _i < 2; ++_i) \
        __builtin_amdgcn_global_load_lds((const unsigned*)((const char*)(gbase) + (voff)[_i]), (PG8_LAS unsigned*)(lds + (bufoff) + ldsw + _i * 8192), 16, 0, 0); } while (0)
#define PG8_LDA(dst, b, h) do { _Pragma("unroll") for (int m = 0; m < 4; ++m) _Pragma("unroll") for (int k = 0; k < 2; ++k) dst[m][k] = *(const PG8_LAS bf16x8*)(lds + PG8_SA(b, h) + aoff + m * 2048 + k * 1024); } while (0)
#define PG8_LDB(dst, b, h) do { _Pragma("unroll") for (int n = 0; n < 2; ++n) _Pragma("unroll") for (int k = 0; k < 2; ++k) dst[n][k] = *(const PG8_LAS bf16x8*)(lds + PG8_SB(b, h) + boff + n * 2048 + k * 1024); } while (0)
#define PG8_MMA(ai, bj, At, Bt) do { __builtin_amdgcn_s_setprio(1); _Pragma("unroll") for (int m = 0; m < 4; ++m) _Pragma("unroll") for (int n = 0; n < 2; ++n) _Pragma("unroll") for (int k = 0; k < 2; ++k) \
        acc[ai][bj][m][n] = __builtin_amdgcn_mfma_f32_16x16x32_bf16(Bt[n][k], At[m][k], acc[ai][bj][m][n], 0, 0, 0); __builtin_amdgcn_s_setprio(0); } while (0)
#define PG8_WAIT_V(n) asm volatile("s_waitcnt vmcnt(" #n ")" ::: "memory")
#define PG8_WAIT_L(n) asm volatile("s_waitcnt lgkmcnt(" #n ")" ::: "memory")
#define PG8_BAR __builtin_amdgcn_s_barrier()
#define PG8_SCHED __builtin_amdgcn_sched_barrier(0)
    Unit cur, nxt; int ui = 0;
    if (!S.next(0, cur)) return;
    f32x4 acc[2][2][4][2];
#pragma unroll
    for (int a = 0; a < 2; ++a)
#pragma unroll
        for (int b = 0; b < 2; ++b)
#pragma unroll
            for (int m = 0; m < 4; ++m)
#pragma unroll
                for (int n = 0; n < 2; ++n) acc[a][b][m][n] = (f32x4){0.f, 0.f, 0.f, 0.f};
    bf16x8 At[4][2], B0[2][2], B1[2][2];
    const char* cA = (const char*)g.A + (size_t)cur.pm * tstepA + (size_t)cur.pn * g.acol_pn * 2; const char* cB = (const char*)g.Bt + (size_t)cur.pn * tstepB;
    S.a_ready(cur);
    if constexpr (SP2) {
        PG8_STAGE(PG8_SB(0, 0), cB, voffB); PG8_STAGE(PG8_SB(0, 1), cB + hstepB, voffB); PG8_STAGE(PG8_SA(0, 0), cA, voffA); PG8_STAGE(PG8_SA(0, 1), cA + hstepA, voffA);
        if (wr == 1) PG8_BAR;
        PG8_WAIT_V(2); PG8_BAR;
        PG8_STAGE(PG8_SB(1, 0), cB + kstep, voffB); PG8_STAGE(PG8_SA(1, 0), cA + kstep, voffA); PG8_STAGE(PG8_SB(1, 1), cB + hstepB + kstep, voffB);
        PG8_WAIT_V(6); PG8_BAR;
    } else {
        PG8_STAGE(PG8_SB(0, 0), cB, voffB); PG8_STAGE(PG8_SA(0, 0), cA, voffA); PG8_STAGE(PG8_SB(0, 1), cB + hstepB, voffB); PG8_STAGE(PG8_SA(0, 1), cA + hstepA, voffA);
        if (wr == 1) PG8_BAR;
        PG8_WAIT_V(4); PG8_BAR;
        PG8_STAGE(PG8_SB(1, 0), cB + kstep, voffB); PG8_STAGE(PG8_SA(1, 0), cA + kstep, voffA); PG8_STAGE(PG8_SB(1, 1), cB + hstepB + kstep, voffB);
        PG8_WAIT_V(6); PG8_BAR;
    }
    for (;;) {
        const bool has_next = S.next(ui + 1, nxt);
        const char* nA = has_next ? (const char*)g.A + (size_t)nxt.pm * tstepA + (size_t)nxt.pn * g.acol_pn * 2 : cA; const char* nB = has_next ? (const char*)g.Bt + (size_t)nxt.pn * tstepB : cB;
        for (int t = 0; t < nt; t += 2) {
            const bool last = (t == nt - 2);
            const char* a1 = cA + (size_t)(t + 1) * kstep;
            const char* a2 = last ? nA : cA + (size_t)(t + 2) * kstep; const char* b2 = last ? nB : cB + (size_t)(t + 2) * kstep;
            const char* a3 = a2 + kstep; const char* b3 = b2 + kstep;
            if (last && has_next) S.a_ready(nxt);
            if constexpr (SP2) {
            PG8_LDB(B0, 0, 0); PG8_LDB(B1, 0, 1); PG8_SCHED; PG8_LDA(At, 0, 0); PG8_STAGE(PG8_SA(1, 1), a1 + hstepA, voffA);
            PG8_WAIT_V(8); PG8_WAIT_L(0); PG8_BAR; PG8_MMA(0, 0, At, B0); PG8_MMA(0, 1, At, B1); PG8_BAR; PG8_SCHED;
            PG8_LDA(At, 0, 1); PG8_STAGE(PG8_SB(0, 0), b2, voffB); PG8_STAGE(PG8_SB(0, 1), b2 + hstepB, voffB); PG8_STAGE(PG8_SA(0, 0), a2, voffA);
            PG8_WAIT_V(8); PG8_WAIT_L(0); PG8_BAR; PG8_MMA(1, 0, At, B0); PG8_MMA(1, 1, At, B1); PG8_BAR; PG8_SCHED;
            PG8_LDB(B0, 1, 0); PG8_LDB(B1, 1, 1); PG8_SCHED; PG8_LDA(At, 1, 0); PG8_STAGE(PG8_SA(0, 1), a2 + hstepA, voffA);
            PG8_WAIT_V(8); PG8_WAIT_L(0); PG8_BAR; PG8_MMA(0, 0, At, B0); PG8_MMA(0, 1, At, B1); PG8_BAR; PG8_SCHED;
            PG8_LDA(At, 1, 1); PG8_STAGE(PG8_SB(1, 0), b3, voffB); PG8_STAGE(PG8_SB(1, 1), b3 + hstepB, voffB); PG8_STAGE(PG8_SA(1, 0), a3, voffA);
            PG8_WAIT_V(8); PG8_WAIT_L(0); PG8_BAR; PG8_MMA(1, 0, At, B0); PG8_MMA(1, 1, At, B1); PG8_BAR; PG8_SCHED;
            } else {
            PG8_LDB(B0, 0, 0); PG8_SCHED; PG8_LDA(At, 0, 0); PG8_STAGE(PG8_SA(1, 1), a1 + hstepA, voffA);
            PG8_WAIT_L(8); PG8_BAR; PG8_WAIT_L(0); PG8_MMA(0, 0, At, B0); PG8_BAR; PG8_SCHED;
            PG8_LDB(B1, 0, 1); PG8_STAGE(PG8_SB(0, 0), b2, voffB);
            PG8_BAR; PG8_WAIT_L(0); PG8_MMA(0, 1, At, B1); PG8_BAR;
            PG8_LDA(At, 0, 1); PG8_STAGE(PG8_SA(0, 0), a2, voffA);
            PG8_BAR; PG8_WAIT_L(0); PG8_MMA(1, 0, At, B0); PG8_BAR; PG8_SCHED;
            PG8_STAGE(PG8_SB(0, 1), b2 + hstepB, voffB);
            PG8_WAIT_V(6); PG8_BAR; PG8_MMA(1, 1, At, B1); PG8_BAR;
            PG8_LDB(B0, 1, 0); PG8_SCHED; PG8_LDA(At, 1, 0); PG8_STAGE(PG8_SA(0, 1), a2 + hstepA, voffA);
            PG8_WAIT_L(8); PG8_BAR; PG8_WAIT_L(0); PG8_MMA(0, 0, At, B0); PG8_BAR; PG8_SCHED;
            PG8_LDB(B1, 1, 1); PG8_STAGE(PG8_SB(1, 0), b3, voffB);
            PG8_BAR; PG8_WAIT_L(0); PG8_MMA(0, 1, At, B1); PG8_BAR;
            PG8_LDA(At, 1, 1); PG8_STAGE(PG8_SA(1, 0), a3, voffA);
            PG8_BAR; PG8_WAIT_L(0); PG8_MMA(1, 0, At, B0); PG8_BAR; PG8_SCHED;
            PG8_STAGE(PG8_SB(1, 1), b3 + hstepB, voffB);
            PG8_WAIT_V(6); PG8_BAR; PG8_MMA(1, 1, At, B1); PG8_BAR;
            }
        }
        if constexpr (ALIGN_EPI) { if (wr == 0) PG8_BAR; }
        if constexpr (!Epi::AFTER_DRAIN) { E(acc, cur, wr, wc, fr, fq); S.done(cur); }
        if (!has_next) break;
#pragma unroll
        for (int a = 0; a < 2; ++a)
#pragma unroll
            for (int b = 0; b < 2; ++b)
#pragma unroll
                for (int m = 0; m < 4; ++m)
#pragma unroll
                    for (int n = 0; n < 2; ++n) acc[a][b][m][n] = (f32x4){0.f, 0.f, 0.f, 0.f};
        cur = nxt; cA = nA; cB = nB; ++ui;
        if constexpr (ALIGN_EPI) { if (wr == 1) PG8_BAR; }
    }
    PG8_WAIT_V(0);
    if constexpr (!ALIGN_EPI) { if (wr == 0) PG8_BAR; }
    PG8_BAR;
    if constexpr (Epi::AFTER_DRAIN) { E.fused(acc, cur, wr, wc, fr, fq, lds, wid, lane); S.done(cur); }
#undef PG8_SA
#undef PG8_SB
#undef PG8_STAGE
#undef PG8_LDA
#undef PG8_LDB
#undef PG8_MMA
#undef PG8_WAIT_V
#undef PG8_WAIT_L
#undef PG8_BAR
#undef PG8_SCHED
}
}

#include <hip/hip_bf16.h>
#include <cmath>
namespace attn_body {
using bf16=__hip_bfloat16;
using bf16x8=__attribute__((ext_vector_type(8)))short;
using s16x4=__attribute__((ext_vector_type(4)))short;
using f32x16=__attribute__((ext_vector_type(16)))float;
using u32x4=__attribute__((ext_vector_type(4)))unsigned;
using f32x4a=__attribute__((ext_vector_type(4)))float;
typedef __attribute__((address_space(3))) const float* lds_cfptr;
typedef __attribute__((address_space(3))) const f32x4a* lds_cf4ptr;
constexpr int BATCH=16,NHEAD=16,SEQ=4096,D=64,DM=NHEAD*D;
constexpr int NW=8,QBLK=32,QB=QBLK*NW,KVBLK=64,NQB=SEQ/QB;
constexpr int ATTN_PITCH=DM, ATTN_UNIT_ROWS=QB;
__device__ __forceinline__ int crow(int r,int hi){return (r&3)+8*(r>>2)+4*hi;}
#define SBAR() __builtin_amdgcn_sched_barrier(0)
__device__ __forceinline__ void cmask(f32x16&p0,f32x16&p1,int jb,int qrel,int hi){
  const float NEG=-INFINITY; int kb=64*jb+4*hi;
  #pragma unroll
  for(int r=0;r<16;++r){int kv=kb+(r&3)+8*(r>>2); if(kv>qrel)p0[r]=NEG; if(kv+32>qrel)p1[r]=NEG;}
}

constexpr int NSLOT=3, SLOTB=8192;
constexpr int LDS_K=0, LDS_V=NSLOT*SLOTB, LDS_WS=2*NSLOT*SLOTB, LDS_OST=LDS_WS+NW*64*4, LDS_BYTES=LDS_OST+NW*4096;
constexpr float C2=0.125f*1.4426950408889634f;
__device__ __forceinline__ void glds16(const void*gsrc,unsigned lds_dst){unsigned keep;
  asm volatile("s_mov_b32 %0, m0\n\ts_mov_b32 m0, %2\n\ts_nop 0\n\tglobal_load_lds_dwordx4 %1, off\n\ts_mov_b32 m0, %0":"=&s"(keep):"v"(gsrc),"s"(lds_dst):"memory");}
__device__ __forceinline__ float max3f(float a,float b,float c){float r;asm("v_max3_f32 %0, %1, %2, %3":"=v"(r):"v"(a),"v"(b),"v"(c));return r;}
__device__ __forceinline__ float max2f(float a,float b){float r;asm("v_max_f32_e32 %0, %1, %2":"=v"(r):"v"(a),"v"(b));return r;}
__device__ __forceinline__ float fadd_s(float a,float b){float r;asm("v_add_f32_e32 %0, %1, %2":"=v"(r):"v"(a),"v"(b));return r;}
__device__ __forceinline__ float fsub_s(float a,float b){float r;asm("v_sub_f32_e32 %0, %1, %2":"=v"(r):"v"(a),"v"(b));return r;}
typedef float f32x2_t __attribute__((ext_vector_type(2))); typedef __bf16 bf16x2_t __attribute__((ext_vector_type(2)));
__device__ __forceinline__ unsigned cvtpk_s(float lo,float hi){f32x2_t v={lo,hi};bf16x2_t b=__builtin_convertvector(v,bf16x2_t);return __builtin_bit_cast(unsigned,b);}
#define WAIT_BAR(N) asm volatile("s_waitcnt vmcnt(" #N ") lgkmcnt(0)\n\ts_barrier":::"memory")

__device__ __forceinline__ void qkt(f32x16&p0,f32x16&p1,const char*Kslot,const bf16x8*qr,int r32,int hi){
  const char*kb=Kslot+hi*1024+r32*16;
  #pragma unroll
  for(int d0=0;d0<4;++d0){
    const bf16x8 b0=*reinterpret_cast<const bf16x8*>(kb+d0*2048);
    const bf16x8 b1=*reinterpret_cast<const bf16x8*>(kb+d0*2048+512);
    {p0=__builtin_amdgcn_mfma_f32_32x32x16_bf16(b0,qr[d0],p0,0,0,0);p1=__builtin_amdgcn_mfma_f32_32x32x16_bf16(b1,qr[d0],p1,0,0,0);}}
}
typedef __attribute__((address_space(3))) const char* lds_cptr;
typedef short v4i16_t __attribute__((ext_vector_type(4)));
__device__ __forceinline__ void kload8(bf16x8*kf,lds_cptr kp){
  kf[0]=*(const __attribute__((address_space(3))) bf16x8*)(kp);      kf[1]=*(const __attribute__((address_space(3))) bf16x8*)(kp+512);
  kf[2]=*(const __attribute__((address_space(3))) bf16x8*)(kp+2048); kf[3]=*(const __attribute__((address_space(3))) bf16x8*)(kp+2560);
  kf[4]=*(const __attribute__((address_space(3))) bf16x8*)(kp+4096); kf[5]=*(const __attribute__((address_space(3))) bf16x8*)(kp+4608);
  kf[6]=*(const __attribute__((address_space(3))) bf16x8*)(kp+6144); kf[7]=*(const __attribute__((address_space(3))) bf16x8*)(kp+6656);
}
__device__ __forceinline__ void kload2(bf16x8*kf,lds_cptr kp,int j){ kf[2*j]=*(const __attribute__((address_space(3))) bf16x8*)(kp+j*2048); kf[2*j+1]=*(const __attribute__((address_space(3))) bf16x8*)(kp+j*2048+512); }
__device__ __forceinline__ s16x4 vtr(lds_cptr p){ return __builtin_bit_cast(s16x4,__builtin_amdgcn_ds_read_tr16_b64_v4i16((__attribute__((address_space(3))) v4i16_t*)p)); }
__device__ __forceinline__ float rowmax(const f32x16&p0,const f32x16&p1){
  float a=max3f(p0[0],p0[1],p1[0]),b=max3f(p0[2],p0[3],p1[1]);a=max3f(a,p1[2],p1[3]);
  #pragma unroll
  for(int r=4;r<16;r+=4){a=max3f(a,p0[r],p0[r+1]);b=max3f(b,p0[r+2],p0[r+3]);a=max3f(a,p1[r],p1[r+1]);b=max3f(b,p1[r+2],p1[r+3]);}
  const float m=max2f(a,b);
  auto rr=__builtin_amdgcn_permlane32_swap(__float_as_uint(m),__float_as_uint(m),false,false);
  return max2f(__uint_as_float(rr[0]),__uint_as_float(rr[1]));
}
__device__ __forceinline__ void pv(f32x16*o,int vb,bf16x8 pa0,bf16x8 pa1,bf16x8 pa2,bf16x8 pa3){
  #pragma unroll
  for(int d0=0;d0<2;++d0){s16x4 lo[4],hi[4];
    #pragma unroll
    for(int ks=0;ks<4;++ks){
      asm volatile("ds_read_b64_tr_b16 %0,%1 offset:%c2":"=&v"(lo[ks]):"v"(vb),"i"(d0*4096+ks*1024):"memory");
      asm volatile("ds_read_b64_tr_b16 %0,%1 offset:%c2":"=&v"(hi[ks]):"v"(vb),"i"(d0*4096+ks*1024+512):"memory");}
    asm volatile("s_waitcnt lgkmcnt(0)":::"memory");SBAR();
    #define PK(k) (bf16x8){lo[k][0],lo[k][1],lo[k][2],lo[k][3],hi[k][0],hi[k][1],hi[k][2],hi[k][3]}
    o[d0]=__builtin_amdgcn_mfma_f32_32x32x16_bf16(pa0,PK(0),o[d0],0,0,0);
    o[d0]=__builtin_amdgcn_mfma_f32_32x32x16_bf16(pa1,PK(1),o[d0],0,0,0);
    o[d0]=__builtin_amdgcn_mfma_f32_32x32x16_bf16(pa2,PK(2),o[d0],0,0,0);
    o[d0]=__builtin_amdgcn_mfma_f32_32x32x16_bf16(pa3,PK(3),o[d0],0,0,0);
    #undef PK
  }
}

#ifndef ATTN_STORE16
#define ATTN_STORE16(p,v) (*(u32x4*)(p)=(v))
#endif
template<int THRL> __device__ __forceinline__ void attn_unit(int b,int h,int qb,const bf16*Q,const bf16*__restrict__ K,const bf16*__restrict__ V,bf16*O,char*shm,lds_cfptr dkl,float lowc,int t0){
  int tid_o=threadIdx.x; asm volatile("":"+v"(tid_o)); const int tid=tid_o,lane=tid&63,r32=lane&31,hi=lane>>5; const int wid=__builtin_amdgcn_readfirstlane(tid>>6);
  const long rowbase=(long)b*SEQ; const int q0=qb*QB;
  const bf16*Qw=Q+(rowbase+q0+wid*QBLK)*DM+h*D;
  const bf16*Kh=K+(rowbase+(long)t0*KVBLK)*DM+h*D,*Vh=V+(rowbase+(long)t0*KVBLK)*DM+h*D;
  const unsigned lds0=(unsigned)(uintptr_t)shm;
  float*wsf=(float*)(shm+LDS_WS)+wid*64;
  const bf16*ksrc=Kh+(long)lane*DM+wid*8;
  const bf16*vsrc=Vh+(long)(16*(wid&3)+(lane>>2))*DM+(wid>>2)*32+(lane&3)*8;
  const unsigned kdst=lds0+LDS_K+wid*1024, vdst=lds0+LDS_V+wid*1024;
  #define DMA_K(t,slot) glds16(ksrc+(long)(t)*KVBLK*DM,(unsigned)__builtin_amdgcn_readfirstlane(kdst+(slot)))
  #define DMA_V(t,slot) glds16(vsrc+(long)(t)*KVBLK*DM,(unsigned)__builtin_amdgcn_readfirstlane(vdst+(slot)))
  const int vb0=(int)(lds0+LDS_V)+((lane>>4)&1)*32+(lane&3)*8+(4*hi+((lane&15)>>2))*64;
  const char*Kbase=shm+LDS_K; bf16x8 kf[8];
  const lds_cptr shm3=(lds_cptr)shm; const lds_cptr kp0=shm3+LDS_K+hi*1024+r32*16; const lds_cptr vp0=shm3+LDS_V+((lane>>4)&1)*32+(lane&3)*8+(4*hi+((lane&15)>>2))*64;
  const int NT=(q0+QB)/KVBLK-t0;
  DMA_K(0,0);DMA_V(0,0);DMA_K(1,SLOTB);
  bf16x8 qr[4];
  #pragma unroll
  for(int d0=0;d0<4;++d0)qr[d0]=*reinterpret_cast<const bf16x8*>(&Qw[(long)r32*DM+d0*16+hi*8]);
  const float dq2=dkl[q0+wid*QBLK+r32]; const lds_cf4ptr dk4=(lds_cf4ptr)dkl+16*t0;
  float mhat=-dq2,l_reg=0.f;f32x16 o[2];o[0]=f32x16{};o[1]=f32x16{};
  #define BINIT(P0,P1,t,NM) do{ const lds_cf4ptr d4_=dk4+16*(t)+hi; _Pragma("unroll") for(int j_=0;j_<4;++j_){ const f32x4a a_=d4_[2*j_], b_=d4_[8+2*j_]; _Pragma("unroll") for(int i_=0;i_<4;++i_){P0[4*j_+i_]=(NM)-a_[i_];P1[4*j_+i_]=(NM)-b_[i_];} } }while(0)
  #define BLOAD(P0,P1,t) do{ const lds_cf4ptr d4_=dk4+16*(t)+hi; _Pragma("unroll") for(int j_=0;j_<4;++j_){ const f32x4a a_=d4_[2*j_], b_=d4_[8+2*j_]; _Pragma("unroll") for(int i_=0;i_<4;++i_){P0[4*j_+i_]=a_[i_];P1[4*j_+i_]=b_[i_];} } }while(0)
  const int qrel=wid*QBLK+r32;
  #define CMASK(P0,P1,t) do{int jb_=(t)-(NT-4); if(jb_>=0)cmask(P0,P1,jb_,qrel,hi);}while(0)
  bool resc=false;
  #define START(P0,P1) do{ const float rm=rowmax(P0,P1); resc=false; \
    { const float dl=rm; mhat=fadd_s(mhat,dl); \
      _Pragma("unroll") for(int r=0;r<16;++r){P0[r]=fsub_s(P0[r],dl);P1[r]=fsub_s(P1[r],dl);} \
      } \
    _Pragma("unroll") for(int r=0;r<16;++r)P0[r]=__builtin_amdgcn_exp2f(P0[r]); }while(0)
  #define RESC() do{ if(resc){ asm volatile("s_waitcnt lgkmcnt(0)":::"memory"); \
      _Pragma("unroll") for(int d_=0;d_<2;++d_) _Pragma("unroll") for(int r=0;r<16;++r)o[d_][r]*=wsf[crow(r,hi)]; } }while(0)
  f32x16 pA0,pA1,pB0,pB1;
  int sl_prev=0,sl_cur=0,sl_next=SLOTB;
  #define ROT() do{sl_prev=sl_cur;sl_cur=sl_next;sl_next=(sl_next==(NSLOT-1)*SLOTB)?0:sl_next+SLOTB;}while(0)
  DMA_K(2,2*SLOTB);
  WAIT_BAR(3);
  BINIT(pA0,pA1,0,dq2);
  qkt(pA0,pA1,Kbase,qr,r32,hi);asm volatile("s_nop 15\n\ts_nop 7":"+v"(pA0),"+v"(pA1));CMASK(pA0,pA1,0);
  START(pA0,pA1);
  { const float nm0_=-mhat; BINIT(pB0,pB1,1,nm0_); }
  _Pragma("unroll") for(int r=0;r<16;++r)pA1[r]=__builtin_amdgcn_exp2f(pA1[r]);
  WAIT_BAR(0);
  DMA_K(3,0);DMA_V(1,SLOTB);
  ROT();
  kload8(kf,kp0+sl_cur);
  WAIT_BAR(2);
  s16x4 vlo[8],vhi[8]; u32x4 pw0,pw1,pw2,pw3;
  #define PKW(P,B) cvtpk_s(P[B],P[B+1])
  #define PAF(k) __builtin_bit_cast(bf16x8,pw##k)
  #define VFR(i) (bf16x8){vlo[i][0],vlo[i][1],vlo[i][2],vlo[i][3],vhi[i][0],vhi[i][1],vhi[i][2],vhi[i][3]}
  #define PIN(x) asm volatile("":"+v"(x))
  #define MX3(a,b,c) __builtin_fmaxf(__builtin_fmaxf((a),(b)),(c))
  #define GAPA(MF,A0,A1,A2,A3,W0,W1,PW) do{ MF; sacc+=A0; sacc+=A1; sacc+=A2; sacc+=A3; PIN(sacc); W0; W1; PIN(PW); SBAR(); }while(0)
  #define EX(v) __builtin_amdgcn_exp2f(v)
  #define GAPB(MF,X,B,G,PI) do{ MF; X[B]=EX(X[B]); X[B+1]=EX(X[B+1]); X[B+2]=EX(X[B+2]); X[B+3]=EX(X[B+3]); PIN(X); if(G){ PI[B]=nmh_-PI[B]; PI[B+1]=nmh_-PI[B+1]; PI[B+2]=nmh_-PI[B+2]; PI[B+3]=nmh_-PI[B+3]; PIN(PI); } SBAR(); }while(0)
  #define VRD(i) do{ vlo[i]=vtr(vp_+(((i)>>2)*4096+((i)&3)*1024)); vhi[i]=vtr(vp_+(((i)>>2)*4096+((i)&3)*1024+512)); }while(0)
  #define KRD(G,j) do{ if(G){ kload2(kf,kp0+sl_next,j); SBAR(); } }while(0)
  #define STEP(C0,C1,P0,P1,t,GK,GV,GL) do{ SBAR(); \
    const lds_cptr vp_=vp0+sl_prev; \
    VRD(0); SBAR(); float sacc=(P0[0]+P0[1]); \
    GAPA(C0=__builtin_amdgcn_mfma_f32_32x32x16_bf16(kf[0],qr[0],C0,0,0,0), P0[2],P0[3],P0[4],P0[5],     pw0[0]=PKW(P0,0), pw0[1]=PKW(P0,2), pw0); \
    VRD(4); SBAR(); GAPA(C1=__builtin_amdgcn_mfma_f32_32x32x16_bf16(kf[1],qr[0],C1,0,0,0), P0[6],P0[7],P0[8],P0[9],     pw0[2]=PKW(P0,4), pw0[3]=PKW(P0,6), pw0); \
    VRD(1); SBAR(); GAPA(C0=__builtin_amdgcn_mfma_f32_32x32x16_bf16(kf[2],qr[1],C0,0,0,0),   P0[10],P0[11],P0[12],P0[13], pw1[0]=PKW(P0,8), pw1[1]=PKW(P0,10), pw1); \
    VRD(5); SBAR(); GAPA(C1=__builtin_amdgcn_mfma_f32_32x32x16_bf16(kf[3],qr[1],C1,0,0,0),   P0[14],P0[15],P1[0],P1[1],   pw1[2]=PKW(P0,12),pw1[3]=PKW(P0,14), pw1); \
    VRD(2); SBAR(); GAPA(C0=__builtin_amdgcn_mfma_f32_32x32x16_bf16(kf[4],qr[2],C0,0,0,0),   P1[2],P1[3],P1[4],P1[5],     pw2[0]=PKW(P1,0), pw2[1]=PKW(P1,2), pw2); \
    VRD(6); SBAR(); GAPA(C1=__builtin_amdgcn_mfma_f32_32x32x16_bf16(kf[5],qr[2],C1,0,0,0),   P1[6],P1[7],P1[8],P1[9],     pw2[2]=PKW(P1,4), pw2[3]=PKW(P1,6), pw2); \
    VRD(3); SBAR(); GAPA(C0=__builtin_amdgcn_mfma_f32_32x32x16_bf16(kf[6],qr[3],C0,0,0,0),   P1[10],P1[11],P1[12],P1[13], pw3[0]=PKW(P1,8), pw3[1]=PKW(P1,10), pw3); \
    VRD(7); SBAR(); GAPA(C1=__builtin_amdgcn_mfma_f32_32x32x16_bf16(kf[7],qr[3],C1,0,0,0),   P1[14],P1[15],0.f,0.f,       pw3[2]=PKW(P1,12),pw3[3]=PKW(P1,14), pw3); \
    l_reg+=sacc; \
    if(GK){DMA_K((t)+3,sl_cur);} if(GV){DMA_V((t)+1,sl_next);} \
    CMASK(C0,C1,t); \
    { float a=MX3(C0[0],C0[1],C1[0]),b=MX3(C0[2],C0[3],C1[1]); a=MX3(a,C1[2],C1[3]); \
      _Pragma("unroll") for(int r=4;r<16;r+=4){a=MX3(a,C0[r],C0[r+1]);b=MX3(b,C0[r+2],C0[r+3]);a=MX3(a,C1[r],C1[r+1]);b=MX3(b,C1[r+2],C1[r+3]);} \
      float rm=__builtin_fmaxf(a,b); { auto rr=__builtin_amdgcn_permlane32_swap(__float_as_uint(rm),__float_as_uint(rm),false,false); rm=__builtin_fmaxf(__uint_as_float(rr[0]),__uint_as_float(rr[1])); } \
      resc=false; \
      if(__builtin_expect(__any(rm>(float)THRL),0)){ const float dl=__builtin_fmaxf(rm,0.f); mhat+=dl; \
        _Pragma("unroll") for(int r=0;r<16;++r){C0[r]-=dl;C1[r]-=dl;} \
        const float f=__builtin_amdgcn_exp2f(-dl); l_reg*=f; if(hi==0)wsf[r32]=f; resc=true; } } \
    const float nmh_=-mhat; if(GL){ BLOAD(P0,P1,(t)+1); } SBAR(); \
    GAPB(o[0]=__builtin_amdgcn_mfma_f32_32x32x16_bf16(PAF(0),VFR(0),o[0],0,0,0), C0,0,GL,P0); \
    GAPB(o[1]=__builtin_amdgcn_mfma_f32_32x32x16_bf16(PAF(0),VFR(4),o[1],0,0,0), C0,4,GL,P0); \
    KRD(GL,0); GAPB(o[0]=__builtin_amdgcn_mfma_f32_32x32x16_bf16(PAF(1),VFR(1),o[0],0,0,0), C0,8,GL,P0); \
    KRD(GL,1); GAPB(o[1]=__builtin_amdgcn_mfma_f32_32x32x16_bf16(PAF(1),VFR(5),o[1],0,0,0), C0,12,GL,P0); \
    KRD(GL,2); GAPB(o[0]=__builtin_amdgcn_mfma_f32_32x32x16_bf16(PAF(2),VFR(2),o[0],0,0,0), C1,0,GL,P1); \
    KRD(GL,3); GAPB(o[1]=__builtin_amdgcn_mfma_f32_32x32x16_bf16(PAF(2),VFR(6),o[1],0,0,0), C1,4,GL,P1); \
    GAPB(o[0]=__builtin_amdgcn_mfma_f32_32x32x16_bf16(PAF(3),VFR(3),o[0],0,0,0), C1,8,GL,P1); \
    GAPB(o[1]=__builtin_amdgcn_mfma_f32_32x32x16_bf16(PAF(3),VFR(7),o[1],0,0,0), C1,12,GL,P1); \
    }while(0)
  int t=1;
  #undef CMASK
  #define CMASK(P0,P1,t) do{}while(0)
  for(;t+5<NT;t+=2){
    STEP(pB0,pB1,pA0,pA1,t,true,true,true);     WAIT_BAR(2); RESC(); ROT();
    STEP(pA0,pA1,pB0,pB1,t+1,true,true,true);   WAIT_BAR(2); RESC(); ROT();
  }
  #undef CMASK
  #define CMASK(P0,P1,t) do{int jb_=(t)-(NT-4); if(jb_>=0)cmask(P0,P1,jb_,qrel,hi);}while(0)
  #define ENDW(tt) do{ if((tt)+3<NT){WAIT_BAR(2);} else if((tt)+2<NT){WAIT_BAR(1);} else {WAIT_BAR(0);} }while(0)
  for(;t+1<NT;t+=2){
    STEP(pB0,pB1,pA0,pA1,t,(t+3<NT),(t+1<NT),(t+1<NT));       ENDW(t);   RESC(); ROT();
    STEP(pA0,pA1,pB0,pB1,t+1,(t+4<NT),(t+2<NT),(t+2<NT));     ENDW(t+1); RESC(); ROT();
  }
  STEP(pB0,pB1,pA0,pA1,NT-1,false,false,false); RESC();
  { float sacc=pB0[0]+pB0[1]; _Pragma("unroll") for(int r=2;r<16;++r)sacc+=pB0[r]; _Pragma("unroll") for(int r=0;r<16;++r)sacc+=pB1[r]; l_reg+=sacc;
    pw0=(u32x4){PKW(pB0,0),PKW(pB0,2),PKW(pB0,4),PKW(pB0,6)};pw1=(u32x4){PKW(pB0,8),PKW(pB0,10),PKW(pB0,12),PKW(pB0,14)};pw2=(u32x4){PKW(pB1,0),PKW(pB1,2),PKW(pB1,4),PKW(pB1,6)};pw3=(u32x4){PKW(pB1,8),PKW(pB1,10),PKW(pB1,12),PKW(pB1,14)};
    SBAR(); pv(o,vb0+sl_cur,PAF(0),PAF(1),PAF(2),PAF(3)); }
  #undef PKW
  #undef PAF
  #undef VFR
  #undef PIN
  #undef MX3
  #undef GAPA
  #undef GAPB
  #undef EX
  #undef VRD
  #undef KRD
  #undef STEP
  #undef ENDW
  {auto rr=__builtin_amdgcn_permlane32_swap(__float_as_uint(l_reg),__float_as_uint(l_reg),false,false);l_reg=__uint_as_float(rr[0])+__uint_as_float(rr[1]);}
  if(hi==0)wsf[32+r32]=l_reg;asm volatile("s_waitcnt lgkmcnt(0)":::"memory");
  float rli[16];
  #pragma unroll
  for(int r=0;r<16;++r)rli[r]=__builtin_amdgcn_rcpf(wsf[32+crow(r,hi)]);
  bf16*Ow=O+(rowbase+q0+wid*QBLK)*DM+h*D;
  { bf16*stg=(bf16*)(shm+LDS_OST)+wid*2048;
    #pragma unroll
    for(int r=0;r<16;++r){const int orow=crow(r,hi);
      #pragma unroll
      for(int d0=0;d0<2;++d0)stg[orow*64+d0*32+r32]=__float2bfloat16(o[d0][r]*rli[r]);}
    asm volatile("s_waitcnt lgkmcnt(0)":::"memory");
    #pragma unroll
    for(int i=0;i<4;++i){const int row=i*8+(lane>>3),ch=lane&7; const u32x4 v=*(const u32x4*)(stg+row*64+ch*8); ATTN_STORE16(Ow+(long)row*DM+ch*8,v);} }
  asm volatile("s_waitcnt lgkmcnt(0)\n\ts_barrier":::"memory");
  #undef BINIT
  #undef BLOAD
  #undef DMA_K
  #undef DMA_V
  #undef CMASK
  #undef START
  #undef RESC
  #undef ROT
}
constexpr int ATTN_LDS_BYTES=LDS_BYTES;
#undef SBAR
#undef WAIT_BAR
}

#define LAS __attribute__((address_space(3)))
typedef unsigned short bf16;
typedef unsigned v4u __attribute__((ext_vector_type(4)));
typedef unsigned v2u __attribute__((ext_vector_type(2)));
typedef float f32x4 __attribute__((ext_vector_type(4)));
typedef float f32x16 __attribute__((ext_vector_type(16)));
typedef short bf16x8 __attribute__((ext_vector_type(8)));

constexpr int MP = 65536, MS = 1024, MT = MP + MS, DMODEL = 1024, FF = 2816, SEQL = 4096, PAST = 1024, SSQ_ = 64, KVS = PAST + SSQ_;
constexpr float LOG2E = 1.4426950408889634f;
constexpr size_t MiB = 1u << 20;
constexpr size_t WS_WPOOL = 0, WS_WGU0 = 1 * MiB, WS_WGU1 = 12 * MiB, WS_WDN0 = 23 * MiB, WS_WDN1 = 29 * MiB, WS_WKVQ = 35 * MiB, WS_WO = 42 * MiB,
                 WS_RSTD = 44 * MiB, WS_SSQ = 45 * MiB, WS_DK2 = 50 * MiB, WS_DKS = 54 * MiB, WS_XB = 64 * MiB, WS_PB = 194 * MiB, WS_R1 = 324 * MiB,
                 WS_KB = WS_R1, WS_VB = WS_R1 + 130 * MiB, WS_QB = WS_R1 + 260 * MiB, WS_GN = 56 * MiB, WS_CTL = 57 * MiB, WS_KVQS = 58 * MiB, WS_END = WS_R1 + 390 * MiB;
constexpr int LDS_BYTES = 147456;
constexpr int DK_OFF = 86016;
static_assert(attn_body::ATTN_LDS_BYTES <= DK_OFF && DK_OFF + 16384 <= LDS_BYTES && pg8::STAGE_BYTES <= LDS_BYTES, "LDS map");

__device__ __forceinline__ float wave_sum(float v) {
#pragma unroll
    for (int o = 1; o < 64; o <<= 1) v += __shfl_xor(v, o);
    return v;
}
__device__ __forceinline__ float wave_max(float v) {
#pragma unroll
    for (int o = 1; o < 64; o <<= 1) v = fmaxf(v, __shfl_xor(v, o));
    return v;
}
__device__ __forceinline__ unsigned pk2(float lo, float hi) { return pg8::cvt_pk_bf16(lo, hi); }
__device__ __forceinline__ float bf2f(unsigned short b) { return __uint_as_float((unsigned)b << 16); }
__device__ __forceinline__ int crow(int r, int hi) { return (r & 3) + 8 * (r >> 2) + 4 * hi; }

struct RmOff { int off; __device__ __forceinline__ int operator()(int n) const { return off + n; } };
struct RmGU  { int up;  __device__ __forceinline__ int operator()(int n) const { return 256 * (n >> 7) + (n & 127) + up * 128; } };
struct RmKVQ { int base; __device__ __forceinline__ int operator()(int n) const { const int l = n & 255; return base + (n & ~255) + 128 * ((l >> 5) & 1) + 32 * (l >> 6) + (l & 31); } };

template <class RowMap> __device__ __forceinline__ void transpose_item(const float* W, int K, int N, bf16* WT, const RowMap rm, const float* kgain, const float* nscale, LAS float* scr, int item, int lane) {
    const int nblk = N / 32, kb = item / nblk, nb = item % nblk, k0 = 64 * kb, n0 = 32 * nb;
    const float ns = nscale ? nscale[n0 + (lane & 31)] : 1.f;
#pragma unroll 8
    for (int i = 0; i < 32; ++i) { const int kk = 2 * i + (lane >> 5); float v = W[(size_t)(k0 + kk) * N + n0 + (lane & 31)] * ns; if (kgain) v *= kgain[k0 + kk]; scr[kk * 33 + (lane & 31)] = v; }
    asm volatile("s_waitcnt lgkmcnt(0)" ::: "memory");
    const int c = lane & 7;
#pragma unroll
    for (int j = 0; j < 4; ++j) { const int n = (lane >> 3) + 8 * j; const LAS float* s = scr + (8 * c) * 33 + n;
        v4u o; o.x = pk2(s[0 * 33], s[1 * 33]); o.y = pk2(s[2 * 33], s[3 * 33]); o.z = pk2(s[4 * 33], s[5 * 33]); o.w = pk2(s[6 * 33], s[7 * 33]);
        *(v4u*)(WT + (size_t)rm(n0 + n) * K + k0 + 8 * c) = o; }
    asm volatile("s_waitcnt lgkmcnt(0)" ::: "memory");
}

#define XB_TMO      128
#define XB_XCNT(j)  (256  + 64 * (j))
#define XB_XSUB(j)  (1280 + 64 * (j))
#define XB_XGEN(j)  (2304 + 64 * (j))
#define XB_TOP      3328
#define XB_TOPGEN   3392
#define XCD_BAR_WORDS 3456
#define XB_SPIN_CAP (1u << 18)

__device__ __forceinline__ unsigned xb_ld(unsigned* p)              { return __hip_atomic_load(p, __ATOMIC_RELAXED, __HIP_MEMORY_SCOPE_AGENT); }
__device__ __forceinline__ unsigned xb_add(unsigned* p, unsigned v) { return __hip_atomic_fetch_add(p, v, __ATOMIC_RELAXED, __HIP_MEMORY_SCOPE_AGENT); }
__device__ __forceinline__ unsigned xb_xcc_id() { return (unsigned)__builtin_amdgcn_s_getreg((3 << 11) | 20) & 0xFu; }
#define XB_SPIN(cond, bar) do { unsigned _sp = 0; while (cond) { __builtin_amdgcn_s_sleep(1); \
    if ((++_sp & 255u) == 0u) { if (xb_ld(&(bar)[XB_TMO])) break; if (_sp > XB_SPIN_CAP) { atomicAdd(&(bar)[XB_TMO], 1u); break; } } } } while (0)

struct XcdBarrier {
    unsigned* bar; unsigned x;
    volatile LAS unsigned* st;
};

__device__ __forceinline__ XcdBarrier xcd_barrier_post(unsigned* bar, volatile LAS unsigned* st) {
    XcdBarrier b; b.bar = bar; b.x = xb_xcc_id(); b.st = st;
    if (threadIdx.x == 0) (void)xb_add(&bar[XB_XCNT(b.x)], 1u);
    return b;
}
__device__ __forceinline__ void xcd_barrier_complete(unsigned* bar, unsigned x, unsigned& nloc, unsigned& nx) {
    const unsigned G = gridDim.x * gridDim.y * gridDim.z;
    unsigned sum, cnt, mine, sp = 0u;
    for (;;) {
        sum = 0u; cnt = 0u; mine = 0u;
#pragma unroll
        for (unsigned j = 0; j < 16; ++j) { const unsigned c = xb_ld(&bar[XB_XCNT(j)]); sum += c; cnt += (c > 0u) ? 1u : 0u; mine = (j == x) ? c : mine; }
        if (sum == G) break;
        __builtin_amdgcn_s_sleep(1);
        if ((++sp & 255u) == 0u) { if (xb_ld(&bar[XB_TMO])) break; if (sp > XB_SPIN_CAP) { atomicAdd(&bar[XB_TMO], 1u); break; } }
    }
    nloc = mine > 0u ? mine : 1u; nx = cnt > 0u ? cnt : 1u;
}

__device__ __forceinline__ void xcd_barrier(const XcdBarrier& b) {
    asm volatile("s_waitcnt vmcnt(0)" ::: "memory");
    __syncthreads();
    if (threadIdx.x == 0) {
        unsigned* bar = b.bar;
        __builtin_amdgcn_s_waitcnt(0);
        unsigned nloc = b.st[0], nx = b.st[1];
        if (nloc == 0u) { xcd_barrier_complete(bar, b.x, nloc, nx); b.st[0] = nloc; b.st[1] = nx; }
        const unsigned old = xb_add(&bar[XB_XSUB(b.x)], 1u);
        const unsigned gen = old / nloc;
        if (old + 1u == (gen + 1u) * nloc) {
            __builtin_amdgcn_fence(__ATOMIC_RELEASE, "agent");
            asm volatile("s_waitcnt vmcnt(0)" ::: "memory");
            const unsigned og = xb_add(&bar[XB_TOP], 1u);
            const unsigned tg = og / nx;
            if (og + 1u == (tg + 1u) * nx) xb_add(&bar[XB_TOPGEN], 1u);
            else XB_SPIN(xb_ld(&bar[XB_TOPGEN]) == tg, bar);
            __builtin_amdgcn_fence(__ATOMIC_ACQUIRE, "agent");
            xb_add(&bar[XB_XGEN(b.x)], 1u);
            asm volatile("s_waitcnt vmcnt(0)" ::: "memory");
        } else {
            XB_SPIN(xb_ld(&bar[XB_XGEN(b.x)]) == gen, bar);
            __builtin_amdgcn_fence(__ATOMIC_ACQUIRE, "agent");
            asm volatile("s_waitcnt vmcnt(0)" ::: "memory");
        }
    }
    __syncthreads();
}

struct Args { const float* in[22]; float* out; unsigned char* ws; };
enum { I_XP = 0, I_XS, I_SP, I_CK, I_CV, I_CL, I_GMIX, I_GFFN, I_PW, I_PS, I_GKV, I_WK, I_WV, I_WF, I_BF, I_GKN, I_WQ, I_GQN, I_WO, I_WG, I_WU, I_WD };

template <int W> __device__ __forceinline__ void pool_item(const float* xb_, const float* rstd, const float* sp_, int t0, bool smp, f32x4 gm, bf16* pb_, float* ps_, int pst) {
    f32x4 halo[W - 1], mn[16];
    if (t0 > 0) {
#pragma unroll
        for (int i = 0; i < W - 1; ++i) { const int t = t0 - (W - 1) + i; halo[i] = (*(const f32x4*)(xb_ + (size_t)t * 1024) * rstd[t]) * gm; }
    } else if (smp) {
#pragma unroll
        for (int i = 0; i < W - 1; ++i) halo[i] = *(const f32x4*)(sp_ + (size_t)(15 - (W - 1) + i) * 1024);
    } else {
#pragma unroll
        for (int i = 0; i < W - 1; ++i) halo[i] = (f32x4){0.f, 0.f, 0.f, 0.f};
    }
#pragma unroll
    for (int r = 0; r < 16; ++r) mn[r] = (*(const f32x4*)(xb_ + (size_t)(t0 + r) * 1024) * rstd[t0 + r]) * gm;
    f32x4 s = {0.f, 0.f, 0.f, 0.f};
#pragma unroll
    for (int i = 0; i < W - 1; ++i) s += halo[i];
#pragma unroll
    for (int r = 0; r < 16; ++r) {
        const int t = t0 + r; s += mn[r];
        const int cnt = (smp || t + 1 >= W) ? W : t + 1;
        const f32x4 p = s * (1.0f / (float)cnt) - mn[r];
        v2u pw; pw.x = pk2(p[0], p[1]); pw.y = pk2(p[2], p[3]);
        *(v2u*)(pb_ + (size_t)r * 1024) = pw;
        if (t >= pst) *(f32x4*)(ps_ + (size_t)(t - pst) * 1024) = mn[r];
        s -= (r - (W - 1) >= 0) ? mn[r - (W - 1) >= 0 ? r - (W - 1) : 0] : halo[r < W - 1 ? r : 0];
    }
}

__device__ __forceinline__ void sample_attn(int b, int h, const float* ck, const float* cv, const bf16* KB, const bf16* VB, const bf16* QB, const float* dks, bf16* OB,
                                            LAS unsigned char* lds, int tid, int lane, int wid) {
    constexpr int RS = 144;
    LAS unsigned char* Ks = lds; LAS unsigned char* Vs = lds + 128 * RS; LAS float* comb = (LAS float*)(lds + 2 * 128 * RS);
    const int r32 = lane & 31, hi = lane >> 5, qh = wid & 1, kg = wid >> 1;
    const int qrow = MP + b * 64 + qh * 32 + r32;
    bf16x8 qf[4];
#pragma unroll
    for (int d0 = 0; d0 < 4; ++d0) qf[d0] = *(const bf16x8*)(QB + (size_t)qrow * 1024 + h * 64 + d0 * 16 + hi * 8);
    const int qpos = PAST + qh * 32 + r32; const float dq2 = dks[qpos];
    float m = -1e30f, l = 0.f; f32x16 o0 = {}, o1 = {};
    const int kk = tid >> 2, dseg = (tid & 3) * 16;
    f32x4 kr[4], vr[4];
#define SA_LOAD(c) do { const int j_ = 128 * (c) + kk; \
        if (j_ < PAST) { const f32x4* pk_ = (const f32x4*)(ck + (((size_t)b * PAST + j_) * 16 + h) * 64 + dseg); const f32x4* pv_ = (const f32x4*)(cv + (((size_t)b * PAST + j_) * 16 + h) * 64 + dseg); \
            _Pragma("unroll") for (int i_ = 0; i_ < 4; ++i_) { kr[i_] = pk_[i_]; vr[i_] = pv_[i_]; } } \
        else if (j_ < KVS) { const v4u* pk_ = (const v4u*)(KB + (size_t)(MP + b * 64 + j_ - PAST) * 1024 + h * 64 + dseg); const v4u* pv_ = (const v4u*)(VB + (size_t)(MP + b * 64 + j_ - PAST) * 1024 + h * 64 + dseg); \
            _Pragma("unroll") for (int i_ = 0; i_ < 2; ++i_) { const v4u a_ = pk_[i_], c_ = pv_[i_]; \
                kr[2 * i_] = (f32x4){__uint_as_float(a_.x << 16), __uint_as_float(a_.x & 0xffff0000u), __uint_as_float(a_.y << 16), __uint_as_float(a_.y & 0xffff0000u)}; \
                kr[2 * i_ + 1] = (f32x4){__uint_as_float(a_.z << 16), __uint_as_float(a_.z & 0xffff0000u), __uint_as_float(a_.w << 16), __uint_as_float(a_.w & 0xffff0000u)}; \
                vr[2 * i_] = (f32x4){__uint_as_float(c_.x << 16), __uint_as_float(c_.x & 0xffff0000u), __uint_as_float(c_.y << 16), __uint_as_float(c_.y & 0xffff0000u)}; \
                vr[2 * i_ + 1] = (f32x4){__uint_as_float(c_.z << 16), __uint_as_float(c_.z & 0xffff0000u), __uint_as_float(c_.w << 16), __uint_as_float(c_.w & 0xffff0000u)}; } } \
        else { _Pragma("unroll") for (int i_ = 0; i_ < 4; ++i_) { kr[i_] = (f32x4){0.f, 0.f, 0.f, 0.f}; vr[i_] = (f32x4){0.f, 0.f, 0.f, 0.f}; } } } while (0)
    SA_LOAD(0);
    for (int c = 0; c < 9; ++c) {
        __syncthreads();
        {
            v4u a, bq;
            a.x = pk2(kr[0][0], kr[0][1]); a.y = pk2(kr[0][2], kr[0][3]); a.z = pk2(kr[1][0], kr[1][1]); a.w = pk2(kr[1][2], kr[1][3]);
            bq.x = pk2(kr[2][0], kr[2][1]); bq.y = pk2(kr[2][2], kr[2][3]); bq.z = pk2(kr[3][0], kr[3][1]); bq.w = pk2(kr[3][2], kr[3][3]);
            *(LAS v4u*)(Ks + kk * RS + dseg * 2) = a; *(LAS v4u*)(Ks + kk * RS + dseg * 2 + 16) = bq;
            a.x = pk2(vr[0][0], vr[0][1]); a.y = pk2(vr[0][2], vr[0][3]); a.z = pk2(vr[1][0], vr[1][1]); a.w = pk2(vr[1][2], vr[1][3]);
            bq.x = pk2(vr[2][0], vr[2][1]); bq.y = pk2(vr[2][2], vr[2][3]); bq.z = pk2(vr[3][0], vr[3][1]); bq.w = pk2(vr[3][2], vr[3][3]);
            *(LAS v4u*)(Vs + kk * RS + dseg * 2) = a; *(LAS v4u*)(Vs + kk * RS + dseg * 2 + 16) = bq;
        }
        __syncthreads();
        if (c + 1 < 9) SA_LOAD(c + 1);
        const int kvb = 128 * c + 32 * kg;
        if (kvb < KVS) {
            f32x16 s = {};
#pragma unroll
            for (int d0 = 0; d0 < 4; ++d0) { const bf16x8 kf = *(const LAS bf16x8*)(Ks + (32 * kg + r32) * RS + (d0 * 16 + hi * 8) * 2); s = __builtin_amdgcn_mfma_f32_32x32x16_bf16(kf, qf[d0], s, 0, 0, 0); }
            float mx = -1e30f;
#pragma unroll
            for (int jj = 0; jj < 4; ++jj) { const f32x4 dk = *(const f32x4*)(dks + kvb + 8 * jj + 4 * hi);
#pragma unroll
                for (int e = 0; e < 4; ++e) { const int kv = kvb + 8 * jj + 4 * hi + e; float x = s[4 * jj + e] + dq2 - dk[e]; x = (kv > qpos) ? -1e30f : x; s[4 * jj + e] = x; mx = fmaxf(mx, x); } }
            mx = fmaxf(mx, __shfl_xor(mx, 32));
            const float mn = fmaxf(m, mx), alpha = __builtin_amdgcn_exp2f(m - mn); m = mn;
            float ps = 0.f;
#pragma unroll
            for (int r = 0; r < 16; ++r) { s[r] = __builtin_amdgcn_exp2f(s[r] - mn); ps += s[r]; }
            l = l * alpha + ps; o0 = o0 * alpha; o1 = o1 * alpha;
#pragma unroll
            for (int ks = 0; ks < 2; ++ks) {
                v4u pw; pw.x = pk2(s[8 * ks], s[8 * ks + 1]); pw.y = pk2(s[8 * ks + 2], s[8 * ks + 3]); pw.z = pk2(s[8 * ks + 4], s[8 * ks + 5]); pw.w = pk2(s[8 * ks + 6], s[8 * ks + 7]);
                const bf16x8 pb = __builtin_bit_cast(bf16x8, pw);
#pragma unroll
                for (int dh = 0; dh < 2; ++dh) { bf16x8 va;
#pragma unroll
                    for (int i = 0; i < 8; ++i) va[i] = *(const LAS short*)(Vs + (32 * kg + crow(8 * ks + i, hi)) * RS + (dh * 32 + r32) * 2);
                    if (dh == 0) o0 = __builtin_amdgcn_mfma_f32_32x32x16_bf16(va, pb, o0, 0, 0, 0); else o1 = __builtin_amdgcn_mfma_f32_32x32x16_bf16(va, pb, o1, 0, 0, 0); }
            }
        }
    }
#undef SA_LOAD
    l += __shfl_xor(l, 32);
    LAS float* cw = comb + wid * (32 * 66) + r32 * 66;
#pragma unroll
    for (int r = 0; r < 16; ++r) { cw[crow(r, hi)] = o0[r]; cw[32 + crow(r, hi)] = o1[r]; }
    if (hi == 0) { cw[64] = m; cw[65] = l; }
    __syncthreads();
    {
        const int q64 = tid >> 3, d8 = (tid & 7) * 8, qh2 = q64 >> 5, ql = q64 & 31;
        float M = -1e30f;
#pragma unroll
        for (int g = 0; g < 4; ++g) M = fmaxf(M, comb[(g * 2 + qh2) * (32 * 66) + ql * 66 + 64]);
        float den = 0.f, a8[8];
#pragma unroll
        for (int e = 0; e < 8; ++e) a8[e] = 0.f;
#pragma unroll
        for (int g = 0; g < 4; ++g) { const LAS float* base = comb + (g * 2 + qh2) * (32 * 66) + ql * 66; const float w = __builtin_amdgcn_exp2f(base[64] - M); den += w * base[65];
#pragma unroll
            for (int e = 0; e < 8; ++e) a8[e] += w * base[d8 + e]; }
        const float inv = 1.0f / den;
        v4u w; w.x = pk2(a8[0] * inv, a8[1] * inv); w.y = pk2(a8[2] * inv, a8[3] * inv); w.z = pk2(a8[4] * inv, a8[5] * inv); w.w = pk2(a8[6] * inv, a8[7] * inv);
        *(v4u*)(OB + (size_t)(MP + b * 64 + q64) * 1024 + h * 64 + d8) = w;
    }
    __syncthreads();
}

#ifndef PG_ALIGN
#define PG_ALIGN true
#endif
#ifndef PH_MASK
#define PH_MASK 0xFFFF
#endif
#define RUN(p) (((PH_MASK) >> (p)) & 1)
#ifndef REP_MASK
#define REP_MASK 0
#endif
#define NREP(p) (1 + (((REP_MASK) >> (p)) & 1))

__global__ void __launch_bounds__(512, 2) mega(Args a) {
    extern __shared__ __attribute__((aligned(16))) unsigned char lds_raw[];
    cg::grid_group grid = cg::this_grid();
    LAS unsigned char* lds = (LAS unsigned char*)lds_raw;
    const int G = gridDim.x;
    int vcu;
    {
        LAS int* vs = (LAS int*)(lds_raw + LDS_BYTES - 16);
        if (threadIdx.x == 0) {
            unsigned* cen = (unsigned*)(a.ws + WS_CTL);
            const unsigned xcc = (unsigned)__builtin_amdgcn_s_getreg((3 << 11) | 20) & 7u;
            const unsigned rank = __hip_atomic_fetch_add(cen + 64 * xcc, 1u, __ATOMIC_RELAXED, __HIP_MEMORY_SCOPE_AGENT);
            vs[0] = (G == 256 && rank < 32u) ? (int)(xcc + 8u * rank) : -1;
        }
        __syncthreads();
        vcu = __builtin_amdgcn_readfirstlane(vs[0]);
        if (threadIdx.x == 0) { vs[1] = 0; vs[2] = 0; }
        __syncthreads();
    }
#define PHASE_ENTER() int tid_o = threadIdx.x; asm volatile("" : "+v"(tid_o)); const int tid = tid_o, lane = tid & 63, wave = __builtin_amdgcn_readfirstlane(tid >> 6); (void)lane; (void)wave; \
    int bx_o = blockIdx.x; asm volatile("" : "+s"(bx_o)); const int bx = bx_o; size_t zo_ = 0; asm volatile("" : "+s"(zo_)); unsigned char* ws = a.ws + zo_; float* out = a.out + zo_; \
    const float* xp = a.in[I_XP]; const float* xs = a.in[I_XS]; (void)xp; (void)xs; \
    bf16* WPOOL = (bf16*)(ws + WS_WPOOL); bf16* WKVQ = (bf16*)(ws + WS_WKVQ); bf16* WOT = (bf16*)(ws + WS_WO); \
    float* RSTD = (float*)(ws + WS_RSTD); float* SSQ = (float*)(ws + WS_SSQ); float* DK2 = (float*)(ws + WS_DK2); float* DKS = (float*)(ws + WS_DKS); \
    bf16* XB = (bf16*)(ws + WS_XB); bf16* PB = (bf16*)(ws + WS_PB); bf16* OB = PB; bf16* ACT = (bf16*)(ws + WS_R1); \
    bf16* QB = (bf16*)(ws + WS_QB); bf16* KB = (bf16*)(ws + WS_KB); bf16* VB = (bf16*)(ws + WS_VB); \
    (void)WPOOL; (void)WKVQ; (void)WOT; (void)RSTD; (void)SSQ; (void)DK2; (void)DKS; (void)XB; (void)PB; (void)OB; (void)ACT; (void)QB; (void)KB; (void)VB;
    (void)xcd_barrier_post((unsigned*)(a.ws + WS_CTL + 4096), (volatile LAS unsigned*)(lds_raw + LDS_BYTES - 12));
#define GSYNC() do { size_t zb_ = 0; asm volatile("" : "+s"(zb_)); XcdBarrier xb_; xb_.bar = (unsigned*)(a.ws + WS_CTL + 4096) + zb_; xb_.x = xb_xcc_id(); xb_.st = (volatile LAS unsigned*)(lds_raw + LDS_BYTES - 12); xcd_barrier(xb_); } while (0)
#define GSYNC0() do { asm volatile("s_waitcnt vmcnt(0)" ::: "memory"); grid.sync(); __builtin_amdgcn_fence(__ATOMIC_ACQUIRE, "agent"); asm volatile("s_waitcnt vmcnt(0)" ::: "memory"); } while (0)

    grid.sync();
    for (int rep_ = 0; rep_ < NREP(0); ++rep_) { if (rep_) GSYNC(); PHASE_ENTER();
        LAS float* scr = (LAS float*)(lds + wave * 16384);
        const int gw = bx * 8 + wave, NGW = G * 8;
        constexpr int I_POOL = 4 * 32, I_GU = 16 * 88, I_DN = 44 * 32, I_SQ = 16 * 32;
        constexpr int NITEMS = I_POOL + 4 * I_GU + 2 * I_DN + 4 * I_SQ;
        for (int it = gw; it < NITEMS; it += NGW) {
            int r = it;
            if (r < I_POOL) { const int mtx = r >> 5; transpose_item(a.in[I_PW] + (size_t)mtx * 65536, 256, 256, WPOOL, RmOff{mtx * 256}, nullptr, a.in[I_PS] + mtx * 256, scr, r & 31, lane); continue; } r -= I_POOL;
            if (r < 4 * I_GU) { const int mtx = r / I_GU, l = mtx >> 1, up = mtx & 1; transpose_item((up ? a.in[I_WU] : a.in[I_WG]) + (size_t)l * 1024 * 2816, 1024, 2816, (bf16*)(ws + (l ? WS_WGU1 : WS_WGU0)), RmGU{up}, a.in[I_GFFN] + l * 1024, nullptr, scr, r % I_GU, lane); continue; } r -= 4 * I_GU;
            if (r < 2 * I_DN) { const int l = r / I_DN; transpose_item(a.in[I_WD] + (size_t)l * 2816 * 1024, 2816, 1024, (bf16*)(ws + (l ? WS_WDN1 : WS_WDN0)), RmOff{0}, nullptr, nullptr, scr, r % I_DN, lane); continue; } r -= 2 * I_DN;
            if (r < I_SQ) { transpose_item(a.in[I_WK], 1024, 1024, WKVQ, RmKVQ{0}, a.in[I_GKV], nullptr, scr, r, lane); continue; } r -= I_SQ;
            if (r < I_SQ) { transpose_item(a.in[I_WV], 1024, 1024, WKVQ, RmKVQ{1024}, a.in[I_GKV], nullptr, scr, r, lane); continue; } r -= I_SQ;
            if (r < I_SQ) { transpose_item(a.in[I_WQ], 1024, 1024, WKVQ, RmKVQ{2048}, a.in[I_GMIX] + 1024, nullptr, scr, r, lane); continue; } r -= I_SQ;
            transpose_item(a.in[I_WO], 1024, 1024, WOT, RmOff{0}, nullptr, nullptr, scr, r, lane);
        }
        const int gt = bx * 512 + tid, NT = G * 512;
        for (int i = gt; i < 16 * 1024; i += NT) { const int n = i >> 10, k = i & 1023; WKVQ[(size_t)(3072 + n) * 1024 + k] = (bf16)(pk2(a.in[I_WF][k * 16 + n] * a.in[I_GKV][k], 0.f) & 0xffffu); }
        if (gt < 192) ((float*)(ws + WS_GN))[gt] = gt < 64 ? a.in[I_GKN][gt] : gt < 128 ? 1.0f : a.in[I_GQN][gt - 128] * (0.125f * LOG2E);
        for (int i = gt; i < 240 * 1024 / 8; i += NT) ((v4u*)(WKVQ + (size_t)3088 * 1024))[i] = (v4u){0u, 0u, 0u, 0u};
        for (int m4 = gw; m4 < MT / 4; m4 += NGW) {
            const int m = 4 * (MT / 4 - 1 - m4);
            const f32x4* xr = (const f32x4*)(m < MP ? xp + (size_t)m * 1024 : xs + (size_t)(m - MP) * 1024) + lane; f32x4 v[4][4];
#pragma unroll
            for (int r = 0; r < 4; ++r)
#pragma unroll
                for (int j = 0; j < 4; ++j) v[r][j] = xr[256 * r + 64 * j];
            float s4[4];
#pragma unroll
            for (int r = 0; r < 4; ++r) { float s = 0.f;
#pragma unroll
                for (int j = 0; j < 4; ++j) s += (v[r][j][0] * v[r][j][0] + v[r][j][1] * v[r][j][1]) + (v[r][j][2] * v[r][j][2] + v[r][j][3] * v[r][j][3]);
                s4[r] = wave_sum(s); }
            if (lane == 0) *(f32x4*)(RSTD + m) = (f32x4){__builtin_amdgcn_rsqf(s4[0] * (1.0f / 1024.0f) + 1e-6f), __builtin_amdgcn_rsqf(s4[1] * (1.0f / 1024.0f) + 1e-6f),
                                                          __builtin_amdgcn_rsqf(s4[2] * (1.0f / 1024.0f) + 1e-6f), __builtin_amdgcn_rsqf(s4[3] * (1.0f / 1024.0f) + 1e-6f)};
        }
    }
    GSYNC();
    {
        const unsigned* cen = (const unsigned*)(a.ws + WS_CTL); bool okc = (G == 256);
#pragma unroll
        for (int x = 0; x < 8; ++x) okc = okc && (__hip_atomic_load(cen + 64 * x, __ATOMIC_RELAXED, __HIP_MEMORY_SCOPE_AGENT) == 32u);
        if (!okc) vcu = blockIdx.x;
    }

    for (int rep_ = 0; rep_ < NREP(1); ++rep_) { if (rep_) GSYNC(); PHASE_ENTER();
        const int half = tid >> 8, c4 = (tid & 255) * 4, grp = __builtin_amdgcn_readfirstlane(c4 >> 8);
        const f32x4 gm = *(const f32x4*)(a.in[I_GMIX] + c4);
        for (int item = bx * 2 + half; item < MT / 16; item += G * 2) {
            const int row0 = item * 16; const bool smp = row0 >= MP;
            int b, t0; if (smp) { const int rs = row0 - MP; b = rs >> 6; t0 = rs & 63; } else { b = row0 >> 12; t0 = row0 & 4095; }
            const int base = row0 - t0;
            const float* xb_ = (smp ? xs + (size_t)(base - MP) * 1024 : xp + (size_t)base * 1024) + c4;
            const float* sp_ = a.in[I_SP] + (size_t)b * 15 * 1024 + c4;
            float* ps_ = out + (smp ? pg8::O_PSS : pg8::O_PSP) + (size_t)b * 15 * 1024 + c4;
            bf16* pb_ = PB + (size_t)row0 * 1024 + c4;
            const int pst = smp ? 49 : 4081;
            if (grp == 0) pool_item<2>(xb_, RSTD + base, sp_, t0, smp, gm, pb_, ps_, pst);
            else if (grp == 1) pool_item<4>(xb_, RSTD + base, sp_, t0, smp, gm, pb_, ps_, pst);
            else if (grp == 2) pool_item<8>(xb_, RSTD + base, sp_, t0, smp, gm, pb_, ps_, pst);
            else pool_item<16>(xb_, RSTD + base, sp_, t0, smp, gm, pb_, ps_, pst);
        }
    }
    GSYNC();

    for (int rep_ = 0; rep_ < NREP(2); ++rep_) { if (rep_) GSYNC(); PHASE_ENTER();
        pg8::Gemm g{PB, WPOOL, MT, 1024, 256, 1024, 256}; pg8::StaticOrder S; S.init(MP, 1024, G, vcu);
        pg8::EpiRes<true, false, false> E{xp, xs, out, XB, SSQ, nullptr};
        pg8::gemm_phase<pg8::EpiRes<true, false, false>, pg8::StaticOrder, PG_ALIGN, true>(lds, g, S, E);
    }
    GSYNC();

    for (int l = 0; l < 2; ++l) {
        if (l == 1) {
            for (int rep_ = 0; rep_ < NREP(5); ++rep_) { if (rep_) GSYNC(); PHASE_ENTER();
                pg8::Gemm g{XB, WKVQ, MT, 3328, 1024, 1024, 0}; pg8::StaticOrder S; S.init(MP, 3328, G, vcu);
                pg8::EpiKVQ E{SSQ, (const float*)(ws + WS_GN), a.in[I_BF], out, KB, (size_t)(130 * MiB / 2)};
                pg8::gemm_phase<pg8::EpiKVQ, pg8::StaticOrder, PG_ALIGN, true>(lds, g, S, E);
            }
            GSYNC();
            for (int rep_ = 0; rep_ < NREP(7); ++rep_) { if (rep_) GSYNC(); PHASE_ENTER();
                const float mq = wave_max(fabsf(a.in[I_GQN][lane])), mk = wave_max(fabsf(a.in[I_GKN][lane]));
                const float lowc = -(0.125f * LOG2E * 64.f) * mq * mk;
                for (int u = bx; u < 256; u += G) {
                    const int b = u >> 4, h = u & 15;
                    {
                        const float* lp = out + pg8::O_LP + ((size_t)b * 4096 + 8 * tid) * 16 + h; float v[8];
#pragma unroll
                        for (int k = 0; k < 8; ++k) v[k] = lp[(size_t)k * 16];
#pragma unroll
                        for (int k = 1; k < 8; ++k) v[k] += v[k - 1];
                        float inc = v[7];
#pragma unroll
                        for (int o = 1; o < 64; o <<= 1) { const float t = __shfl_up(inc, o); if (lane >= o) inc += t; }
                        LAS float* wt = (LAS float*)(lds + DK_OFF + 16384);
                        if (lane == 63) wt[wave] = inc;
                        __syncthreads();
                        float pre = 0.f;
#pragma unroll
                        for (int w = 0; w < 8; ++w) pre += (w < wave) ? wt[w] : 0.f;
                        const float ex = pre + inc - v[7];
                        LAS f32x4* dstl = (LAS f32x4*)(lds + DK_OFF) + 2 * tid;
                        dstl[0] = (f32x4){(v[0] + ex) * LOG2E, (v[1] + ex) * LOG2E, (v[2] + ex) * LOG2E, (v[3] + ex) * LOG2E};
                        dstl[1] = (f32x4){(v[4] + ex) * LOG2E, (v[5] + ex) * LOG2E, (v[6] + ex) * LOG2E, (v[7] + ex) * LOG2E};
                    }
                    __syncthreads();
                    for (int qb = 15; qb >= 0; --qb) {
                        const LAS float* dl = (const LAS float*)(lds + DK_OFF);
                        const float thr = dl[256 * qb] - 2.f * lowc + 45.f;
                        const int jmax = 4 * qb;
                        const bool sk = (lane < jmax) && (dl[64 * lane + 63] > thr);
                        const int t0 = (int)__builtin_popcountll(__ballot(sk)) & ~1;
                        attn_body::attn_unit<8>(b, h, qb, (const attn_body::bf16*)QB, (const attn_body::bf16*)KB, (const attn_body::bf16*)VB, (attn_body::bf16*)OB, (char*)lds_raw,
                                                (const LAS float*)(lds + DK_OFF), lowc, t0);
                    }
                    __syncthreads();
                }
            }
            for (int rep_ = 0; rep_ < NREP(7); ++rep_) { if (rep_) GSYNC(); PHASE_ENTER();
                for (int u = bx; u < 256; u += G) {
                    {
                        const int b = u >> 4, h = u & 15; const float* ls = out + pg8::O_LS + (size_t)b * 64 * 16 + h; const float* cl = a.in[I_CL] + (size_t)b * 1024 * 16 + h; float v[4];
#pragma unroll
                        for (int k = 0; k < 4; ++k) { const int j = 4 * tid + k; v[k] = j < PAST ? cl[(size_t)j * 16] : (j < KVS ? ls[(size_t)(j - PAST) * 16] : 0.f); }
#pragma unroll
                        for (int k = 1; k < 4; ++k) v[k] += v[k - 1];
                        float inc = v[3];
#pragma unroll
                        for (int o = 1; o < 64; o <<= 1) { const float t = __shfl_up(inc, o); if (lane >= o) inc += t; }
                        LAS float* wt = (LAS float*)(lds + DK_OFF + 16384);
                        if (lane == 63) wt[wave] = inc;
                        __syncthreads();
                        float pre = 0.f;
#pragma unroll
                        for (int w = 0; w < 8; ++w) pre += (w < wave) ? wt[w] : 0.f;
                        const float ex = pre + inc - v[3];
                        if (4 * tid < KVS) *(f32x4*)(DKS + (size_t)u * KVS + 4 * tid) = (f32x4){(v[0] + ex) * LOG2E, (v[1] + ex) * LOG2E, (v[2] + ex) * LOG2E, (v[3] + ex) * LOG2E};
                        asm volatile("s_waitcnt vmcnt(0)" ::: "memory"); __syncthreads();
                    }
                    sample_attn(u >> 4, u & 15, a.in[I_CK], a.in[I_CV], (bf16*)(ws + WS_KVQS) - (size_t)MP * 1024, (bf16*)(ws + WS_KVQS + 2 * MiB) - (size_t)MP * 1024, (bf16*)(ws + WS_KVQS + 4 * MiB) - (size_t)MP * 1024, DKS + (size_t)u * KVS, OB, lds, tid, lane, wave);
                }
            }
            GSYNC();
            for (int rep_ = 0; rep_ < NREP(8); ++rep_) { if (rep_) GSYNC(); PHASE_ENTER();
                pg8::Gemm g{OB, WOT, MT, 1024, 1024, 1024, 0}; pg8::StaticOrder S; S.init(MP, 1024, G, vcu);
                pg8::EpiRes<true, true, false> E{out, out + (size_t)MP * 1024, out, XB, SSQ, nullptr};
                pg8::gemm_phase<pg8::EpiRes<true, true, false>, pg8::StaticOrder, PG_ALIGN, true>(lds, g, S, E);
            }
            GSYNC();
        }
#define SROLE_NB(v) ((v) < 16 ? 0 : (v) < 104 ? 2 : (v) < 120 ? 5 : ((v) < 172 && l == 0) ? 9 : 0)
        {
            PHASE_ENTER();
            pg8::Gemm g{XB, (bf16*)(ws + (l ? WS_WGU1 : WS_WGU0)), MT, 5632, 1024, 1024, 0}; pg8::StaticOrder base; base.init(MP, 5632, G, vcu);
            pg8::EpiGU E{SSQ, ACT};
            pg8::RangeOrder S{base, 0, SROLE_NB(vcu), -1, 0};
            pg8::gemm_phase<pg8::EpiGU, pg8::RangeOrder, PG_ALIGN, true>(lds, g, S, E);
        }
        if (vcu < 120 || (vcu < 172 && l == 0)) {
            PHASE_ENTER();
            int role, sidx;
            if (vcu < 16) { role = 1; sidx = vcu; } else if (vcu < 104) { role = 2; sidx = vcu - 16; } else if (vcu < 120) { role = 3; sidx = vcu - 104; } else { role = 4; sidx = vcu - 120; }
            unsigned* cnt = (unsigned*)(ws + WS_CTL + 32768) + l * 256;
            if (role > 1) {
                if (tid == 0) { const unsigned need = role == 3 ? 88u : 16u; unsigned sp = 0;
                    while (__hip_atomic_load(cnt + 64 * (role - 2), __ATOMIC_RELAXED, __HIP_MEMORY_SCOPE_AGENT) < need && ++sp < (1u << 22)) __builtin_amdgcn_s_sleep(2);
                    __builtin_amdgcn_fence(__ATOMIC_ACQUIRE, "agent"); asm volatile("s_waitcnt vmcnt(0)" ::: "memory"); }
                __syncthreads();
            }
            if (role == 1) {
                pg8::OneUnit S1{256 + (sidx >> 2), sidx & 3};
                if (l) { pg8::Gemm g2{OB, WOT, MT, 1024, 1024, 1024, 0}; pg8::EpiRes<true, true, false> E3{xp, xs, out, XB, SSQ, nullptr}; pg8::gemm_phase<pg8::EpiRes<true, true, false>, pg8::OneUnit, PG_ALIGN, true>(lds, g2, S1, E3); }
                else { pg8::Gemm g2{PB, WPOOL, MT, 1024, 256, 1024, 256}; pg8::EpiRes<true, false, false> E2{xp, xs, out, XB, SSQ, nullptr}; pg8::gemm_phase<pg8::EpiRes<true, false, false>, pg8::OneUnit, PG_ALIGN, true>(lds, g2, S1, E2); }
            } else if (role == 2) {
                pg8::Gemm g2{XB, (bf16*)(ws + (l ? WS_WGU1 : WS_WGU0)), MT, 5632, 1024, 1024, 0}; pg8::EpiGU E2{SSQ, ACT};
                pg8::OneUnit S1{256 + sidx / 22, sidx % 22};
                pg8::gemm_phase<pg8::EpiGU, pg8::OneUnit, PG_ALIGN, true>(lds, g2, S1, E2);
            } else if (role == 3) {
                pg8::Gemm g2{ACT, (bf16*)(ws + (l ? WS_WDN1 : WS_WDN0)), MT, 1024, 2816, 2816, 0}; pg8::OneUnit S1{256 + (sidx >> 2), sidx & 3};
                pg8::EpiRes<true, true, true> E2{out, out + (size_t)MP * 1024, out, XB, SSQ, nullptr};
                pg8::gemm_phase<pg8::EpiRes<true, true, true>, pg8::OneUnit, PG_ALIGN, true>(lds, g2, S1, E2);
            } else {
                pg8::Gemm g2{XB, WKVQ, MT, 3328, 1024, 1024, 0}; pg8::OneUnit S1{256 + sidx / 13, sidx % 13};
                pg8::EpiKVQ E2{SSQ, (const float*)(ws + WS_GN), a.in[I_BF], out, (bf16*)(ws + WS_KVQS) - (size_t)MP * 1024, (size_t)(2 * MiB / 2)};
                pg8::gemm_phase<pg8::EpiKVQ, pg8::OneUnit, PG_ALIGN, true>(lds, g2, S1, E2);
            }
            asm volatile("s_waitcnt vmcnt(0)" ::: "memory"); __syncthreads();
            if (tid == 0) { __builtin_amdgcn_fence(__ATOMIC_RELEASE, "agent"); asm volatile("s_waitcnt vmcnt(0)" ::: "memory");
                __hip_atomic_fetch_add(cnt + 64 * (role - 1), 1u, __ATOMIC_RELAXED, __HIP_MEMORY_SCOPE_AGENT); }
        }
        {
            PHASE_ENTER();
            pg8::Gemm g{XB, (bf16*)(ws + (l ? WS_WGU1 : WS_WGU0)), MT, 5632, 1024, 1024, 0}; pg8::StaticOrder base; base.init(MP, 5632, G, vcu);
            pg8::EpiGU E{SSQ, ACT};
            const bool dns = vcu >= 104 && vcu < 120, tk = vcu >= 172 && vcu < 188;
            pg8::RangeOrder S{base, SROLE_NB(vcu), dns ? 21 : 22, tk ? vcu - 172 + 104 : -1, 21};
            pg8::gemm_phase<pg8::EpiGU, pg8::RangeOrder, PG_ALIGN, true>(lds, g, S, E);
        }
#undef SROLE_NB
        GSYNC();
        for (int rep_ = 0; rep_ < NREP(4); ++rep_) { if (rep_) GSYNC(); PHASE_ENTER();
            pg8::Gemm g{ACT, (bf16*)(ws + (l ? WS_WDN1 : WS_WDN0)), MT, 1024, 2816, 2816, 0}; pg8::StaticOrder S; S.init(MP, 1024, G, vcu);
            if (l == 0) { pg8::EpiRes<true, true, false> E{out, out + (size_t)MP * 1024, out, XB, SSQ, nullptr}; pg8::gemm_phase<pg8::EpiRes<true, true, false>, pg8::StaticOrder, PG_ALIGN, true>(lds, g, S, E); }
            else { pg8::EpiRes<false, true, true> E{out, out + (size_t)MP * 1024, out, XB, nullptr, nullptr}; pg8::gemm_phase<pg8::EpiRes<false, true, true>, pg8::StaticOrder, PG_ALIGN, true>(lds, g, S, E); }
        }
        if (l == 0) GSYNC();
    }
}

extern "C" void kernel_launch(void* const* d_in, const int* in_sizes, int n_in, void* d_out, int out_size, void* d_ws, size_t ws_size, hipStream_t stream) {
    static int grid = 0;
    if (grid == 0) {
        if (n_in != 22 || (size_t)out_size != pg8::O_END || ws_size < WS_END) { fprintf(stderr, "kernel_launch: unexpected shapes: n_in %d out %d ws %zu (need %zu)\n", n_in, out_size, ws_size, (size_t)WS_END); grid = -1; return; }
        int dev = 0, cus = 0, per_cu = 0;
        (void)hipGetDevice(&dev); (void)hipDeviceGetAttribute(&cus, hipDeviceAttributeMultiprocessorCount, dev);
        if (hipFuncSetAttribute((const void*)mega, hipFuncAttributeMaxDynamicSharedMemorySize, LDS_BYTES) != hipSuccess) fprintf(stderr, "kernel_launch: hipFuncSetAttribute failed\n");
        if (hipOccupancyMaxActiveBlocksPerMultiprocessor(&per_cu, (const void*)mega, 512, LDS_BYTES) != hipSuccess || per_cu < 1) { fprintf(stderr, "kernel_launch: occupancy query says %d\n", per_cu); per_cu = 1; }
        (void)hipGetLastError();
        if (cus <= 0) cus = 256;
        grid = cus;
    }
    if (grid < 0) return;
    if (hipMemsetAsync((char*)d_ws + WS_CTL, 0, 65536, stream) != hipSuccess) { fprintf(stderr, "kernel_launch: memset failed\n"); return; }
    Args a{};
    for (int i = 0; i < 22; ++i) a.in[i] = (const float*)d_in[i];
    a.out = (float*)d_out; a.ws = (unsigned char*)d_ws;
    void* args[] = {&a};
    const hipError_t e = hipLaunchCooperativeKernel((const void*)mega, dim3(grid), dim3(512), args, LDS_BYTES, stream);
    if (e != hipSuccess) fprintf(stderr, "kernel_launch: cooperative launch failed: %s (grid %d)\n", hipGetErrorString(e), grid);
}
```

```cpp
#include <hip/hip_runtime.h>
#include <hip/hip_cooperative_groups.h>
#include <cstdio>
#include <cstdint>
namespace cg = cooperative_groups;
namespace pg8 {
#define PG8_LAS __attribute__((address_space(3)))
typedef unsigned short bf16_t;
typedef short bf16x8 __attribute__((ext_vector_type(8)));
typedef float f32x4 __attribute__((ext_vector_type(4)));
typedef unsigned u32x4 __attribute__((ext_vector_type(4)));
constexpr int BM = 256, BK = 64, HALF = 128, HTB = HALF * BK * 2  , STAGE_BYTES = 8 * HTB, NXCD = 8, WGM = 8;

__host__ __device__ __forceinline__ int lds_byte(int r, int c) { const int st = (r >> 4) * 2 + (c >> 5), rr = r & 15, cc = c & 31, ob = rr * 64 + cc * 2; return st * 1024 + (ob ^ (((ob >> 9) & 1) << 5)); }
__host__ __device__ __forceinline__ void stage_rc(int b, int& R, int& C) { const int st = b / 1024, sb = b % 1024, swz = sb ^ (((sb >> 9) & 1) << 5); R = (st >> 1) * 16 + swz / 64; C = (st & 1) * 32 + (swz % 64) / 2; }
__host__ __device__ __forceinline__ int perm32(int rho) { const int n = rho >> 4, i = rho & 15; return 8 * (i >> 2) + 4 * n + (i & 3); }

struct Unit { int pm, pn; };
struct Gemm { const bf16_t* A; const bf16_t* Bt; int M, N, K; int lda; int acol_pn; };

struct StaticOrder {
    int nM, nN, nwg, G, c;
    __host__ __device__ void init(int M, int N, int G_, int c_) { nM = M / BM; nN = N / BM; nwg = nM * nN; G = G_; c = c_; }
    __host__ __device__ bool next(int i, Unit& u) const {
        const long L = (long)i * G + c; if (L >= nwg) return false;
        int wgid = (int)L; { const int q = nwg / NXCD, r = nwg % NXCD, xcd = wgid % NXCD, off = wgid / NXCD; wgid = (xcd < r ? xcd * (q + 1) : r * (q + 1) + (xcd - r) * q) + off; }
        const int nig = WGM * nN, gid = wgid / nig, fm = gid * WGM, gsz = (nM - fm) < WGM ? (nM - fm) : WGM;
        u.pm = fm + ((wgid % nig) % gsz); u.pn = (wgid % nig) / gsz; return true;
    }
    __device__ __forceinline__ void a_ready(const Unit&) const {}
    __device__ __forceinline__ void done(const Unit&) const {}
};
__device__ __forceinline__ unsigned cvt_pk_bf16(float lo, float hi) { unsigned r; asm volatile("v_cvt_pk_bf16_f32 %0, %1, %2" : "=v"(r) : "v"(lo), "v"(hi)); return r; }
typedef float f32x2 __attribute__((ext_vector_type(2)));
typedef unsigned u32x2 __attribute__((ext_vector_type(2)));
constexpr int EMP = 65536;
constexpr size_t O_YP = 0, O_YS = 67108864, O_PSP = O_YS + 1048576, O_PSS = O_PSP + 245760, O_KP = O_PSS + 245760, O_VP = O_KP + 67108864,
                 O_LP = O_VP + 67108864, O_KS = O_LP + 1048576, O_VS = O_KS + 1048576, O_LS = O_VS + 1048576, O_END = O_LS + 16384;
__device__ __forceinline__ float rstd_from_ssq(const float* ssq, int row, int fq) {
    const f32x4 v = *(const f32x4*)(ssq + (size_t)row * 16 + fq * 4);
    float s = (v[0] + v[1]) + (v[2] + v[3]);
    s += __shfl_xor(s, 16); s += __shfl_xor(s, 32);
    return __builtin_amdgcn_rsqf(s * (1.0f / 1024.0f) + 1e-6f);
}
template <bool HAS_XB, bool SRC_BF16, bool WR_F32> struct EpiRes {
    static constexpr bool HAS_SCALE = false;
    static constexpr bool PERM = false, AFTER_DRAIN = false;
    const float* srcP; const float* srcS; float* dst; bf16_t* xb; float* ssq; const float* cscale;
    __device__ __forceinline__ void operator()(const f32x4 (&acc)[2][2][4][2], const Unit& u, int wr, int wc, int fr_in, int fq_in) const {
        int ln_ = threadIdx.x & 63; asm volatile("" : "+v"(ln_)); const int fr = ln_ & 15, fq = ln_ >> 4; (void)fr_in; (void)fq_in;
        const int col0 = u.pn * BM + wc * 32 + 4 * fq;
        f32x4 sc[2][2];
#pragma unroll
        for (int bj = 0; bj < 2; ++bj)
#pragma unroll
            for (int n = 0; n < 2; ++n) sc[bj][n] = HAS_SCALE ? *(const f32x4*)(cscale + col0 + bj * HALF + n * 16) : (f32x4){1.f, 1.f, 1.f, 1.f};
#pragma unroll
        for (int ai = 0; ai < 2; ++ai)
#pragma unroll
            for (int m = 0; m < 4; ++m) {
                const int row = u.pm * BM + ai * HALF + wr * 64 + m * 16 + fr;
                const float* src = (row < EMP ? srcP + (size_t)row * 1024 : srcS + (size_t)(row - EMP) * 1024) + col0;
                float* d = dst + (size_t)row * 1024 + col0;
                float ss = 0.f;
#pragma unroll
                for (int bj = 0; bj < 2; ++bj)
#pragma unroll
                    for (int n = 0; n < 2; ++n) {
                        f32x4 v = acc[ai][bj][m][n]; if (HAS_SCALE) v = v * sc[bj][n];
                        f32x4 x;
                        if (SRC_BF16) { const u32x2 rb = *(const u32x2*)(xb + (size_t)row * 1024 + col0 + bj * HALF + n * 16);
                            x = (f32x4){__uint_as_float(rb.x << 16), __uint_as_float(rb.x & 0xffff0000u), __uint_as_float(rb.y << 16), __uint_as_float(rb.y & 0xffff0000u)} + v; }
                        else x = *(const f32x4*)(src + bj * HALF + n * 16) + v;
                        if (WR_F32) *(f32x4*)(d + bj * HALF + n * 16) = x;
                        if (HAS_XB) { u32x2 w; w.x = cvt_pk_bf16(x[0], x[1]); w.y = cvt_pk_bf16(x[2], x[3]); *(u32x2*)(xb + (size_t)row * 1024 + col0 + bj * HALF + n * 16) = w;
                            ss += (x[0] * x[0] + x[1] * x[1]) + (x[2] * x[2] + x[3] * x[3]); }
                    }
                if (HAS_XB) { ss += __shfl_xor(ss, 16); ss += __shfl_xor(ss, 32); if (fq == 0) ssq[(size_t)row * 16 + u.pn * 4 + wc] = ss; }
            }
    }
};
struct EpiGU {
    static constexpr bool PERM = true, AFTER_DRAIN = false;
    const float* ssq; bf16_t* act;
    __device__ __forceinline__ void operator()(const f32x4 (&acc)[2][2][4][2], const Unit& u, int wr, int wc, int fr_in, int fq_in) const {
        int ln_ = threadIdx.x & 63; asm volatile("" : "+v"(ln_)); const int fr = ln_ & 15, fq = ln_ >> 4; (void)fr_in; (void)fq_in;
        const int col = u.pn * 128 + wc * 32 + 8 * fq;
#pragma unroll
        for (int ai = 0; ai < 2; ++ai)
#pragma unroll
            for (int m = 0; m < 4; ++m) {
                const int row = u.pm * BM + ai * HALF + wr * 64 + m * 16 + fr;
                const float r = rstd_from_ssq(ssq, row, fq);
                u32x4 w;
#pragma unroll
                for (int n = 0; n < 2; ++n) {
                    const f32x4 g = acc[ai][0][m][n] * r, up = acc[ai][1][m][n] * r; float hh[4];
#pragma unroll
                    for (int e = 0; e < 4; ++e) hh[e] = g[e] * __builtin_amdgcn_rcpf(1.0f + __builtin_amdgcn_exp2f(-1.4426950408889634f * g[e])) * up[e];
                    w[2 * n] = cvt_pk_bf16(hh[0], hh[1]); w[2 * n + 1] = cvt_pk_bf16(hh[2], hh[3]);
                }
                *(u32x4*)(act + (size_t)row * 2816 + col) = w;
            }
    }
};
struct EpiKVQ {
    static constexpr bool PERM = true, AFTER_DRAIN = false;
    const float* ssq; const float* gn; const float* bfp; float* out; bf16_t* kvq; size_t kvq_stride;
    __device__ __forceinline__ void operator()(const f32x4 (&acc)[2][2][4][2], const Unit& u, int wr, int wc, int fr_in, int fq_in) const {
        int ln_ = threadIdx.x & 63; asm volatile("" : "+v"(ln_)); const int fr = ln_ & 15, fq = ln_ >> 4; (void)fr_in; (void)fq_in;
        const int t = u.pn >> 2, j = u.pn & 3;
        if (t == 3) {
            if (wc != 0) return;
            const int h0 = 8 * (fq & 1);
            const f32x4 b0 = *(const f32x4*)(bfp + h0), b1 = *(const f32x4*)(bfp + h0 + 4);
#pragma unroll
            for (int ai = 0; ai < 2; ++ai)
#pragma unroll
                for (int m = 0; m < 4; ++m) {
                    const int row = u.pm * BM + ai * HALF + wr * 64 + m * 16 + fr;
                    const float r = rstd_from_ssq(ssq, row, fq);
                    if (fq < 2) {
                        float* o = (row < EMP ? out + O_LP + (size_t)row * 16 : out + O_LS + (size_t)(row - EMP) * 16) + h0;
#pragma unroll
                        for (int n = 0; n < 2; ++n) { const f32x4 z = acc[ai][0][m][n] * r + (n == 0 ? b0 : b1); f32x4 lf;
#pragma unroll
                            for (int e = 0; e < 4; ++e) lf[e] = fminf(z[e], 0.f) - 0.6931471805599453f * __builtin_amdgcn_logf(1.0f + __builtin_amdgcn_exp2f(-1.4426950408889634f * fabsf(z[e])));
                            *(f32x4*)(o + 4 * n) = lf; }
                    }
                }
            return;
        }
        f32x4 gain[2][2];
#pragma unroll
        for (int bj = 0; bj < 2; ++bj)
#pragma unroll
            for (int n = 0; n < 2; ++n) gain[bj][n] = *(const f32x4*)(gn + 64 * t + 32 * bj + 8 * fq + 4 * n);
        const int cl = 256 * j + 64 * wc + 8 * fq;
        bf16_t* const ob0 = kvq + (size_t)t * kvq_stride;
#pragma unroll
        for (int ai = 0; ai < 2; ++ai)
#pragma unroll
            for (int m = 0; m < 4; ++m) {
                const int row = u.pm * BM + ai * HALF + wr * 64 + m * 16 + fr;
                const float r = rstd_from_ssq(ssq, row, fq);
                f32x4 v[2][2]; float ss = 0.f;
#pragma unroll
                for (int bj = 0; bj < 2; ++bj)
#pragma unroll
                    for (int n = 0; n < 2; ++n) { v[bj][n] = acc[ai][bj][m][n] * r; const f32x4 x = v[bj][n]; ss += (x[0] * x[0] + x[1] * x[1]) + (x[2] * x[2] + x[3] * x[3]); }
                if (t != 1) { ss += __shfl_xor(ss, 16); ss += __shfl_xor(ss, 32); const float rn = __builtin_amdgcn_rsqf(ss * (1.0f / 64.0f) + 1e-6f);
#pragma unroll
                    for (int bj = 0; bj < 2; ++bj)
#pragma unroll
                        for (int n = 0; n < 2; ++n) v[bj][n] = v[bj][n] * rn * gain[bj][n]; }
                if (t < 2) { float* o = (row < EMP ? out + (t == 0 ? O_KP : O_VP) + (size_t)row * 1024 : out + (t == 0 ? O_KS : O_VS) + (size_t)(row - EMP) * 1024) + cl;
#pragma unroll
                    for (int bj = 0; bj < 2; ++bj) { *(f32x4*)(o + 32 * bj) = v[bj][0]; *(f32x4*)(o + 32 * bj + 4) = v[bj][1]; } }
                bf16_t* ob = ob0 + (size_t)row * 1024 + cl;
#pragma unroll
                for (int bj = 0; bj < 2; ++bj) { u32x4 w; w.x = cvt_pk_bf16(v[bj][0][0], v[bj][0][1]); w.y = cvt_pk_bf16(v[bj][0][2], v[bj][0][3]); w.z = cvt_pk_bf16(v[bj][1][0], v[bj][1][1]); w.w = cvt_pk_bf16(v[bj][1][2], v[bj][1][3]);
                    *(u32x4*)(ob + 32 * bj) = w; }
            }
    }
};

struct RangeOrder {
    StaticOrder b; int i0, i1; int xc, xi;
    __device__ __forceinline__ bool next(int i, Unit& u) const {
        if (i0 + i < i1) return b.next(i0 + i, u);
        if (xc >= 0 && i0 + i == i1) { StaticOrder b2 = b; b2.c = xc; return b2.next(xi, u); }
        return false; }
    __device__ __forceinline__ void a_ready(const Unit&) const {}
    __device__ __forceinline__ void done(const Unit&) const {}
};
struct OneUnit {
    int pm, pn;
    __device__ __forceinline__ bool next(int i, Unit& u) const { if (i != 0) return false; u.pm = pm; u.pn = pn; return true; }
    __device__ __forceinline__ void a_ready(const Unit&) const {}
    __device__ __forceinline__ void done(const Unit&) const {}
};
template <class Epi, class Sched, bool ALIGN_EPI = false, bool SP2 = false>
__device__ __forceinline__ void gemm_phase(PG8_LAS unsigned char* lds, const Gemm g, const Sched& S, const Epi& E) {
    int tid_o = threadIdx.x; asm volatile("" : "+v"(tid_o)); const int tid = tid_o, wid = __builtin_amdgcn_readfirstlane(tid >> 6), lane = tid & 63, wr = wid >> 2, wc = wid & 3, fr = lane & 15, fq = lane >> 4;
    const int K = g.K, nt = K / BK;
    unsigned voffA[2], voffB[2];
#pragma unroll
    for (int i = 0; i < 2; ++i) { int R, C; stage_rc(tid * 16 + i * 8192, R, C); const int Rb = Epi::PERM ? ((R & ~31) + perm32(R & 31)) : R;
        voffA[i] = (unsigned)(R * g.lda + C) * 2u; voffB[i] = (unsigned)(Rb * K + C) * 2u; }
    const size_t kstep = (size_t)(BK * 2);
    const size_t hstepB = (size_t)HALF * K * 2, hstepA = (size_t)HALF * g.lda * 2;
    const size_t tstepB = 2 * hstepB, tstepA = 2 * hstepA;
    const unsigned ldsw = (unsigned)wid * 1024u;
    const int aoff = lds_byte(wr * 64 + fr, fq * 8), boff = lds_byte(wc * 32 + fr, fq * 8);
#define PG8_SA(b, h) (((b) * 2 + (h)) * HTB)
#define PG8_SB(b, h) ((4 + (b) * 2 + (h)) * HTB)
#define PG8_STAGE(bufoff, gbase, voff) do { _Pragma("unroll") for (int _i = 0; _i < 2; ++_i) \
        __builtin_amdgcn_global_load_lds((const unsigned*)((const char*)(gbase) + (voff)[_i]), (PG8_LAS unsigned*)(lds + (bufoff) + ldsw + _i * 8192), 16, 0, 0); } while (0)
#define PG8_LDA(dst, b, h) do { _Pragma("unroll") for (int m = 0; m < 4; ++m) _Pragma("unroll") for (int k = 0; k < 2; ++k) dst[m][k] = *(const PG8_LAS bf16x8*)(lds + PG8_SA(b, h) + aoff + m * 2048 + k * 1024); } while (0)
#define PG8_LDB(dst, b, h) do { _Pragma("unroll") for (int n = 0; n < 2; ++n) _Pragma("unroll") for (int k = 0; k < 2; ++k) dst[n][k] = *(const PG8_LAS bf16x8*)(lds + PG8_SB(b, h) + boff + n * 2048 + k * 1024); } while (0)
#define PG8_MMA(ai, bj, At, Bt) do { __builtin_amdgcn_s_setprio(1); _Pragma("unroll") for (int m = 0; m < 4; ++m) _Pragma("unroll") for (int n = 0; n < 2; ++n) _Pragma("unroll") for (int k = 0; k < 2; ++k) \
        acc[ai][bj][m][n] = __builtin_amdgcn_mfma_f32_16x16x32_bf16(Bt[n][k], At[m][k], acc[ai][bj][m][n], 0, 0, 0); __builtin_amdgcn_s_setprio(0); } while (0)
#define PG8_WAIT_V(n) asm volatile("s_waitcnt vmcnt(" #n ")" ::: "memory")
#define PG8_WAIT_L(n) asm volatile("s_waitcnt lgkmcnt(" #n ")" ::: "memory")
#define PG8_BAR __builtin_amdgcn_s_barrier()
#define PG8_SCHED __builtin_amdgcn_sched_barrier(0)
    Unit cur, nxt; int ui = 0;
    if (!S.next(0, cur)) return;
    f32x4 acc[2][2][4][2];
#pragma unroll
    for (int a = 0; a < 2; ++a)
#pragma unroll
        for (int b = 0; b < 2; ++b)
#pragma unroll
            for (int m = 0; m < 4; ++m)
#pragma unroll
                for (int n = 0; n < 2; ++n) acc[a][b][m][n] = (f32x4){0.f, 0.f, 0.f, 0.f};
    bf16x8 At[4][2], B0[2][2], B1[2][2];
    const char* cA = (const char*)g.A + (size_t)cur.pm * tstepA + (size_t)cur.pn * g.acol_pn * 2; const char* cB = (const char*)g.Bt + (size_t)cur.pn * tstepB;
    S.a_ready(cur);
    if constexpr (SP2) {
        PG8_STAGE(PG8_SB(0, 0), cB, voffB); PG8_STAGE(PG8_SB(0, 1), cB + hstepB, voffB); PG8_STAGE(PG8_SA(0, 0), cA, voffA); PG8_STAGE(PG8_SA(0, 1), cA + hstepA, voffA);
        if (wr == 1) PG8_BAR;
        PG8_WAIT_V(2); PG8_BAR;
        PG8_STAGE(PG8_SB(1, 0), cB + kstep, voffB); PG8_STAGE(PG8_SA(1, 0), cA + kstep, voffA); PG8_STAGE(PG8_SB(1, 1), cB + hstepB + kstep, voffB);
        PG8_WAIT_V(6); PG8_BAR;
    } else {
        PG8_STAGE(PG8_SB(0, 0), cB, voffB); PG8_STAGE(PG8_SA(0, 0), cA, voffA); PG8_STAGE(PG8_SB(0, 1), cB + hstepB, voffB); PG8_STAGE(PG8_SA(0, 1), cA + hstepA, voffA);
        if (wr == 1) PG8_BAR;
        PG8_WAIT_V(4); PG8_BAR;
        PG8_STAGE(PG8_SB(1, 0), cB + kstep, voffB); PG8_STAGE(PG8_SA(1, 0), cA + kstep, voffA); PG8_STAGE(PG8_SB(1, 1), cB + hstepB + kstep, voffB);
        PG8_WAIT_V(6); PG8_BAR;
    }
    for (;;) {
        const bool has_next = S.next(ui + 1, nxt);
        const char* nA = has_next ? (const char*)g.A + (size_t)nxt.pm * tstepA + (size_t)nxt.pn * g.acol_pn * 2 : cA; const char* nB = has_next ? (const char*)g.Bt + (size_t)nxt.pn * tstepB : cB;
        for (int t = 0; t < nt; t += 2) {
            const bool last = (t == nt - 2);
            const char* a1 = cA + (size_t)(t + 1) * kstep;
            const char* a2 = last ? nA : cA + (size_t)(t + 2) * kstep; const char* b2 = last ? nB : cB + (size_t)(t + 2) * kstep;
            const char* a3 = a2 + kstep; const char* b3 = b2 + kstep;
            if (last && has_next) S.a_ready(nxt);
            if constexpr (SP2) {
            PG8_LDB(B0, 0, 0); PG8_LDB(B1, 0, 1); PG8_SCHED; PG8_LDA(At, 0, 0); PG8_STAGE(PG8_SA(1, 1), a1 + hstepA, voffA);
            PG8_WAIT_V(8); PG8_WAIT_L(0); PG8_BAR; PG8_MMA(0, 0, At, B0); PG8_MMA(0, 1, At, B1); PG8_BAR; PG8_SCHED;
            PG8_LDA(At, 0, 1); PG8_STAGE(PG8_SB(0, 0), b2, voffB); PG8_STAGE(PG8_SB(0, 1), b2 + hstepB, voffB); PG8_STAGE(PG8_SA(0, 0), a2, voffA);
            PG8_WAIT_V(8); PG8_WAIT_L(0); PG8_BAR; PG8_MMA(1, 0, At, B0); PG8_MMA(1, 1, At, B1); PG8_BAR; PG8_SCHED;
            PG8_LDB(B0, 1, 0); PG8_LDB(B1, 1, 1); PG8_SCHED; PG8_LDA(At, 1, 0); PG8_STAGE(PG8_SA(0, 1), a2 + hstepA, voffA);
            PG8_WAIT_V(8); PG8_WAIT_L(0); PG8_BAR; PG8_MMA(0, 0, At, B0); PG8_MMA(0, 1, At, B1); PG8_BAR; PG8_SCHED;
            PG8_LDA(At, 1, 1); PG8_STAGE(PG8_SB(1, 0), b3, voffB); PG8_STAGE(PG8_SB(1, 1), b3 + hstepB, voffB); PG8_STAGE(PG8_SA(1, 0), a3, voffA);
            PG8_WAIT_V(8); PG8_WAIT_L(0); PG8_BAR; PG8_MMA(1, 0, At, B0); PG8_MMA(1, 1, At, B1); PG8_BAR; PG8_SCHED;
            } else {
            PG8_LDB(B0, 0, 0); PG8_SCHED; PG8_LDA(At, 0, 0); PG8_STAGE(PG8_SA(1, 1), a1 + hstepA, voffA);
            PG8_WAIT_L(8); PG8_BAR; PG8_WAIT_L(0); PG8_MMA(0, 0, At, B0); PG8_BAR; PG8_SCHED;
            PG8_LDB(B1, 0, 1); PG8_STAGE(PG8_SB(0, 0), b2, voffB);
            PG8_BAR; PG8_WAIT_L(0); PG8_MMA(0, 1, At, B1); PG8_BAR;
            PG8_LDA(At, 0, 1); PG8_STAGE(PG8_SA(0, 0), a2, voffA);
            PG8_BAR; PG8_WAIT_L(0); PG8_MMA(1, 0, At, B0); PG8_BAR; PG8_SCHED;
            PG8_STAGE(PG8_SB(0, 1), b2 + hstepB, voffB);
            PG8_WAIT_V(6); PG8_BAR; PG8_MMA(1, 1, At, B1); PG8_BAR;
            PG8_LDB(B0, 1, 0); PG8_SCHED; PG8_LDA(At, 1, 0); PG8_STAGE(PG8_SA(0, 1), a2 + hstepA, voffA);
            PG8_WAIT_L(8); PG8_BAR; PG8_WAIT_L(0); PG8_MMA(0, 0, At, B0); PG8_BAR; PG8_SCHED;
            PG8_LDB(B1, 1, 1); PG8_STAGE(PG8_SB(1, 0), b3, voffB);
            PG8_BAR; PG8_WAIT_L(0); PG8_MMA(0, 1, At, B1); PG8_BAR;
            PG8_LDA(At, 1, 1); PG8_STAGE(PG8_SA(1, 0), a3, voffA);
            PG8_BAR; PG8_WAIT_L(0); PG8_MMA(1, 0, At, B0); PG8_BAR; PG8_SCHED;
            PG8_STAGE(PG8_SB(1, 1), b3 + hstepB, voffB);
            PG8_WAIT_V(6); PG8_BAR; PG8_MMA(1, 1, At, B1); PG8_BAR;
            }
        }
        if constexpr (ALIGN_EPI) { if (wr == 0) PG8_BAR; }
        if constexpr (!Epi::AFTER_DRAIN) { E(acc, cur, wr, wc, fr, fq); S.done(cur); }
        if (!has_next) break;
#pragma unroll
        for (int a = 0; a < 2; ++a)
#pragma unroll
            for (int b = 0; b < 2; ++b)
#pragma unroll
                for (int m = 0; m < 4; ++m)
#pragma unroll
                    for (int n = 0; n < 2; ++n) acc[a][b][m][n] = (f32x4){0.f, 0.f, 0.f, 0.f};
        cur = nxt; cA = nA; cB = nB; ++ui;
        if constexpr (ALIGN_EPI) { if (wr == 1) PG8_BAR; }
    }
    PG8_WAIT_V(0);
    if constexpr (!ALIGN_EPI) { if (wr == 0) PG8_BAR; }
    PG8_BAR;
    if constexpr (Epi::AFTER_DRAIN) { E.fused(acc, cur, wr, wc, fr, fq, lds, wid, lane); S.done(cur); }
#undef PG8_SA
#undef PG8_SB
#undef PG8_STAGE
#undef PG8_LDA
#undef PG8_LDB
#undef PG8_MMA
#undef PG8_WAIT_V
#undef PG8_WAIT_L
#undef PG8_BAR
#undef PG8_SCHED
}
}

#include <hip/hip_bf16.h>
#include <cmath>
namespace attn_body {
using bf16=__hip_bfloat16;
using bf16x8=__attribute__((ext_vector_type(8)))short;
using s16x4=__attribute__((ext_vector_type(4)))short;
using f32x16=__attribute__((ext_vector_type(16)))float;
using u32x4=__attribute__((ext_vector_type(4)))unsigned;
using f32x4a=__attribute__((ext_vector_type(4)))float;
typedef __attribute__((address_space(3))) const float* lds_cfptr;
typedef __attribute__((address_space(3))) const f32x4a* lds_cf4ptr;
constexpr int BATCH=16,NHEAD=16,SEQ=4096,D=64,DM=NHEAD*D;
constexpr int NW=8,QBLK=32,QB=QBLK*NW,KVBLK=64,NQB=SEQ/QB;
constexpr int ATTN_PITCH=DM, ATTN_UNIT_ROWS=QB;
__device__ __forceinline__ int crow(int r,int hi){return (r&3)+8*(r>>2)+4*hi;}
#define SBAR() __builtin_amdgcn_sched_barrier(0)
__device__ __forceinline__ void cmask(f32x16&p0,f32x16&p1,int jb,int qrel,int hi){
  const float NEG=-INFINITY; int kb=64*jb+4*hi;
  #pragma unroll
  for(int r=0;r<16;++r){int kv=kb+(r&3)+8*(r>>2); if(kv>qrel)p0[r]=NEG; if(kv+32>qrel)p1[r]=NEG;}
}

constexpr int NSLOT=3, SLOTB=8192;
constexpr int LDS_K=0, LDS_V=NSLOT*SLOTB, LDS_WS=2*NSLOT*SLOTB, LDS_OST=LDS_WS+NW*64*4, LDS_BYTES=LDS_OST+NW*4096;
constexpr float C2=0.125f*1.4426950408889634f;
__device__ __forceinline__ void glds16(const void*gsrc,unsigned lds_dst){unsigned keep;
  asm volatile("s_mov_b32 %0, m0\n\ts_mov_b32 m0, %2\n\ts_nop 0\n\tglobal_load_lds_dwordx4 %1, off\n\ts_mov_b32 m0, %0":"=&s"(keep):"v"(gsrc),"s"(lds_dst):"memory");}
__device__ __forceinline__ float max3f(float a,float b,float c){float r;asm("v_max3_f32 %0, %1, %2, %3":"=v"(r):"v"(a),"v"(b),"v"(c));return r;}
__device__ __forceinline__ float max2f(float a,float b){float r;asm("v_max_f32_e32 %0, %1, %2":"=v"(r):"v"(a),"v"(b));return r;}
__device__ __forceinline__ float fadd_s(float a,float b){float r;asm("v_add_f32_e32 %0, %1, %2":"=v"(r):"v"(a),"v"(b));return r;}
__device__ __forceinline__ float fsub_s(float a,float b){float r;asm("v_sub_f32_e32 %0, %1, %2":"=v"(r):"v"(a),"v"(b));return r;}
typedef float f32x2_t __attribute__((ext_vector_type(2))); typedef __bf16 bf16x2_t __attribute__((ext_vector_type(2)));
__device__ __forceinline__ unsigned cvtpk_s(float lo,float hi){f32x2_t v={lo,hi};bf16x2_t b=__builtin_convertvector(v,bf16x2_t);return __builtin_bit_cast(unsigned,b);}
#define WAIT_BAR(N) asm volatile("s_waitcnt vmcnt(" #N ") lgkmcnt(0)\n\ts_barrier":::"memory")

__device__ __forceinline__ void qkt(f32x16&p0,f32x16&p1,const char*Kslot,const bf16x8*qr,int r32,int hi){
  const char*kb=Kslot+hi*1024+r32*16;
  #pragma unroll
  for(int d0=0;d0<4;++d0){
    const bf16x8 b0=*reinterpret_cast<const bf16x8*>(kb+d0*2048);
    const bf16x8 b1=*reinterpret_cast<const bf16x8*>(kb+d0*2048+512);
    {p0=__builtin_amdgcn_mfma_f32_32x32x16_bf16(b0,qr[d0],p0,0,0,0);p1=__builtin_amdgcn_mfma_f32_32x32x16_bf16(b1,qr[d0],p1,0,0,0);}}
}
typedef __attribute__((address_space(3))) const char* lds_cptr;
typedef short v4i16_t __attribute__((ext_vector_type(4)));
__device__ __forceinline__ void kload8(bf16x8*kf,lds_cptr kp){
  kf[0]=*(const __attribute__((address_space(3))) bf16x8*)(kp);      kf[1]=*(const __attribute__((address_space(3))) bf16x8*)(kp+512);
  kf[2]=*(const __attribute__((address_space(3))) bf16x8*)(kp+2048); kf[3]=*(const __attribute__((address_space(3))) bf16x8*)(kp+2560);
  kf[4]=*(const __attribute__((address_space(3))) bf16x8*)(kp+4096); kf[5]=*(const __attribute__((address_space(3))) bf16x8*)(kp+4608);
  kf[6]=*(const __attribute__((address_space(3))) bf16x8*)(kp+6144); kf[7]=*(const __attribute__((address_space(3))) bf16x8*)(kp+6656);
}
__device__ __forceinline__ void kload2(bf16x8*kf,lds_cptr kp,int j){ kf[2*j]=*(const __attribute__((address_space(3))) bf16x8*)(kp+j*2048); kf[2*j+1]=*(const __attribute__((address_space(3))) bf16x8*)(kp+j*2048+512); }
__device__ __forceinline__ s16x4 vtr(lds_cptr p){ return __builtin_bit_cast(s16x4,__builtin_amdgcn_ds_read_tr16_b64_v4i16((__attribute__((address_space(3))) v4i16_t*)p)); }
__device__ __forceinline__ float rowmax(const f32x16&p0,const f32x16&p1){
  float a=max3f(p0[0],p0[1],p1[0]),b=max3f(p0[2],p0[3],p1[1]);a=max3f(a,p1[2],p1[3]);
  #pragma unroll
  for(int r=4;r<16;r+=4){a=max3f(a,p0[r],p0[r+1]);b=max3f(b,p0[r+2],p0[r+3]);a=max3f(a,p1[r],p1[r+1]);b=max3f(b,p1[r+2],p1[r+3]);}
  const float m=max2f(a,b);
  auto rr=__builtin_amdgcn_permlane32_swap(__float_as_uint(m),__float_as_uint(m),false,false);
  return max2f(__uint_as_float(rr[0]),__uint_as_float(rr[1]));
}
__device__ __forceinline__ void pv(f32x16*o,int vb,bf16x8 pa0,bf16x8 pa1,bf16x8 pa2,bf16x8 pa3){
  #pragma unroll
  for(int d0=0;d0<2;++d0){s16x4 lo[4],hi[4];
    #pragma unroll
    for(int ks=0;ks<4;++ks){
      asm volatile("ds_read_b64_tr_b16 %0,%1 offset:%c2":"=&v"(lo[ks]):"v"(vb),"i"(d0*4096+ks*1024):"memory");
      asm volatile("ds_read_b64_tr_b16 %0,%1 offset:%c2":"=&v"(hi[ks]):"v"(vb),"i"(d0*4096+ks*1024+512):"memory");}
    asm volatile("s_waitcnt lgkmcnt(0)":::"memory");SBAR();
    #define PK(k) (bf16x8){lo[k][0],lo[k][1],lo[k][2],lo[k][3],hi[k][0],hi[k][1],hi[k][2],hi[k][3]}
    o[d0]=__builtin_amdgcn_mfma_f32_32x32x16_bf16(pa0,PK(0),o[d0],0,0,0);
    o[d0]=__builtin_amdgcn_mfma_f32_32x32x16_bf16(pa1,PK(1),o[d0],0,0,0);
    o[d0]=__builtin_amdgcn_mfma_f32_32x32x16_bf16(pa2,PK(2),o[d0],0,0,0);
    o[d0]=__builtin_amdgcn_mfma_f32_32x32x16_bf16(pa3,PK(3),o[d0],0,0,0);
    #undef PK
  }
}

#ifndef ATTN_STORE16
#define ATTN_STORE16(p,v) (*(u32x4*)(p)=(v))
#endif
template<int THRL> __device__ __forceinline__ void attn_unit(int b,int h,int qb,const bf16*Q,const bf16*__restrict__ K,const bf16*__restrict__ V,bf16*O,char*shm,lds_cfptr dkl,float lowc,int t0){
  int tid_o=threadIdx.x; asm volatile("":"+v"(tid_o)); const int tid=tid_o,lane=tid&63,r32=lane&31,hi=lane>>5; const int wid=__builtin_amdgcn_readfirstlane(tid>>6);
  const long rowbase=(long)b*SEQ; const int q0=qb*QB;
  const bf16*Qw=Q+(rowbase+q0+wid*QBLK)*DM+h*D;
  const bf16*Kh=K+(rowbase+(long)t0*KVBLK)*DM+h*D,*Vh=V+(rowbase+(long)t0*KVBLK)*DM+h*D;
  const unsigned lds0=(unsigned)(uintptr_t)shm;
  float*wsf=(float*)(shm+LDS_WS)+wid*64;
  const bf16*ksrc=Kh+(long)lane*DM+wid*8;
  const bf16*vsrc=Vh+(long)(16*(wid&3)+(lane>>2))*DM+(wid>>2)*32+(lane&3)*8;
  const unsigned kdst=lds0+LDS_K+wid*1024, vdst=lds0+LDS_V+wid*1024;
  #define DMA_K(t,slot) glds16(ksrc+(long)(t)*KVBLK*DM,(unsigned)__builtin_amdgcn_readfirstlane(kdst+(slot)))
  #define DMA_V(t,slot) glds16(vsrc+(long)(t)*KVBLK*DM,(unsigned)__builtin_amdgcn_readfirstlane(vdst+(slot)))
  const int vb0=(int)(lds0+LDS_V)+((lane>>4)&1)*32+(lane&3)*8+(4*hi+((lane&15)>>2))*64;
  const char*Kbase=shm+LDS_K; bf16x8 kf[8];
  const lds_cptr shm3=(lds_cptr)shm; const lds_cptr kp0=shm3+LDS_K+hi*1024+r32*16; const lds_cptr vp0=shm3+LDS_V+((lane>>4)&1)*32+(lane&3)*8+(4*hi+((lane&15)>>2))*64;
  const int NT=(q0+QB)/KVBLK-t0;
  DMA_K(0,0);DMA_V(0,0);DMA_K(1,SLOTB);
  bf16x8 qr[4];
  #pragma unroll
  for(int d0=0;d0<4;++d0)qr[d0]=*reinterpret_cast<const bf16x8*>(&Qw[(long)r32*DM+d0*16+hi*8]);
  const float dq2=dkl[q0+wid*QBLK+r32]; const lds_cf4ptr dk4=(lds_cf4ptr)dkl+16*t0;
  float mhat=-dq2,l_reg=0.f;f32x16 o[2];o[0]=f32x16{};o[1]=f32x16{};
  #define BINIT(P0,P1,t,NM) do{ const lds_cf4ptr d4_=dk4+16*(t)+hi; _Pragma("unroll") for(int j_=0;j_<4;++j_){ const f32x4a a_=d4_[2*j_], b_=d4_[8+2*j_]; _Pragma("unroll") for(int i_=0;i_<4;++i_){P0[4*j_+i_]=(NM)-a_[i_];P1[4*j_+i_]=(NM)-b_[i_];} } }while(0)
  #define BLOAD(P0,P1,t) do{ const lds_cf4ptr d4_=dk4+16*(t)+hi; _Pragma("unroll") for(int j_=0;j_<4;++j_){ const f32x4a a_=d4_[2*j_], b_=d4_[8+2*j_]; _Pragma("unroll") for(int i_=0;i_<4;++i_){P0[4*j_+i_]=a_[i_];P1[4*j_+i_]=b_[i_];} } }while(0)
  const int qrel=wid*QBLK+r32;
  #define CMASK(P0,P1,t) do{int jb_=(t)-(NT-4); if(jb_>=0)cmask(P0,P1,jb_,qrel,hi);}while(0)
  bool resc=false;
  #define START(P0,P1) do{ const float rm=rowmax(P0,P1); resc=false; \
    { const float dl=rm; mhat=fadd_s(mhat,dl); \
      _Pragma("unroll") for(int r=0;r<16;++r){P0[r]=fsub_s(P0[r],dl);P1[r]=fsub_s(P1[r],dl);} \
      } \
    _Pragma("unroll") for(int r=0;r<16;++r)P0[r]=__builtin_amdgcn_exp2f(P0[r]); }while(0)
  #define RESC() do{ if(resc){ asm volatile("s_waitcnt lgkmcnt(0)":::"memory"); \
      _Pragma("unroll") for(int d_=0;d_<2;++d_) _Pragma("unroll") for(int r=0;r<16;++r)o[d_][r]*=wsf[crow(r,hi)]; } }while(0)
  f32x16 pA0,pA1,pB0,pB1;
  int sl_prev=0,sl_cur=0,sl_next=SLOTB;
  #define ROT() do{sl_prev=sl_cur;sl_cur=sl_next;sl_next=(sl_next==(NSLOT-1)*SLOTB)?0:sl_next+SLOTB;}while(0)
  DMA_K(2,2*SLOTB);
  WAIT_BAR(3);
  BINIT(pA0,pA1,0,dq2);
  qkt(pA0,pA1,Kbase,qr,r32,hi);asm volatile("s_nop 15\n\ts_nop 7":"+v"(pA0),"+v"(pA1));CMASK(pA0,pA1,0);
  START(pA0,pA1);
  { const float nm0_=-mhat; BINIT(pB0,pB1,1,nm0_); }
  _Pragma("unroll") for(int r=0;r<16;++r)pA1[r]=__builtin_amdgcn_exp2f(pA1[r]);
  WAIT_BAR(0);
  DMA_K(3,0);DMA_V(1,SLOTB);
  ROT();
  kload8(kf,kp0+sl_cur);
  WAIT_BAR(2);
  s16x4 vlo[8],vhi[8]; u32x4 pw0,pw1,pw2,pw3;
  #define PKW(P,B) cvtpk_s(P[B],P[B+1])
  #define PAF(k) __builtin_bit_cast(bf16x8,pw##k)
  #define VFR(i) (bf16x8){vlo[i][0],vlo[i][1],vlo[i][2],vlo[i][3],vhi[i][0],vhi[i][1],vhi[i][2],vhi[i][3]}
  #define PIN(x) asm volatile("":"+v"(x))
  #define MX3(a,b,c) __builtin_fmaxf(__builtin_fmaxf((a),(b)),(c))
  #define GAPA(MF,A0,A1,A2,A3,W0,W1,PW) do{ MF; sacc+=A0; sacc+=A1; sacc+=A2; sacc+=A3; PIN(sacc); W0; W1; PIN(PW); SBAR(); }while(0)
  #define EX(v) __builtin_amdgcn_exp2f(v)
  #define GAPB(MF,X,B,G,PI) do{ MF; X[B]=EX(X[B]); X[B+1]=EX(X[B+1]); X[B+2]=EX(X[B+2]); X[B+3]=EX(X[B+3]); PIN(X); if(G){ PI[B]=nmh_-PI[B]; PI[B+1]=nmh_-PI[B+1]; PI[B+2]=nmh_-PI[B+2]; PI[B+3]=nmh_-PI[B+3]; PIN(PI); } SBAR(); }while(0)
  #define VRD(i) do{ vlo[i]=vtr(vp_+(((i)>>2)*4096+((i)&3)*1024)); vhi[i]=vtr(vp_+(((i)>>2)*4096+((i)&3)*1024+512)); }while(0)
  #define KRD(G,j) do{ if(G){ kload2(kf,kp0+sl_next,j); SBAR(); } }while(0)
  #define STEP(C0,C1,P0,P1,t,GK,GV,GL) do{ SBAR(); \
    const lds_cptr vp_=vp0+sl_prev; \
    VRD(0); SBAR(); float sacc=(P0[0]+P0[1]); \
    GAPA(C0=__builtin_amdgcn_mfma_f32_32x32x16_bf16(kf[0],qr[0],C0,0,0,0), P0[2],P0[3],P0[4],P0[5],     pw0[0]=PKW(P0,0), pw0[1]=PKW(P0,2), pw0); \
    VRD(4); SBAR(); GAPA(C1=__builtin_amdgcn_mfma_f32_32x32x16_bf16(kf[1],qr[0],C1,0,0,0), P0[6],P0[7],P0[8],P0[9],     pw0[2]=PKW(P0,4), pw0[3]=PKW(P0,6), pw0); \
    VRD(1); SBAR(); GAPA(C0=__builtin_amdgcn_mfma_f32_32x32x16_bf16(kf[2],qr[1],C0,0,0,0),   P0[10],P0[11],P0[12],P0[13], pw1[0]=PKW(P0,8), pw1[1]=PKW(P0,10), pw1); \
    VRD(5); SBAR(); GAPA(C1=__builtin_amdgcn_mfma_f32_32x32x16_bf16(kf[3],qr[1],C1,0,0,0),   P0[14],P0[15],P1[0],P1[1],   pw1[2]=PKW(P0,12),pw1[3]=PKW(P0,14), pw1); \
    VRD(2); SBAR(); GAPA(C0=__builtin_amdgcn_mfma_f32_32x32x16_bf16(kf[4],qr[2],C0,0,0,0),   P1[2],P1[3],P1[4],P1[5],     pw2[0]=PKW(P1,0), pw2[1]=PKW(P1,2), pw2); \
    VRD(6); SBAR(); GAPA(C1=__builtin_amdgcn_mfma_f32_32x32x16_bf16(kf[5],qr[2],C1,0,0,0),   P1[6],P1[7],P1[8],P1[9],     pw2[2]=PKW(P1,4), pw2[3]=PKW(P1,6), pw2); \
    VRD(3); SBAR(); GAPA(C0=__builtin_amdgcn_mfma_f32_32x32x16_bf16(kf[6],qr[3],C0,0,0,0),   P1[10],P1[11],P1[12],P1[13], pw3[0]=PKW(P1,8), pw3[1]=PKW(P1,10), pw3); \
    VRD(7); SBAR(); GAPA(C1=__builtin_amdgcn_mfma_f32_32x32x16_bf16(kf[7],qr[3],C1,0,0,0),   P1[14],P1[15],0.f,0.f,       pw3[2]=PKW(P1,12),pw3[3]=PKW(P1,14), pw3); \
    l_reg+=sacc; \
    if(GK){DMA_K((t)+3,sl_cur);} if(GV){DMA_V((t)+1,sl_next);} \
    CMASK(C0,C1,t); \
    { float a=MX3(C0[0],C0[1],C1[0]),b=MX3(C0[2],C0[3],C1[1]); a=MX3(a,C1[2],C1[3]); \
      _Pragma("unroll") for(int r=4;r<16;r+=4){a=MX3(a,C0[r],C0[r+1]);b=MX3(b,C0[r+2],C0[r+3]);a=MX3(a,C1[r],C1[r+1]);b=MX3(b,C1[r+2],C1[r+3]);} \
      float rm=__builtin_fmaxf(a,b); { auto rr=__builtin_amdgcn_permlane32_swap(__float_as_uint(rm),__float_as_uint(rm),false,false); rm=__builtin_fmaxf(__uint_as_float(rr[0]),__uint_as_float(rr[1])); } \
      resc=false; \
      if(__builtin_expect(__any(rm>(float)THRL),0)){ const float dl=__builtin_fmaxf(rm,0.f); mhat+=dl; \
        _Pragma("unroll") for(int r=0;r<16;++r){C0[r]-=dl;C1[r]-=dl;} \
        const float f=__builtin_amdgcn_exp2f(-dl); l_reg*=f; if(hi==0)wsf[r32]=f; resc=true; } } \
    const float nmh_=-mhat; if(GL){ BLOAD(P0,P1,(t)+1); } SBAR(); \
    GAPB(o[0]=__builtin_amdgcn_mfma_f32_32x32x16_bf16(PAF(0),VFR(0),o[0],0,0,0), C0,0,GL,P0); \
    GAPB(o[1]=__builtin_amdgcn_mfma_f32_32x32x16_bf16(PAF(0),VFR(4),o[1],0,0,0), C0,4,GL,P0); \
    KRD(GL,0); GAPB(o[0]=__builtin_amdgcn_mfma_f32_32x32x16_bf16(PAF(1),VFR(1),o[0],0,0,0), C0,8,GL,P0); \
    KRD(GL,1); GAPB(o[1]=__builtin_amdgcn_mfma_f32_32x32x16_bf16(PAF(1),VFR(5),o[1],0,0,0), C0,12,GL,P0); \
    KRD(GL,2); GAPB(o[0]=__builtin_amdgcn_mfma_f32_32x32x16_bf16(PAF(2),VFR(2),o[0],0,0,0), C1,0,GL,P1); \
    KRD(GL,3); GAPB(o[1]=__builtin_amdgcn_mfma_f32_32x32x16_bf16(PAF(2),VFR(6),o[1],0,0,0), C1,4,GL,P1); \
    GAPB(o[0]=__builtin_amdgcn_mfma_f32_32x32x16_bf16(PAF(3),VFR(3),o[0],0,0,0), C1,8,GL,P1); \
    GAPB(o[1]=__builtin_amdgcn_mfma_f32_32x32x16_bf16(PAF(3),VFR(7),o[1],0,0,0), C1,12,GL,P1); \
    }while(0)
  int t=1;
  #undef CMASK
  #define CMASK(P0,P1,t) do{}while(0)
  for(;t+5<NT;t+=2){
    STEP(pB0,pB1,pA0,pA1,t,true,true,true);     WAIT_BAR(2); RESC(); ROT();
    STEP(pA0,pA1,pB0,pB1,t+1,true,true,true);   WAIT_BAR(2); RESC(); ROT();
  }
  #undef CMASK
  #define CMASK(P0,P1,t) do{int jb_=(t)-(NT-4); if(jb_>=0)cmask(P0,P1,jb_,qrel,hi);}while(0)
  #define ENDW(tt) do{ if((tt)+3<NT){WAIT_BAR(2);} else if((tt)+2<NT){WAIT_BAR(1);} else {WAIT_BAR(0);} }while(0)
  for(;t+1<NT;t+=2){
    STEP(pB0,pB1,pA0,pA1,t,(t+3<NT),(t+1<NT),(t+1<NT));       ENDW(t);   RESC(); ROT();
    STEP(pA0,pA1,pB0,pB1,t+1,(t+4<NT),(t+2<NT),(t+2<NT));     ENDW(t+1); RESC(); ROT();
  }
  STEP(pB0,pB1,pA0,pA1,NT-1,false,false,false); RESC();
  { float sacc=pB0[0]+pB0[1]; _Pragma("unroll") for(int r=2;r<16;++r)sacc+=pB0[r]; _Pragma("unroll") for(int r=0;r<16;++r)sacc+=pB1[r]; l_reg+=sacc;
    pw0=(u32x4){PKW(pB0,0),PKW(pB0,2),PKW(pB0,4),PKW(pB0,6)};pw1=(u32x4){PKW(pB0,8),PKW(pB0,10),PKW(pB0,12),PKW(pB0,14)};pw2=(u32x4){PKW(pB1,0),PKW(pB1,2),PKW(pB1,4),PKW(pB1,6)};pw3=(u32x4){PKW(pB1,8),PKW(pB1,10),PKW(pB1,12),PKW(pB1,14)};
    SBAR(); pv(o,vb0+sl_cur,PAF(0),PAF(1),PAF(2),PAF(3)); }
  #undef PKW
  #undef PAF
  #undef VFR
  #undef PIN
  #undef MX3
  #undef GAPA
  #undef GAPB
  #undef EX
  #undef VRD
  #undef KRD
  #undef STEP
  #undef ENDW
  {auto rr=__builtin_amdgcn_permlane32_swap(__float_as_uint(l_reg),__float_as_uint(l_reg),false,false);l_reg=__uint_as_float(rr[0])+__uint_as_float(rr[1]);}
  if(hi==0)wsf[32+r32]=l_reg;asm volatile("s_waitcnt lgkmcnt(0)":::"memory");
  float rli[16];
  #pragma unroll
  for(int r=0;r<16;++r)rli[r]=__builtin_amdgcn_rcpf(wsf[32+crow(r,hi)]);
  bf16*Ow=O+(rowbase+q0+wid*QBLK)*DM+h*D;
  { bf16*stg=(bf16*)(shm+LDS_OST)+wid*2048;
    #pragma unroll
    for(int r=0;r<16;++r){const int orow=crow(r,hi);
      #pragma unroll
      for(int d0=0;d0<2;++d0)stg[orow*64+d0*32+r32]=__float2bfloat16(o[d0][r]*rli[r]);}
    asm volatile("s_waitcnt lgkmcnt(0)":::"memory");
    #pragma unroll
    for(int i=0;i<4;++i){const int row=i*8+(lane>>3),ch=lane&7; const u32x4 v=*(const u32x4*)(stg+row*64+ch*8); ATTN_STORE16(Ow+(long)row*DM+ch*8,v);} }
  asm volatile("s_waitcnt lgkmcnt(0)\n\ts_barrier":::"memory");
  #undef BINIT
  #undef BLOAD
  #undef DMA_K
  #undef DMA_V
  #undef CMASK
  #undef START
  #undef RESC
  #undef ROT
}
constexpr int ATTN_LDS_BYTES=LDS_BYTES;
#undef SBAR
#undef WAIT_BAR
}

#define LAS __attribute__((address_space(3)))
typedef unsigned short bf16;
typedef unsigned v4u __attribute__((ext_vector_type(4)));
typedef unsigned v2u __attribute__((ext_vector_type(2)));
typedef float f32x4 __attribute__((ext_vector_type(4)));
typedef float f32x16 __attribute__((ext_vector_type(16)));
typedef short bf16x8 __attribute__((ext_vector_type(8)));

constexpr int MP = 65536, MS = 1024, MT = MP + MS, DMODEL = 1024, FF = 2816, SEQL = 4096, PAST = 1024, SSQ_ = 64, KVS = PAST + SSQ_;
constexpr float LOG2E = 1.4426950408889634f;
constexpr size_t MiB = 1u << 20;
constexpr size_t WS_WPOOL = 0, WS_WGU0 = 1 * MiB, WS_WGU1 = 12 * MiB, WS_WDN0 = 23 * MiB, WS_WDN1 = 29 * MiB, WS_WKVQ = 35 * MiB, WS_WO = 42 * MiB,
                 WS_RSTD = 44 * MiB, WS_SSQ = 45 * MiB, WS_DK2 = 50 * MiB, WS_DKS = 54 * MiB, WS_XB = 64 * MiB, WS_PB = 194 * MiB, WS_R1 = 324 * MiB,
                 WS_KB = WS_R1, WS_VB = WS_R1 + 130 * MiB, WS_QB = WS_R1 + 260 * MiB, WS_GN = 56 * MiB, WS_CTL = 57 * MiB, WS_KVQS = 58 * MiB, WS_END = WS_R1 + 390 * MiB;
constexpr int LDS_BYTES = 147456;
constexpr int DK_OFF = 86016;
static_assert(attn_body::ATTN_LDS_BYTES <= DK_OFF && DK_OFF + 16384 <= LDS_BYTES && pg8::STAGE_BYTES <= LDS_BYTES, "LDS map");

__device__ __forceinline__ float wave_sum(float v) {
#pragma unroll
    for (int o = 1; o < 64; o <<= 1) v += __shfl_xor(v, o);
    return v;
}
__device__ __forceinline__ float wave_max(float v) {
#pragma unroll
    for (int o = 1; o < 64; o <<= 1) v = fmaxf(v, __shfl_xor(v, o));
    return v;
}
__device__ __forceinline__ unsigned pk2(float lo, float hi) { return pg8::cvt_pk_bf16(lo, hi); }
__device__ __forceinline__ float bf2f(unsigned short b) { return __uint_as_float((unsigned)b << 16); }
__device__ __forceinline__ int crow(int r, int hi) { return (r & 3) + 8 * (r >> 2) + 4 * hi; }

struct RmOff { int off; __device__ __forceinline__ int operator()(int n) const { return off + n; } };
struct RmGU  { int up;  __device__ __forceinline__ int operator()(int n) const { return 256 * (n >> 7) + (n & 127) + up * 128; } };
struct RmKVQ { int base; __device__ __forceinline__ int operator()(int n) const { const int l = n & 255; return base + (n & ~255) + 128 * ((l >> 5) & 1) + 32 * (l >> 6) + (l & 31); } };

template <class RowMap> __device__ __forceinline__ void transpose_item(const float* W, int K, int N, bf16* WT, const RowMap rm, const float* kgain, const float* nscale, LAS float* scr, int item, int lane) {
    const int nblk = N / 32, kb = item / nblk, nb = item % nblk, k0 = 64 * kb, n0 = 32 * nb;
    const float ns = nscale ? nscale[n0 + (lane & 31)] : 1.f;
#pragma unroll 8
    for (int i = 0; i < 32; ++i) { const int kk = 2 * i + (lane >> 5); float v = W[(size_t)(k0 + kk) * N + n0 + (lane & 31)] * ns; if (kgain) v *= kgain[k0 + kk]; scr[kk * 33 + (lane & 31)] = v; }
    asm volatile("s_waitcnt lgkmcnt(0)" ::: "memory");
    const int c = lane & 7;
#pragma unroll
    for (int j = 0; j < 4; ++j) { const int n = (lane >> 3) + 8 * j; const LAS float* s = scr + (8 * c) * 33 + n;
        v4u o; o.x = pk2(s[0 * 33], s[1 * 33]); o.y = pk2(s[2 * 33], s[3 * 33]); o.z = pk2(s[4 * 33], s[5 * 33]); o.w = pk2(s[6 * 33], s[7 * 33]);
        *(v4u*)(WT + (size_t)rm(n0 + n) * K + k0 + 8 * c) = o; }
    asm volatile("s_waitcnt lgkmcnt(0)" ::: "memory");
}

#define XB_TMO      128
#define XB_XCNT(j)  (256  + 64 * (j))
#define XB_XSUB(j)  (1280 + 64 * (j))
#define XB_XGEN(j)  (2304 + 64 * (j))
#define XB_TOP      3328
#define XB_TOPGEN   3392
#define XCD_BAR_WORDS 3456
#define XB_SPIN_CAP (1u << 18)

__device__ __forceinline__ unsigned xb_ld(unsigned* p)              { return __hip_atomic_load(p, __ATOMIC_RELAXED, __HIP_MEMORY_SCOPE_AGENT); }
__device__ __forceinline__ unsigned xb_add(unsigned* p, unsigned v) { return __hip_atomic_fetch_add(p, v, __ATOMIC_RELAXED, __HIP_MEMORY_SCOPE_AGENT); }
__device__ __forceinline__ unsigned xb_xcc_id() { return (unsigned)__builtin_amdgcn_s_getreg((3 << 11) | 20) & 0xFu; }
#define XB_SPIN(cond, bar) do { unsigned _sp = 0; while (cond) { __builtin_amdgcn_s_sleep(1); \
    if ((++_sp & 255u) == 0u) { if (xb_ld(&(bar)[XB_TMO])) break; if (_sp > XB_SPIN_CAP) { atomicAdd(&(bar)[XB_TMO], 1u); break; } } } } while (0)

struct XcdBarrier {
    unsigned* bar; unsigned x;
    volatile LAS unsigned* st;
};

__device__ __forceinline__ XcdBarrier xcd_barrier_post(unsigned* bar, volatile LAS unsigned* st) {
    XcdBarrier b; b.bar = bar; b.x = xb_xcc_id(); b.st = st;
    if (threadIdx.x == 0) (void)xb_add(&bar[XB_XCNT(b.x)], 1u);
    return b;
}
__device__ __forceinline__ void xcd_barrier_complete(unsigned* bar, unsigned x, unsigned& nloc, unsigned& nx) {
    const unsigned G = gridDim.x * gridDim.y * gridDim.z;
    unsigned sum, cnt, mine, sp = 0u;
    for (;;) {
        sum = 0u; cnt = 0u; mine = 0u;
#pragma unroll
        for (unsigned j = 0; j < 16; ++j) { const unsigned c = xb_ld(&bar[XB_XCNT(j)]); sum += c; cnt += (c > 0u) ? 1u : 0u; mine = (j == x) ? c : mine; }
        if (sum == G) break;
        __builtin_amdgcn_s_sleep(1);
        if ((++sp & 255u) == 0u) { if (xb_ld(&bar[XB_TMO])) break; if (sp > XB_SPIN_CAP) { atomicAdd(&bar[XB_TMO], 1u); break; } }
    }
    nloc = mine > 0u ? mine : 1u; nx = cnt > 0u ? cnt : 1u;
}

__device__ __forceinline__ void xcd_barrier(const XcdBarrier& b) {
    asm volatile("s_waitcnt vmcnt(0)" ::: "memory");
    __syncthreads();
    if (threadIdx.x == 0) {
        unsigned* bar = b.bar;
        __builtin_amdgcn_s_waitcnt(0);
        unsigned nloc = b.st[0], nx = b.st[1];
        if (nloc == 0u) { xcd_barrier_complete(bar, b.x, nloc, nx); b.st[0] = nloc; b.st[1] = nx; }
        const unsigned old = xb_add(&bar[XB_XSUB(b.x)], 1u);
        const unsigned gen = old / nloc;
        if (old + 1u == (gen + 1u) * nloc) {
            __builtin_amdgcn_fence(__ATOMIC_RELEASE, "agent");
            asm volatile("s_waitcnt vmcnt(0)" ::: "memory");
            const unsigned og = xb_add(&bar[XB_TOP], 1u);
            const unsigned tg = og / nx;
            if (og + 1u == (tg + 1u) * nx) xb_add(&bar[XB_TOPGEN], 1u);
            else XB_SPIN(xb_ld(&bar[XB_TOPGEN]) == tg, bar);
            __builtin_amdgcn_fence(__ATOMIC_ACQUIRE, "agent");
            xb_add(&bar[XB_XGEN(b.x)], 1u);
            asm volatile("s_waitcnt vmcnt(0)" ::: "memory");
        } else {
            XB_SPIN(xb_ld(&bar[XB_XGEN(b.x)]) == gen, bar);
            __builtin_amdgcn_fence(__ATOMIC_ACQUIRE, "agent");
            asm volatile("s_waitcnt vmcnt(0)" ::: "memory");
        }
    }
    __syncthreads();
}

struct Args { const float* in[22]; float* out; unsigned char* ws; };
enum { I_XP = 0, I_XS, I_SP, I_CK, I_CV, I_CL, I_GMIX, I_GFFN, I_PW, I_PS, I_GKV, I_WK, I_WV, I_WF, I_BF, I_GKN, I_WQ, I_GQN, I_WO, I_WG, I_WU, I_WD };

template <int W> __device__ __forceinline__ void pool_item(const float* xb_, const float* rstd, const float* sp_, int t0, bool smp, f32x4 gm, bf16* pb_, float* ps_, int pst) {
    f32x4 halo[W - 1], mn[16];
    if (t0 > 0) {
#pragma unroll
        for (int i = 0; i < W - 1; ++i) { const int t = t0 - (W - 1) + i; halo[i] = (*(const f32x4*)(xb_ + (size_t)t * 1024) * rstd[t]) * gm; }
    } else if (smp) {
#pragma unroll
        for (int i = 0; i < W - 1; ++i) halo[i] = *(const f32x4*)(sp_ + (size_t)(15 - (W - 1) + i) * 1024);
    } else {
#pragma unroll
        for (int i = 0; i < W - 1; ++i) halo[i] = (f32x4){0.f, 0.f, 0.f, 0.f};
    }
#pragma unroll
    for (int r = 0; r < 16; ++r) mn[r] = (*(const f32x4*)(xb_ + (size_t)(t0 + r) * 1024) * rstd[t0 + r]) * gm;
    f32x4 s = {0.f, 0.f, 0.f, 0.f};
#pragma unroll
    for (int i = 0; i < W - 1; ++i) s += halo[i];
#pragma unroll
    for (int r = 0; r < 16; ++r) {
        const int t = t0 + r; s += mn[r];
        const int cnt = (smp || t + 1 >= W) ? W : t + 1;
        const f32x4 p = s * (1.0f / (float)cnt) - mn[r];
        v2u pw; pw.x = pk2(p[0], p[1]); pw.y = pk2(p[2], p[3]);
        *(v2u*)(pb_ + (size_t)r * 1024) = pw;
        if (t >= pst) *(f32x4*)(ps_ + (size_t)(t - pst) * 1024) = mn[r];
        s -= (r - (W - 1) >= 0) ? mn[r - (W - 1) >= 0 ? r - (W - 1) : 0] : halo[r < W - 1 ? r : 0];
    }
}

template <int W> __device__ __forceinline__ void pool_step(const f32x4 (&prev)[16], const f32x4 (&mn)[16], int t0, bool smp, bf16* pb_, float* ps_, int pst) {
    f32x4 s = {0.f, 0.f, 0.f, 0.f};
#pragma unroll
    for (int i = 0; i < W - 1; ++i) s += prev[16 - (W - 1) + i];
#pragma unroll
    for (int r = 0; r < 16; ++r) {
        const int t = t0 + r; s += mn[r];
        const int cnt = (smp || t + 1 >= W) ? W : t + 1;
        const f32x4 p = s * (1.0f / (float)cnt) - mn[r];
        v2u pw; pw.x = pk2(p[0], p[1]); pw.y = pk2(p[2], p[3]);
        *(v2u*)(pb_ + (size_t)r * 1024) = pw;
        if (t >= pst) *(f32x4*)(ps_ + (size_t)(t - pst) * 1024) = mn[r];
        s -= (r - (W - 1) >= 0) ? mn[r - (W - 1) >= 0 ? r - (W - 1) : 0] : prev[(16 - (W - 1) + r) < 16 ? (16 - (W - 1) + r) : 0];
    }
}

__device__ __forceinline__ void sample_attn(int b, int h, const float* ck, const float* cv, const bf16* KB, const bf16* VB, const bf16* QB, const float* dks, bf16* OB,
                                            LAS unsigned char* lds, int tid, int lane, int wid) {
    constexpr int RS = 144;
    LAS unsigned char* Ks = lds; LAS unsigned char* Vs = lds + 128 * RS; LAS float* comb = (LAS float*)(lds + 2 * 128 * RS);
    const int r32 = lane & 31, hi = lane >> 5, qh = wid & 1, kg = wid >> 1;
    const int qrow = MP + b * 64 + qh * 32 + r32;
    bf16x8 qf[4];
#pragma unroll
    for (int d0 = 0; d0 < 4; ++d0) qf[d0] = *(const bf16x8*)(QB + (size_t)qrow * 1024 + h * 64 + d0 * 16 + hi * 8);
    const int qpos = PAST + qh * 32 + r32; const float dq2 = dks[qpos];
    float m = -1e30f, l = 0.f; f32x16 o0 = {}, o1 = {};
    const int kk = tid >> 2, dseg = (tid & 3) * 16;
    f32x4 kr[4], vr[4];
#define SA_LOAD(c) do { const int j_ = 128 * (c) + kk; \
        if (j_ < PAST) { const f32x4* pk_ = (const f32x4*)(ck + (((size_t)b * PAST + j_) * 16 + h) * 64 + dseg); const f32x4* pv_ = (const f32x4*)(cv + (((size_t)b * PAST + j_) * 16 + h) * 64 + dseg); \
            _Pragma("unroll") for (int i_ = 0; i_ < 4; ++i_) { kr[i_] = pk_[i_]; vr[i_] = pv_[i_]; } } \
        else if (j_ < KVS) { const v4u* pk_ = (const v4u*)(KB + (size_t)(MP + b * 64 + j_ - PAST) * 1024 + h * 64 + dseg); const v4u* pv_ = (const v4u*)(VB + (size_t)(MP + b * 64 + j_ - PAST) * 1024 + h * 64 + dseg); \
            _Pragma("unroll") for (int i_ = 0; i_ < 2; ++i_) { const v4u a_ = pk_[i_], c_ = pv_[i_]; \
                kr[2 * i_] = (f32x4){__uint_as_float(a_.x << 16), __uint_as_float(a_.x & 0xffff0000u), __uint_as_float(a_.y << 16), __uint_as_float(a_.y & 0xffff0000u)}; \
                kr[2 * i_ + 1] = (f32x4){__uint_as_float(a_.z << 16), __uint_as_float(a_.z & 0xffff0000u), __uint_as_float(a_.w << 16), __uint_as_float(a_.w & 0xffff0000u)}; \
                vr[2 * i_] = (f32x4){__uint_as_float(c_.x << 16), __uint_as_float(c_.x & 0xffff0000u), __uint_as_float(c_.y << 16), __uint_as_float(c_.y & 0xffff0000u)}; \
                vr[2 * i_ + 1] = (f32x4){__uint_as_float(c_.z << 16), __uint_as_float(c_.z & 0xffff0000u), __uint_as_float(c_.w << 16), __uint_as_float(c_.w & 0xffff0000u)}; } } \
        else { _Pragma("unroll") for (int i_ = 0; i_ < 4; ++i_) { kr[i_] = (f32x4){0.f, 0.f, 0.f, 0.f}; vr[i_] = (f32x4){0.f, 0.f, 0.f, 0.f}; } } } while (0)
    SA_LOAD(0);
    for (int c = 0; c < 9; ++c) {
        __syncthreads();
        {
            v4u a, bq;
            a.x = pk2(kr[0][0], kr[0][1]); a.y = pk2(kr[0][2], kr[0][3]); a.z = pk2(kr[1][0], kr[1][1]); a.w = pk2(kr[1][2], kr[1][3]);
            bq.x = pk2(kr[2][0], kr[2][1]); bq.y = pk2(kr[2][2], kr[2][3]); bq.z = pk2(kr[3][0], kr[3][1]); bq.w = pk2(kr[3][2], kr[3][3]);
            *(LAS v4u*)(Ks + kk * RS + dseg * 2) = a; *(LAS v4u*)(Ks + kk * RS + dseg * 2 + 16) = bq;
            a.x = pk2(vr[0][0], vr[0][1]); a.y = pk2(vr[0][2], vr[0][3]); a.z = pk2(vr[1][0], vr[1][1]); a.w = pk2(vr[1][2], vr[1][3]);
            bq.x = pk2(vr[2][0], vr[2][1]); bq.y = pk2(vr[2][2], vr[2][3]); bq.z = pk2(vr[3][0], vr[3][1]); bq.w = pk2(vr[3][2], vr[3][3]);
            *(LAS v4u*)(Vs + kk * RS + dseg * 2) = a; *(LAS v4u*)(Vs + kk * RS + dseg * 2 + 16) = bq;
        }
        __syncthreads();
        if (c + 1 < 9) SA_LOAD(c + 1);
        const int kvb = 128 * c + 32 * kg;
        if (kvb < KVS) {
            f32x16 s = {};
#pragma unroll
            for (int d0 = 0; d0 < 4; ++d0) { const bf16x8 kf = *(const LAS bf16x8*)(Ks + (32 * kg + r32) * RS + (d0 * 16 + hi * 8) * 2); s = __builtin_amdgcn_mfma_f32_32x32x16_bf16(kf, qf[d0], s, 0, 0, 0); }
            float mx = -1e30f;
#pragma unroll
            for (int jj = 0; jj < 4; ++jj) { const f32x4 dk = *(const f32x4*)(dks + kvb + 8 * jj + 4 * hi);
#pragma unroll
                for (int e = 0; e < 4; ++e) { const int kv = kvb + 8 * jj + 4 * hi + e; float x = s[4 * jj + e] + dq2 - dk[e]; x = (kv > qpos) ? -1e30f : x; s[4 * jj + e] = x; mx = fmaxf(mx, x); } }
            mx = fmaxf(mx, __shfl_xor(mx, 32));
            const float mn = fmaxf(m, mx), alpha = __builtin_amdgcn_exp2f(m - mn); m = mn;
            float ps = 0.f;
#pragma unroll
            for (int r = 0; r < 16; ++r) { s[r] = __builtin_amdgcn_exp2f(s[r] - mn); ps += s[r]; }
            l = l * alpha + ps; o0 = o0 * alpha; o1 = o1 * alpha;
#pragma unroll
            for (int ks = 0; ks < 2; ++ks) {
                v4u pw; pw.x = pk2(s[8 * ks], s[8 * ks + 1]); pw.y = pk2(s[8 * ks + 2], s[8 * ks + 3]); pw.z = pk2(s[8 * ks + 4], s[8 * ks + 5]); pw.w = pk2(s[8 * ks + 6], s[8 * ks + 7]);
                const bf16x8 pb = __builtin_bit_cast(bf16x8, pw);
#pragma unroll
                for (int dh = 0; dh < 2; ++dh) { bf16x8 va;
#pragma unroll
                    for (int i = 0; i < 8; ++i) va[i] = *(const LAS short*)(Vs + (32 * kg + crow(8 * ks + i, hi)) * RS + (dh * 32 + r32) * 2);
                    if (dh == 0) o0 = __builtin_amdgcn_mfma_f32_32x32x16_bf16(va, pb, o0, 0, 0, 0); else o1 = __builtin_amdgcn_mfma_f32_32x32x16_bf16(va, pb, o1, 0, 0, 0); }
            }
        }
    }
#undef SA_LOAD
    l += __shfl_xor(l, 32);
    LAS float* cw = comb + wid * (32 * 66) + r32 * 66;
#pragma unroll
    for (int r = 0; r < 16; ++r) { cw[crow(r, hi)] = o0[r]; cw[32 + crow(r, hi)] = o1[r]; }
    if (hi == 0) { cw[64] = m; cw[65] = l; }
    __syncthreads();
    {
        const int q64 = tid >> 3, d8 = (tid & 7) * 8, qh2 = q64 >> 5, ql = q64 & 31;
        float M = -1e30f;
#pragma unroll
        for (int g = 0; g < 4; ++g) M = fmaxf(M, comb[(g * 2 + qh2) * (32 * 66) + ql * 66 + 64]);
        float den = 0.f, a8[8];
#pragma unroll
        for (int e = 0; e < 8; ++e) a8[e] = 0.f;
#pragma unroll
        for (int g = 0; g < 4; ++g) { const LAS float* base = comb + (g * 2 + qh2) * (32 * 66) + ql * 66; const float w = __builtin_amdgcn_exp2f(base[64] - M); den += w * base[65];
#pragma unroll
            for (int e = 0; e < 8; ++e) a8[e] += w * base[d8 + e]; }
        const float inv = 1.0f / den;
        v4u w; w.x = pk2(a8[0] * inv, a8[1] * inv); w.y = pk2(a8[2] * inv, a8[3] * inv); w.z = pk2(a8[4] * inv, a8[5] * inv); w.w = pk2(a8[6] * inv, a8[7] * inv);
        *(v4u*)(OB + (size_t)(MP + b * 64 + q64) * 1024 + h * 64 + d8) = w;
    }
    __syncthreads();
}

#ifndef PG_ALIGN
#define PG_ALIGN true
#endif
#ifndef PH_MASK
#define PH_MASK 0xFFFF
#endif
#define RUN(p) (((PH_MASK) >> (p)) & 1)
#ifndef REP_MASK
#define REP_MASK 0
#endif
#define NREP(p) (1 + (((REP_MASK) >> (p)) & 1))

__global__ void __launch_bounds__(512, 2) mega(Args a) {
    extern __shared__ __attribute__((aligned(16))) unsigned char lds_raw[];
    cg::grid_group grid = cg::this_grid();
    LAS unsigned char* lds = (LAS unsigned char*)lds_raw;
    const int G = gridDim.x;
    int vcu;
    {
        LAS int* vs = (LAS int*)(lds_raw + LDS_BYTES - 16);
        if (threadIdx.x == 0) {
            unsigned* cen = (unsigned*)(a.ws + WS_CTL);
            const unsigned xcc = (unsigned)__builtin_amdgcn_s_getreg((3 << 11) | 20) & 7u;
            const unsigned rank = __hip_atomic_fetch_add(cen + 64 * xcc, 1u, __ATOMIC_RELAXED, __HIP_MEMORY_SCOPE_AGENT);
            vs[0] = (G == 256 && rank < 32u) ? (int)(xcc + 8u * rank) : -1;
        }
        __syncthreads();
        vcu = __builtin_amdgcn_readfirstlane(vs[0]);
        if (threadIdx.x == 0) { vs[1] = 0; vs[2] = 0; }
        __syncthreads();
    }
#define PHASE_ENTER() int tid_o = threadIdx.x; asm volatile("" : "+v"(tid_o)); const int tid = tid_o, lane = tid & 63, wave = __builtin_amdgcn_readfirstlane(tid >> 6); (void)lane; (void)wave; \
    int bx_o = blockIdx.x; asm volatile("" : "+s"(bx_o)); const int bx = bx_o; size_t zo_ = 0; asm volatile("" : "+s"(zo_)); unsigned char* ws = a.ws + zo_; float* out = a.out + zo_; \
    const float* xp = a.in[I_XP]; const float* xs = a.in[I_XS]; (void)xp; (void)xs; \
    bf16* WPOOL = (bf16*)(ws + WS_WPOOL); bf16* WKVQ = (bf16*)(ws + WS_WKVQ); bf16* WOT = (bf16*)(ws + WS_WO); \
    float* RSTD = (float*)(ws + WS_RSTD); float* SSQ = (float*)(ws + WS_SSQ); float* DK2 = (float*)(ws + WS_DK2); float* DKS = (float*)(ws + WS_DKS); \
    bf16* XB = (bf16*)(ws + WS_XB); bf16* PB = (bf16*)(ws + WS_PB); bf16* OB = PB; bf16* ACT = (bf16*)(ws + WS_R1); \
    bf16* QB = (bf16*)(ws + WS_QB); bf16* KB = (bf16*)(ws + WS_KB); bf16* VB = (bf16*)(ws + WS_VB); \
    (void)WPOOL; (void)WKVQ; (void)WOT; (void)RSTD; (void)SSQ; (void)DK2; (void)DKS; (void)XB; (void)PB; (void)OB; (void)ACT; (void)QB; (void)KB; (void)VB;
    (void)xcd_barrier_post((unsigned*)(a.ws + WS_CTL + 4096), (volatile LAS unsigned*)(lds_raw + LDS_BYTES - 12));
#define GSYNC() do { size_t zb_ = 0; asm volatile("" : "+s"(zb_)); XcdBarrier xb_; xb_.bar = (unsigned*)(a.ws + WS_CTL + 4096) + zb_; xb_.x = xb_xcc_id(); xb_.st = (volatile LAS unsigned*)(lds_raw + LDS_BYTES - 12); xcd_barrier(xb_); } while (0)
#define GSYNC0() do { asm volatile("s_waitcnt vmcnt(0)" ::: "memory"); grid.sync(); __builtin_amdgcn_fence(__ATOMIC_ACQUIRE, "agent"); asm volatile("s_waitcnt vmcnt(0)" ::: "memory"); } while (0)

    grid.sync();
    for (int rep_ = 0; rep_ < NREP(0); ++rep_) { if (rep_) GSYNC(); PHASE_ENTER();
        LAS float* scr = (LAS float*)(lds + wave * 16384);
        const int gw = bx * 8 + wave, NGW = G * 8;
        constexpr int I_POOL = 4 * 32, I_GU = 16 * 88, I_DN = 44 * 32, I_SQ = 16 * 32;
        constexpr int NITEMS = I_POOL + 4 * I_GU + 2 * I_DN + 4 * I_SQ;
        for (int it = gw; it < NITEMS; it += NGW) {
            int r = it;
            if (r < I_POOL) { const int mtx = r >> 5; transpose_item(a.in[I_PW] + (size_t)mtx * 65536, 256, 256, WPOOL, RmOff{mtx * 256}, nullptr, a.in[I_PS] + mtx * 256, scr, r & 31, lane); continue; } r -= I_POOL;
            if (r < 4 * I_GU) { const int mtx = r / I_GU, l = mtx >> 1, up = mtx & 1; transpose_item((up ? a.in[I_WU] : a.in[I_WG]) + (size_t)l * 1024 * 2816, 1024, 2816, (bf16*)(ws + (l ? WS_WGU1 : WS_WGU0)), RmGU{up}, a.in[I_GFFN] + l * 1024, nullptr, scr, r % I_GU, lane); continue; } r -= 4 * I_GU;
            if (r < 2 * I_DN) { const int l = r / I_DN; transpose_item(a.in[I_WD] + (size_t)l * 2816 * 1024, 2816, 1024, (bf16*)(ws + (l ? WS_WDN1 : WS_WDN0)), RmOff{0}, nullptr, nullptr, scr, r % I_DN, lane); continue; } r -= 2 * I_DN;
            if (r < I_SQ) { transpose_item(a.in[I_WK], 1024, 1024, WKVQ, RmKVQ{0}, a.in[I_GKV], nullptr, scr, r, lane); continue; } r -= I_SQ;
            if (r < I_SQ) { transpose_item(a.in[I_WV], 1024, 1024, WKVQ, RmKVQ{1024}, a.in[I_GKV], nullptr, scr, r, lane); continue; } r -= I_SQ;
            if (r < I_SQ) { transpose_item(a.in[I_WQ], 1024, 1024, WKVQ, RmKVQ{2048}, a.in[I_GMIX] + 1024, nullptr, scr, r, lane); continue; } r -= I_SQ;
            transpose_item(a.in[I_WO], 1024, 1024, WOT, RmOff{0}, nullptr, nullptr, scr, r, lane);
        }
        const int gt = bx * 512 + tid, NT = G * 512;
        for (int i = gt; i < 16 * 1024; i += NT) { const int n = i >> 10, k = i & 1023; WKVQ[(size_t)(3072 + n) * 1024 + k] = (bf16)(pk2(a.in[I_WF][k * 16 + n] * a.in[I_GKV][k], 0.f) & 0xffffu); }
        if (gt < 192) ((float*)(ws + WS_GN))[gt] = gt < 64 ? a.in[I_GKN][gt] : gt < 128 ? 1.0f : a.in[I_GQN][gt - 128] * (0.125f * LOG2E);
        for (int i = gt; i < 240 * 1024 / 8; i += NT) ((v4u*)(WKVQ + (size_t)3088 * 1024))[i] = (v4u){0u, 0u, 0u, 0u};
    }
    __syncthreads();

    for (int rep_ = 0; rep_ < NREP(1); ++rep_) { if (rep_) GSYNC(); PHASE_ENTER();
        const int half = tid >> 8, c4 = (tid & 255) * 4, grp = __builtin_amdgcn_readfirstlane(c4 >> 8), wq = (tid >> 6) & 3;
        const f32x4 gm = *(const f32x4*)(a.in[I_GMIX] + c4);
        LAS float* redb = (LAS float*)lds + half * 64; int par = 0;
        f32x4 prev[16], raw[16]; float rs[16];
#define P1_LOAD(src, t_first) do { _Pragma("unroll") for (int r_ = 0; r_ < 16; ++r_) raw[r_] = *(const f32x4*)((src) + (size_t)((t_first) + r_) * 1024); } while (0)
#define P1_RSTD(valid) do { float ss_[16]; \
            _Pragma("unroll") for (int r_ = 0; r_ < 16; ++r_) { const f32x4 v_ = raw[r_]; ss_[r_] = (valid) ? wave_sum((v_[0] * v_[0] + v_[1] * v_[1]) + (v_[2] * v_[2] + v_[3] * v_[3])) : 0.f; } \
            LAS float* red_ = redb + par * 128; par ^= 1; \
            if (lane == 0) { _Pragma("unroll") for (int r_ = 0; r_ < 16; r_ += 4) *(LAS f32x4*)(red_ + wq * 16 + r_) = (f32x4){ss_[r_], ss_[r_ + 1], ss_[r_ + 2], ss_[r_ + 3]}; } \
            __syncthreads(); \
            _Pragma("unroll") for (int r_ = 0; r_ < 16; ++r_) rs[r_] = __builtin_amdgcn_rsqf(((red_[r_] + red_[16 + r_]) + (red_[32 + r_] + red_[48 + r_])) * (1.0f / 1024.0f) + 1e-6f); } while (0)
#define P1_STEP(t0_, smp_, pb_, ps_, pst_) do { if (grp == 0) pool_step<2>(prev, raw, t0_, smp_, pb_, ps_, pst_); else if (grp == 1) pool_step<4>(prev, raw, t0_, smp_, pb_, ps_, pst_); \
            else if (grp == 2) pool_step<8>(prev, raw, t0_, smp_, pb_, ps_, pst_); else pool_step<16>(prev, raw, t0_, smp_, pb_, ps_, pst_); } while (0)
        for (int run = bx * 2 + half; run < 512; run += G * 2) {
            const int row0 = run * 128, b = row0 >> 12, tr = row0 & 4095;
            const float* xb_ = xp + (size_t)(row0 - tr) * 1024 + c4;
            float* ps_ = out + pg8::O_PSP + (size_t)b * 15 * 1024 + c4;
            if (tr > 0) P1_LOAD(xb_, tr - 16);
            P1_RSTD(tr > 0);
#pragma unroll
            for (int r = 0; r < 16; ++r) prev[r] = (tr > 0) ? (raw[r] * rs[r]) * gm : (f32x4){0.f, 0.f, 0.f, 0.f};
            for (int st = 0; st < 8; ++st) {
                const int t0 = tr + 16 * st;
                P1_LOAD(xb_, t0);
                P1_RSTD(true);
#pragma unroll
                for (int r = 0; r < 16; ++r) raw[r] = (raw[r] * rs[r]) * gm;
                P1_STEP(t0, false, PB + (size_t)(row0 + 16 * st) * 1024 + c4, ps_, 4081);
#pragma unroll
                for (int r = 0; r < 16; ++r) prev[r] = raw[r];
            }
        }
        for (int si = bx * 2 + half; si < 64; si += G * 2) {
            const int b = si >> 2, t0 = 16 * (si & 3);
            const float* xb_ = xs + (size_t)b * 64 * 1024 + c4;
            const float* sp_ = a.in[I_SP] + (size_t)b * 15 * 1024 + c4;
            if (t0 > 0) P1_LOAD(xb_, t0 - 16);
            P1_RSTD(t0 > 0);
            if (t0 > 0) {
#pragma unroll
                for (int r = 0; r < 16; ++r) prev[r] = (raw[r] * rs[r]) * gm;
            } else {
                prev[0] = (f32x4){0.f, 0.f, 0.f, 0.f};
#pragma unroll
                for (int r = 1; r < 16; ++r) prev[r] = *(const f32x4*)(sp_ + (size_t)(r - 1) * 1024);
            }
            P1_LOAD(xb_, t0);
            P1_RSTD(true);
#pragma unroll
            for (int r = 0; r < 16; ++r) raw[r] = (raw[r] * rs[r]) * gm;
            P1_STEP(t0, true, PB + (size_t)(MP + 16 * si) * 1024 + c4, out + pg8::O_PSS + (size_t)b * 15 * 1024 + c4, 49);
        }
#undef P1_LOAD
#undef P1_RSTD
#undef P1_STEP
    }
    GSYNC();
    {
        const unsigned* cen = (const unsigned*)(a.ws + WS_CTL); bool okc = (G == 256);
#pragma unroll
        for (int x = 0; x < 8; ++x) okc = okc && (__hip_atomic_load(cen + 64 * x, __ATOMIC_RELAXED, __HIP_MEMORY_SCOPE_AGENT) == 32u);
        if (!okc) vcu = blockIdx.x;
    }

    for (int rep_ = 0; rep_ < NREP(2); ++rep_) { if (rep_) GSYNC(); PHASE_ENTER();
        pg8::Gemm g{PB, WPOOL, MT, 1024, 256, 1024, 256}; pg8::StaticOrder S; S.init(MP, 1024, G, vcu);
        pg8::EpiRes<true, false, false> E{xp, xs, out, XB, SSQ, nullptr};
        pg8::gemm_phase<pg8::EpiRes<true, false, false>, pg8::StaticOrder, PG_ALIGN, true>(lds, g, S, E);
    }
    GSYNC();

    for (int l = 0; l < 2; ++l) {
        if (l == 1) {
            for (int rep_ = 0; rep_ < NREP(5); ++rep_) { if (rep_) GSYNC(); PHASE_ENTER();
                pg8::Gemm g{XB, WKVQ, MT, 3328, 1024, 1024, 0}; pg8::StaticOrder S; S.init(MP, 3328, G, vcu);
                pg8::EpiKVQ E{SSQ, (const float*)(ws + WS_GN), a.in[I_BF], out, KB, (size_t)(130 * MiB / 2)};
                pg8::gemm_phase<pg8::EpiKVQ, pg8::StaticOrder, PG_ALIGN, true>(lds, g, S, E);
            }
            GSYNC();
            for (int rep_ = 0; rep_ < NREP(7); ++rep_) { if (rep_) GSYNC(); PHASE_ENTER();
                const float mq = wave_max(fabsf(a.in[I_GQN][lane])), mk = wave_max(fabsf(a.in[I_GKN][lane]));
                const float lowc = -(0.125f * LOG2E * 64.f) * mq * mk;
                for (int u = bx; u < 256; u += G) {
                    const int b = u >> 4, h = u & 15;
                    {
                        const float* lp = out + pg8::O_LP + ((size_t)b * 4096 + 8 * tid) * 16 + h; float v[8];
#pragma unroll
                        for (int k = 0; k < 8; ++k) v[k] = lp[(size_t)k * 16];
#pragma unroll
                        for (int k = 1; k < 8; ++k) v[k] += v[k - 1];
                        float inc = v[7];
#pragma unroll
                        for (int o = 1; o < 64; o <<= 1) { const float t = __shfl_up(inc, o); if (lane >= o) inc += t; }
                        LAS float* wt = (LAS float*)(lds + DK_OFF + 16384);
                        if (lane == 63) wt[wave] = inc;
                        __syncthreads();
                        float pre = 0.f;
#pragma unroll
                        for (int w = 0; w < 8; ++w) pre += (w < wave) ? wt[w] : 0.f;
                        const float ex = pre + inc - v[7];
                        LAS f32x4* dstl = (LAS f32x4*)(lds + DK_OFF) + 2 * tid;
                        dstl[0] = (f32x4){(v[0] + ex) * LOG2E, (v[1] + ex) * LOG2E, (v[2] + ex) * LOG2E, (v[3] + ex) * LOG2E};
                        dstl[1] = (f32x4){(v[4] + ex) * LOG2E, (v[5] + ex) * LOG2E, (v[6] + ex) * LOG2E, (v[7] + ex) * LOG2E};
                    }
                    __syncthreads();
                    for (int qb = 15; qb >= 0; --qb) {
                        const LAS float* dl = (const LAS float*)(lds + DK_OFF);
                        const float thr = dl[256 * qb] - 2.f * lowc + 45.f;
                        const int jmax = 4 * qb;
                        const bool sk = (lane < jmax) && (dl[64 * lane + 63] > thr);
                        const int t0 = (int)__builtin_popcountll(__ballot(sk)) & ~1;
                        attn_body::attn_unit<8>(b, h, qb, (const attn_body::bf16*)QB, (const attn_body::bf16*)KB, (const attn_body::bf16*)VB, (attn_body::bf16*)OB, (char*)lds_raw,
                                                (const LAS float*)(lds + DK_OFF), lowc, t0);
                    }
                    __syncthreads();
                }
            }
            for (int rep_ = 0; rep_ < NREP(7); ++rep_) { if (rep_) GSYNC(); PHASE_ENTER();
                for (int u = bx; u < 256; u += G) {
                    {
                        const int b = u >> 4, h = u & 15; const float* ls = out + pg8::O_LS + (size_t)b * 64 * 16 + h; const float* cl = a.in[I_CL] + (size_t)b * 1024 * 16 + h; float v[4];
#pragma unroll
                        for (int k = 0; k < 4; ++k) { const int j = 4 * tid + k; v[k] = j < PAST ? cl[(size_t)j * 16] : (j < KVS ? ls[(size_t)(j - PAST) * 16] : 0.f); }
#pragma unroll
                        for (int k = 1; k < 4; ++k) v[k] += v[k - 1];
                        float inc = v[3];
#pragma unroll
                        for (int o = 1; o < 64; o <<= 1) { const float t = __shfl_up(inc, o); if (lane >= o) inc += t; }
                        LAS float* wt = (LAS float*)(lds + DK_OFF + 16384);
                        if (lane == 63) wt[wave] = inc;
                        __syncthreads();
                        float pre = 0.f;
#pragma unroll
                        for (int w = 0; w < 8; ++w) pre += (w < wave) ? wt[w] : 0.f;
                        const float ex = pre + inc - v[3];
                        if (4 * tid < KVS) *(f32x4*)(DKS + (size_t)u * KVS + 4 * tid) = (f32x4){(v[0] + ex) * LOG2E, (v[1] + ex) * LOG2E, (v[2] + ex) * LOG2E, (v[3] + ex) * LOG2E};
                        asm volatile("s_waitcnt vmcnt(0)" ::: "memory"); __syncthreads();
                    }
                    sample_attn(u >> 4, u & 15, a.in[I_CK], a.in[I_CV], (bf16*)(ws + WS_KVQS) - (size_t)MP * 1024, (bf16*)(ws + WS_KVQS + 2 * MiB) - (size_t)MP * 1024, (bf16*)(ws + WS_KVQS + 4 * MiB) - (size_t)MP * 1024, DKS + (size_t)u * KVS, OB, lds, tid, lane, wave);
                }
            }
            GSYNC();
            for (int rep_ = 0; rep_ < NREP(8); ++rep_) { if (rep_) GSYNC(); PHASE_ENTER();
                pg8::Gemm g{OB, WOT, MT, 1024, 1024, 1024, 0}; pg8::StaticOrder S; S.init(MP, 1024, G, vcu);
                pg8::EpiRes<true, true, false> E{out, out + (size_t)MP * 1024, out, XB, SSQ, nullptr};
                pg8::gemm_phase<pg8::EpiRes<true, true, false>, pg8::StaticOrder, PG_ALIGN, true>(lds, g, S, E);
            }
            GSYNC();
        }
#define SROLE_NB(v) ((v) < 16 ? 0 : (v) < 104 ? 2 : (v) < 120 ? 5 : ((v) < 172 && l == 0) ? 9 : 0)
        {
            PHASE_ENTER();
            pg8::Gemm g{XB, (bf16*)(ws + (l ? WS_WGU1 : WS_WGU0)), MT, 5632, 1024, 1024, 0}; pg8::StaticOrder base; base.init(MP, 5632, G, vcu);
            pg8::EpiGU E{SSQ, ACT};
            pg8::RangeOrder S{base, 0, SROLE_NB(vcu), -1, 0};
            pg8::gemm_phase<pg8::EpiGU, pg8::RangeOrder, PG_ALIGN, true>(lds, g, S, E);
        }
        if (vcu < 120 || (vcu < 172 && l == 0)) {
            PHASE_ENTER();
            int role, sidx;
            if (vcu < 16) { role = 1; sidx = vcu; } else if (vcu < 104) { role = 2; sidx = vcu - 16; } else if (vcu < 120) { role = 3; sidx = vcu - 104; } else { role = 4; sidx = vcu - 120; }
            unsigned* cnt = (unsigned*)(ws + WS_CTL + 32768) + l * 256;
            if (role > 1) {
                if (tid == 0) { const unsigned need = role == 3 ? 88u : 16u; unsigned sp = 0;
                    while (__hip_atomic_load(cnt + 64 * (role - 2), __ATOMIC_RELAXED, __HIP_MEMORY_SCOPE_AGENT) < need && ++sp < (1u << 22)) __builtin_amdgcn_s_sleep(2);
                    __builtin_amdgcn_fence(__ATOMIC_ACQUIRE, "agent"); asm volatile("s_waitcnt vmcnt(0)" ::: "memory"); }
                __syncthreads();
            }
            if (role == 1) {
                pg8::OneUnit S1{256 + (sidx >> 2), sidx & 3};
                if (l) { pg8::Gemm g2{OB, WOT, MT, 1024, 1024, 1024, 0}; pg8::EpiRes<true, true, false> E3{xp, xs, out, XB, SSQ, nullptr}; pg8::gemm_phase<pg8::EpiRes<true, true, false>, pg8::OneUnit, PG_ALIGN, true>(lds, g2, S1, E3); }
                else { pg8::Gemm g2{PB, WPOOL, MT, 1024, 256, 1024, 256}; pg8::EpiRes<true, false, false> E2{xp, xs, out, XB, SSQ, nullptr}; pg8::gemm_phase<pg8::EpiRes<true, false, false>, pg8::OneUnit, PG_ALIGN, true>(lds, g2, S1, E2); }
            } else if (role == 2) {
                pg8::Gemm g2{XB, (bf16*)(ws + (l ? WS_WGU1 : WS_WGU0)), MT, 5632, 1024, 1024, 0}; pg8::EpiGU E2{SSQ, ACT};
                pg8::OneUnit S1{256 + sidx / 22, sidx % 22};
                pg8::gemm_phase<pg8::EpiGU, pg8::OneUnit, PG_ALIGN, true>(lds, g2, S1, E2);
            } else if (role == 3) {
                pg8::Gemm g2{ACT, (bf16*)(ws + (l ? WS_WDN1 : WS_WDN0)), MT, 1024, 2816, 2816, 0}; pg8::OneUnit S1{256 + (sidx >> 2), sidx & 3};
                pg8::EpiRes<true, true, true> E2{out, out + (size_t)MP * 1024, out, XB, SSQ, nullptr};
                pg8::gemm_phase<pg8::EpiRes<true, true, true>, pg8::OneUnit, PG_ALIGN, true>(lds, g2, S1, E2);
            } else {
                pg8::Gemm g2{XB, WKVQ, MT, 3328, 1024, 1024, 0}; pg8::OneUnit S1{256 + sidx / 13, sidx % 13};
                pg8::EpiKVQ E2{SSQ, (const float*)(ws + WS_GN), a.in[I_BF], out, (bf16*)(ws + WS_KVQS) - (size_t)MP * 1024, (size_t)(2 * MiB / 2)};
                pg8::gemm_phase<pg8::EpiKVQ, pg8::OneUnit, PG_ALIGN, true>(lds, g2, S1, E2);
            }
            asm volatile("s_waitcnt vmcnt(0)" ::: "memory"); __syncthreads();
            if (tid == 0) { __builtin_amdgcn_fence(__ATOMIC_RELEASE, "agent"); asm volatile("s_waitcnt vmcnt(0)" ::: "memory");
                __hip_atomic_fetch_add(cnt + 64 * (role - 1), 1u, __ATOMIC_RELAXED, __HIP_MEMORY_SCOPE_AGENT); }
        }
        {
            PHASE_ENTER();
            pg8::Gemm g{XB, (bf16*)(ws + (l ? WS_WGU1 : WS_WGU0)), MT, 5632, 1024, 1024, 0}; pg8::StaticOrder base; base.init(MP, 5632, G, vcu);
            pg8::EpiGU E{SSQ, ACT};
            const bool dns = vcu >= 104 && vcu < 120, tk = vcu >= 172 && vcu < 188;
            pg8::RangeOrder S{base, SROLE_NB(vcu), dns ? 21 : 22, tk ? vcu - 172 + 104 : -1, 21};
            pg8::gemm_phase<pg8::EpiGU, pg8::RangeOrder, PG_ALIGN, true>(lds, g, S, E);
        }
#undef SROLE_NB
        GSYNC();
        for (int rep_ = 0; rep_ < NREP(4); ++rep_) { if (rep_) GSYNC(); PHASE_ENTER();
            pg8::Gemm g{ACT, (bf16*)(ws + (l ? WS_WDN1 : WS_WDN0)), MT, 1024, 2816, 2816, 0}; pg8::StaticOrder S; S.init(MP, 1024, G, vcu);
            if (l == 0) { pg8::EpiRes<true, true, false> E{out, out + (size_t)MP * 1024, out, XB, SSQ, nullptr}; pg8::gemm_phase<pg8::EpiRes<true, true, false>, pg8::StaticOrder, PG_ALIGN, true>(lds, g, S, E); }
            else { pg8::EpiRes<false, true, true> E{out, out + (size_t)MP * 1024, out, XB, nullptr, nullptr}; pg8::gemm_phase<pg8::EpiRes<false, true, true>, pg8::StaticOrder, PG_ALIGN, true>(lds, g, S, E); }
        }
        if (l == 0) GSYNC();
    }
}

extern "C" void kernel_launch(void* const* d_in, const int* in_sizes, int n_in, void* d_out, int out_size, void* d_ws, size_t ws_size, hipStream_t stream) {
    static int grid = 0;
    if (grid == 0) {
        if (n_in != 22 || (size_t)out_size != pg8::O_END || ws_size < WS_END) { fprintf(stderr, "kernel_launch: unexpected shapes: n_in %d out %d ws %zu (need %zu)\n", n_in, out_size, ws_size, (size_t)WS_END); grid = -1; return; }
        int dev = 0, cus = 0, per_cu = 0;
        (void)hipGetDevice(&dev); (void)hipDeviceGetAttribute(&cus, hipDeviceAttributeMultiprocessorCount, dev);
        if (hipFuncSetAttribute((const void*)mega, hipFuncAttributeMaxDynamicSharedMemorySize, LDS_BYTES) != hipSuccess) fprintf(stderr, "kernel_launch: hipFuncSetAttribute failed\n");
        if (hipOccupancyMaxActiveBlocksPerMultiprocessor(&per_cu, (const void*)mega, 512, LDS_BYTES) != hipSuccess || per_cu < 1) { fprintf(stderr, "kernel_launch: occupancy query says %d\n", per_cu); per_cu = 1; }
        (void)hipGetLastError();
        if (cus <= 0) cus = 256;
        grid = cus;
    }
    if (grid < 0) return;
    if (hipMemsetAsync((char*)d_ws + WS_CTL, 0, 65536, stream) != hipSuccess) { fprintf(stderr, "kernel_launch: memset failed\n"); return; }
    Args a{};
    for (int i = 0; i < 22; ++i) a.in[i] = (const float*)d_in[i];
    a.out = (float*)d_out; a.ws = (unsigned char*)d_ws;
    void* args[] = {&a};
    const hipError_t e = hipLaunchCooperativeKernel((const void*)mega, dim3(grid), dim3(512), args, LDS_BYTES, stream);
    if (e != hipSuccess) fprintf(stderr, "kernel_launch: cooperative launch failed: %s (grid %d)\n", hipGetErrorString(e), grid);
}
```

```cpp
#include <hip/hip_runtime.h>
#include <hip/hip_cooperative_groups.h>
#include <cstdio>
#include <cstdint>
namespace cg = cooperative_groups;
namespace pg8 {
#define PG8_LAS __attribute__((address_space(3)))
typedef unsigned short bf16_t;
typedef short bf16x8 __attribute__((ext_vector_type(8)));
typedef float f32x4 __attribute__((ext_vector_type(4)));
typedef unsigned u32x4 __attribute__((ext_vector_type(4)));
constexpr int BM = 256, BK = 64, HALF = 128, HTB = HALF * BK * 2  , STAGE_BYTES = 8 * HTB, NXCD = 8, WGM = 8;

__host__ __device__ __forceinline__ int lds_byte(int r, int c) { const int st = (r >> 4) * 2 + (c >> 5), rr = r & 15, cc = c & 31, ob = rr * 64 + cc * 2; return st * 1024 + (ob ^ (((ob >> 9) & 1) << 5)); }
__host__ __device__ __forceinline__ void stage_rc(int b, int& R, int& C) { const int st = b / 1024, sb = b % 1024, swz = sb ^ (((sb >> 9) & 1) << 5); R = (st >> 1) * 16 + swz / 64; C = (st & 1) * 32 + (swz % 64) / 2; }
__host__ __device__ __forceinline__ int perm32(int rho) { const int n = rho >> 4, i = rho & 15; return 8 * (i >> 2) + 4 * n + (i & 3); }

struct Unit { int pm, pn; };
struct Gemm { const bf16_t* A; const bf16_t* Bt; int M, N, K; int lda; int acol_pn; };

struct StaticOrder {
    int nM, nN, nwg, G, c;
    __host__ __device__ void init(int M, int N, int G_, int c_) { nM = M / BM; nN = N / BM; nwg = nM * nN; G = G_; c = c_; }
    __host__ __device__ bool next(int i, Unit& u) const {
        const long L = (long)i * G + c; if (L >= nwg) return false;
        int wgid = (int)L; { const int q = nwg / NXCD, r = nwg % NXCD, xcd = wgid % NXCD, off = wgid / NXCD; wgid = (xcd < r ? xcd * (q + 1) : r * (q + 1) + (xcd - r) * q) + off; }
        const int nig = WGM * nN, gid = wgid / nig, fm = gid * WGM, gsz = (nM - fm) < WGM ? (nM - fm) : WGM;
        u.pm = fm + ((wgid % nig) % gsz); u.pn = (wgid % nig) / gsz; return true;
    }
    __device__ __forceinline__ void a_ready(const Unit&) const {}
    __device__ __forceinline__ void done(const Unit&) const {}
};
__device__ __forceinline__ unsigned cvt_pk_bf16(float lo, float hi) { unsigned r; asm volatile("v_cvt_pk_bf16_f32 %0, %1, %2" : "=v"(r) : "v"(lo), "v"(hi)); return r; }
typedef float f32x2 __attribute__((ext_vector_type(2)));
typedef unsigned u32x2 __attribute__((ext_vector_type(2)));
typedef float f32x2e __attribute__((ext_vector_type(2))); typedef __bf16 bf16x2e __attribute__((ext_vector_type(2)));
__device__ __forceinline__ unsigned pkbf(float lo, float hi) { f32x2e v = {lo, hi}; bf16x2e b = __builtin_convertvector(v, bf16x2e); return __builtin_bit_cast(unsigned, b); }
__device__ __forceinline__ void rstd8(const float* ssq, int row00, int fq, float (&rr)[2][4]) {
    f32x4 sv[2][4];
#pragma unroll
    for (int ai = 0; ai < 2; ++ai)
#pragma unroll
        for (int m = 0; m < 4; ++m) sv[ai][m] = *(const f32x4*)(ssq + (size_t)(row00 + ai * HALF + m * 16) * 16 + fq * 4);
    float s[2][4];
#pragma unroll
    for (int ai = 0; ai < 2; ++ai)
#pragma unroll
        for (int m = 0; m < 4; ++m) s[ai][m] = (sv[ai][m][0] + sv[ai][m][1]) + (sv[ai][m][2] + sv[ai][m][3]);
#pragma unroll
    for (int ai = 0; ai < 2; ++ai)
#pragma unroll
        for (int m = 0; m < 4; ++m) s[ai][m] += __shfl_xor(s[ai][m], 16);
#pragma unroll
    for (int ai = 0; ai < 2; ++ai)
#pragma unroll
        for (int m = 0; m < 4; ++m) s[ai][m] += __shfl_xor(s[ai][m], 32);
#pragma unroll
    for (int ai = 0; ai < 2; ++ai)
#pragma unroll
        for (int m = 0; m < 4; ++m) rr[ai][m] = __builtin_amdgcn_rsqf(s[ai][m] * (1.0f / 1024.0f) + 1e-6f);
}
constexpr int EMP = 65536;
constexpr size_t O_YP = 0, O_YS = 67108864, O_PSP = O_YS + 1048576, O_PSS = O_PSP + 245760, O_KP = O_PSS + 245760, O_VP = O_KP + 67108864,
                 O_LP = O_VP + 67108864, O_KS = O_LP + 1048576, O_VS = O_KS + 1048576, O_LS = O_VS + 1048576, O_END = O_LS + 16384;
__device__ __forceinline__ float rstd_from_ssq(const float* ssq, int row, int fq) {
    const f32x4 v = *(const f32x4*)(ssq + (size_t)row * 16 + fq * 4);
    float s = (v[0] + v[1]) + (v[2] + v[3]);
    s += __shfl_xor(s, 16); s += __shfl_xor(s, 32);
    return __builtin_amdgcn_rsqf(s * (1.0f / 1024.0f) + 1e-6f);
}
template <bool HAS_XB, bool SRC_BF16, bool WR_F32> struct EpiRes {
    static constexpr bool PERM = false, AFTER_DRAIN = false;
    const float* srcP; const float* srcS; float* dst; bf16_t* xb; float* ssq; const float* cscale;
    __device__ __forceinline__ void operator()(const f32x4 (&acc)[2][2][4][2], const Unit& u, int wr, int wc, int fr_in, int fq_in) const {
        int ln_ = threadIdx.x & 63; asm volatile("" : "+v"(ln_)); const int fr = ln_ & 15, fq = ln_ >> 4; (void)fr_in; (void)fq_in;
        const int col0 = u.pn * BM + wc * 32 + 4 * fq;
#pragma unroll
        for (int ai = 0; ai < 2; ++ai) {
            f32x4 res[4][2][2];
#pragma unroll
            for (int m = 0; m < 4; ++m) {
                const int row = u.pm * BM + ai * HALF + wr * 64 + m * 16 + fr;
#pragma unroll
                for (int bj = 0; bj < 2; ++bj)
#pragma unroll
                    for (int n = 0; n < 2; ++n) {
                        if (SRC_BF16) { const u32x2 rb = *(const u32x2*)(xb + (size_t)row * 1024 + col0 + bj * HALF + n * 16);
                            res[m][bj][n] = (f32x4){__uint_as_float(rb.x << 16), __uint_as_float(rb.x & 0xffff0000u), __uint_as_float(rb.y << 16), __uint_as_float(rb.y & 0xffff0000u)}; }
                        else { const float* src = (row < EMP ? srcP + (size_t)row * 1024 : srcS + (size_t)(row - EMP) * 1024) + col0; res[m][bj][n] = *(const f32x4*)(src + bj * HALF + n * 16); }
                    }
            }
            float ssv[4];
#pragma unroll
            for (int m = 0; m < 4; ++m) {
                const int row = u.pm * BM + ai * HALF + wr * 64 + m * 16 + fr;
                float* d = dst + (size_t)row * 1024 + col0;
                float ss = 0.f;
#pragma unroll
                for (int bj = 0; bj < 2; ++bj)
#pragma unroll
                    for (int n = 0; n < 2; ++n) {
                        const f32x4 x = res[m][bj][n] + acc[ai][bj][m][n];
                        if (WR_F32) *(f32x4*)(d + bj * HALF + n * 16) = x;
                        if (HAS_XB) { u32x2 w; w.x = pkbf(x[0], x[1]); w.y = pkbf(x[2], x[3]); *(u32x2*)(xb + (size_t)row * 1024 + col0 + bj * HALF + n * 16) = w;
                            ss += (x[0] * x[0] + x[1] * x[1]) + (x[2] * x[2] + x[3] * x[3]); }
                    }
                ssv[m] = ss;
            }
            if (HAS_XB) {
#pragma unroll
                for (int m = 0; m < 4; ++m) ssv[m] += __shfl_xor(ssv[m], 16);
#pragma unroll
                for (int m = 0; m < 4; ++m) ssv[m] += __shfl_xor(ssv[m], 32);
#pragma unroll
                for (int m = 0; m < 4; ++m) if (fq == 0) ssq[(size_t)(u.pm * BM + ai * HALF + wr * 64 + m * 16 + fr) * 16 + u.pn * 4 + wc] = ssv[m];
            }
        }
    }
};
struct EpiGU {
    static constexpr bool PERM = true, AFTER_DRAIN = false;
    const float* ssq; bf16_t* act;
    __device__ __forceinline__ void operator()(const f32x4 (&acc)[2][2][4][2], const Unit& u, int wr, int wc, int fr_in, int fq_in) const {
        int ln_ = threadIdx.x & 63; asm volatile("" : "+v"(ln_)); const int fr = ln_ & 15, fq = ln_ >> 4; (void)fr_in; (void)fq_in;
        const int col = u.pn * 128 + wc * 32 + 8 * fq;
        float rr[2][4]; rstd8(ssq, u.pm * BM + wr * 64 + fr, fq, rr);
#pragma unroll
        for (int ai = 0; ai < 2; ++ai)
#pragma unroll
            for (int m = 0; m < 4; ++m) {
                const int row = u.pm * BM + ai * HALF + wr * 64 + m * 16 + fr;
                const float r = rr[ai][m];
                u32x4 w;
#pragma unroll
                for (int n = 0; n < 2; ++n) {
                    const f32x4 g = acc[ai][0][m][n] * r, up = acc[ai][1][m][n] * r; float hh[4];
#pragma unroll
                    for (int e = 0; e < 4; ++e) hh[e] = g[e] * __builtin_amdgcn_rcpf(1.0f + __builtin_amdgcn_exp2f(-1.4426950408889634f * g[e])) * up[e];
                    w[2 * n] = pkbf(hh[0], hh[1]); w[2 * n + 1] = pkbf(hh[2], hh[3]);
                }
                *(u32x4*)(act + (size_t)row * 2816 + col) = w;
            }
    }
};
struct EpiKVQ {
    static constexpr bool PERM = true, AFTER_DRAIN = false;
    const float* ssq; const float* gn; const float* bfp; float* out; bf16_t* kvq; size_t kvq_stride;
    __device__ __forceinline__ void operator()(const f32x4 (&acc)[2][2][4][2], const Unit& u, int wr, int wc, int fr_in, int fq_in) const {
        int ln_ = threadIdx.x & 63; asm volatile("" : "+v"(ln_)); const int fr = ln_ & 15, fq = ln_ >> 4; (void)fr_in; (void)fq_in;
        const int t = u.pn >> 2, j = u.pn & 3;
        if (t == 3) {
            if (wc != 0) return;
            const int h0 = 8 * (fq & 1);
            const f32x4 b0 = *(const f32x4*)(bfp + h0), b1 = *(const f32x4*)(bfp + h0 + 4);
            float rrf[2][4]; rstd8(ssq, u.pm * BM + wr * 64 + fr, fq, rrf);
#pragma unroll
            for (int ai = 0; ai < 2; ++ai)
#pragma unroll
                for (int m = 0; m < 4; ++m) {
                    const int row = u.pm * BM + ai * HALF + wr * 64 + m * 16 + fr;
                    const float r = rrf[ai][m];
                    if (fq < 2) {
                        float* o = (row < EMP ? out + O_LP + (size_t)row * 16 : out + O_LS + (size_t)(row - EMP) * 16) + h0;
#pragma unroll
                        for (int n = 0; n < 2; ++n) { const f32x4 z = acc[ai][0][m][n] * r + (n == 0 ? b0 : b1); f32x4 lf;
#pragma unroll
                            for (int e = 0; e < 4; ++e) lf[e] = fminf(z[e], 0.f) - 0.6931471805599453f * __builtin_amdgcn_logf(1.0f + __builtin_amdgcn_exp2f(-1.4426950408889634f * fabsf(z[e])));
                            *(f32x4*)(o + 4 * n) = lf; }
                    }
                }
            return;
        }
        f32x4 gain[2][2];
#pragma unroll
        for (int bj = 0; bj < 2; ++bj)
#pragma unroll
            for (int n = 0; n < 2; ++n) gain[bj][n] = *(const f32x4*)(gn + 64 * t + 32 * bj + 8 * fq + 4 * n);
        const int cl = 256 * j + 64 * wc + 8 * fq;
        bf16_t* const ob0 = kvq + (size_t)t * kvq_stride;
        float rr[2][4]; rstd8(ssq, u.pm * BM + wr * 64 + fr, fq, rr);
#pragma unroll
        for (int ai = 0; ai < 2; ++ai)
#pragma unroll
            for (int m = 0; m < 4; ++m) {
                const int row = u.pm * BM + ai * HALF + wr * 64 + m * 16 + fr;
                const float r = rr[ai][m];
                f32x4 v[2][2]; float ss = 0.f;
#pragma unroll
                for (int bj = 0; bj < 2; ++bj)
#pragma unroll
                    for (int n = 0; n < 2; ++n) { v[bj][n] = acc[ai][bj][m][n] * r; const f32x4 x = v[bj][n]; ss += (x[0] * x[0] + x[1] * x[1]) + (x[2] * x[2] + x[3] * x[3]); }
                if (t != 1) { ss += __shfl_xor(ss, 16); ss += __shfl_xor(ss, 32); const float rn = __builtin_amdgcn_rsqf(ss * (1.0f / 64.0f) + 1e-6f);
#pragma unroll
                    for (int bj = 0; bj < 2; ++bj)
#pragma unroll
                        for (int n = 0; n < 2; ++n) v[bj][n] = v[bj][n] * rn * gain[bj][n]; }
                if (t < 2) { float* o = (row < EMP ? out + (t == 0 ? O_KP : O_VP) + (size_t)row * 1024 : out + (t == 0 ? O_KS : O_VS) + (size_t)(row - EMP) * 1024) + cl;
#pragma unroll
                    for (int bj = 0; bj < 2; ++bj) { *(f32x4*)(o + 32 * bj) = v[bj][0]; *(f32x4*)(o + 32 * bj + 4) = v[bj][1]; } }
                bf16_t* ob = ob0 + (size_t)row * 1024 + cl;
#pragma unroll
                for (int bj = 0; bj < 2; ++bj) { u32x4 w; w.x = pkbf(v[bj][0][0], v[bj][0][1]); w.y = pkbf(v[bj][0][2], v[bj][0][3]); w.z = pkbf(v[bj][1][0], v[bj][1][1]); w.w = pkbf(v[bj][1][2], v[bj][1][3]);
                    *(u32x4*)(ob + 32 * bj) = w; }
            }
    }
};

struct RangeOrder {
    StaticOrder b; int i0, i1; int xc, xi;
    __device__ __forceinline__ bool next(int i, Unit& u) const {
        if (i0 + i < i1) return b.next(i0 + i, u);
        if (xc >= 0 && i0 + i == i1) { StaticOrder b2 = b; b2.c = xc; return b2.next(xi, u); }
        return false; }
    __device__ __forceinline__ void a_ready(const Unit&) const {}
    __device__ __forceinline__ void done(const Unit&) const {}
};
struct OneUnit {
    int pm, pn;
    __device__ __forceinline__ bool next(int i, Unit& u) const { if (i != 0) return false; u.pm = pm; u.pn = pn; return true; }
    __device__ __forceinline__ void a_ready(const Unit&) const {}
    __device__ __forceinline__ void done(const Unit&) const {}
};
template <class Epi, class Sched, bool ALIGN_EPI = false, bool SP2 = false>
__device__ __forceinline__ void gemm_phase(PG8_LAS unsigned char* lds, const Gemm g, const Sched& S, const Epi& E) {
    int tid_o = threadIdx.x; asm volatile("" : "+v"(tid_o)); const int tid = tid_o, wid = __builtin_amdgcn_readfirstlane(tid >> 6), lane = tid & 63, wr = wid >> 2, wc = wid & 3, fr = lane & 15, fq = lane >> 4;
    const int K = g.K, nt = K / BK;
    unsigned voffA[2], voffB[2];
#pragma unroll
    for (int i = 0; i < 2; ++i) { int R, C; stage_rc(tid * 16 + i * 8192, R, C); const int Rb = Epi::PERM ? ((R & ~31) + perm32(R & 31)) : R;
        voffA[i] = (unsigned)(R * g.lda + C) * 2u; voffB[i] = (unsigned)(Rb * K + C) * 2u; }
    const size_t kstep = (size_t)(BK * 2);
    const size_t hstepB = (size_t)HALF * K * 2, hstepA = (size_t)HALF * g.lda * 2;
    const size_t tstepB = 2 * hstepB, tstepA = 2 * hstepA;
    const unsigned ldsw = (unsigned)wid * 1024u;
    const int aoff = lds_byte(wr * 64 + fr, fq * 8), boff = lds_byte(wc * 32 + fr, fq * 8);
#define PG8_SA(b, h) (((b) * 2 + (h)) * HTB)
#define PG8_SB(b, h) ((4 + (b) * 2 + (h)) * HTB)
#define PG8_STAGE(bufoff, gbase, voff) do { _Pragma("unroll") for (int _i = 0; _i < 2; ++_i) \
        __builtin_amdgcn_global_load_lds((const unsigned*)((const char*)(gbase) + (voff)[_i]), (PG8_LAS unsigned*)(lds + (bufoff) + ldsw + _i * 8192), 16, 0, 0); } while (0)
#define PG8_LDA(dst, b, h) do { _Pragma("unroll") for (int m = 0; m < 4; ++m) _Pragma("unroll") for (int k = 0; k < 2; ++k) dst[m][k] = *(const PG8_LAS bf16x8*)(lds + PG8_SA(b, h) + aoff + m * 2048 + k * 1024); } while (0)
#define PG8_LDB(dst, b, h) do { _Pragma("unroll") for (int n = 0; n < 2; ++n) _Pragma("unroll") for (int k = 0; k < 2; ++k) dst[n][k] = *(const PG8_LAS bf16x8*)(lds + PG8_SB(b, h) + boff + n * 2048 + k * 1024); } while (0)
#define PG8_MMA(ai, bj, At, Bt) do { __builtin_amdgcn_s_setprio(1); _Pragma("unroll") for (int m = 0; m < 4; ++m) _Pragma("unroll") for (int n = 0; n < 2; ++n) _Pragma("unroll") for (int k = 0; k < 2; ++k) \
        acc[ai][bj][m][n] = __builtin_amdgcn_mfma_f32_16x16x32_bf16(Bt[n][k], At[m][k], acc[ai][bj][m][n], 0, 0, 0); __builtin_amdgcn_s_setprio(0); } while (0)
#define PG8_WAIT_V(n) asm volatile("s_waitcnt vmcnt(" #n ")" ::: "memory")
#define PG8_WAIT_L(n) asm volatile("s_waitcnt lgkmcnt(" #n ")" ::: "memory")
#define PG8_BAR __builtin_amdgcn_s_barrier()
#define PG8_SCHED __builtin_amdgcn_sched_barrier(0)
    Unit cur, nxt; int ui = 0;
    if (!S.next(0, cur)) return;
    f32x4 acc[2][2][4][2];
#pragma unroll
    for (int a = 0; a < 2; ++a)
#pragma unroll
        for (int b = 0; b < 2; ++b)
#pragma unroll
            for (int m = 0; m < 4; ++m)
#pragma unroll
                for (int n = 0; n < 2; ++n) acc[a][b][m][n] = (f32x4){0.f, 0.f, 0.f, 0.f};
    bf16x8 At[4][2], B0[2][2], B1[2][2];
    const char* cA = (const char*)g.A + (size_t)cur.pm * tstepA + (size_t)cur.pn * g.acol_pn * 2; const char* cB = (const char*)g.Bt + (size_t)cur.pn * tstepB;
    S.a_ready(cur);
    if constexpr (SP2) {
        PG8_STAGE(PG8_SB(0, 0), cB, voffB); PG8_STAGE(PG8_SB(0, 1), cB + hstepB, voffB); PG8_STAGE(PG8_SA(0, 0), cA, voffA); PG8_STAGE(PG8_SA(0, 1), cA + hstepA, voffA);
        if (wr == 1) PG8_BAR;
        PG8_WAIT_V(2); PG8_BAR;
        PG8_STAGE(PG8_SB(1, 0), cB + kstep, voffB); PG8_STAGE(PG8_SA(1, 0), cA + kstep, voffA); PG8_STAGE(PG8_SB(1, 1), cB + hstepB + kstep, voffB);
        PG8_WAIT_V(6); PG8_BAR;
    } else {
        PG8_STAGE(PG8_SB(0, 0), cB, voffB); PG8_STAGE(PG8_SA(0, 0), cA, voffA); PG8_STAGE(PG8_SB(0, 1), cB + hstepB, voffB); PG8_STAGE(PG8_SA(0, 1), cA + hstepA, voffA);
        if (wr == 1) PG8_BAR;
        PG8_WAIT_V(4); PG8_BAR;
        PG8_STAGE(PG8_SB(1, 0), cB + kstep, voffB); PG8_STAGE(PG8_SA(1, 0), cA + kstep, voffA); PG8_STAGE(PG8_SB(1, 1), cB + hstepB + kstep, voffB);
        PG8_WAIT_V(6); PG8_BAR;
    }
    for (;;) {
        const bool has_next = S.next(ui + 1, nxt);
        const char* nA = has_next ? (const char*)g.A + (size_t)nxt.pm * tstepA + (size_t)nxt.pn * g.acol_pn * 2 : cA; const char* nB = has_next ? (const char*)g.Bt + (size_t)nxt.pn * tstepB : cB;
        for (int t = 0; t < nt; t += 2) {
            const bool last = (t == nt - 2);
            const char* a1 = cA + (size_t)(t + 1) * kstep;
            const char* a2 = last ? nA : cA + (size_t)(t + 2) * kstep; const char* b2 = last ? nB : cB + (size_t)(t + 2) * kstep;
            const char* a3 = a2 + kstep; const char* b3 = b2 + kstep;
            if (last && has_next) S.a_ready(nxt);
            if constexpr (SP2) {
            PG8_LDB(B0, 0, 0); PG8_LDB(B1, 0, 1); PG8_SCHED; PG8_LDA(At, 0, 0); PG8_STAGE(PG8_SA(1, 1), a1 + hstepA, voffA);
            PG8_WAIT_V(8); PG8_WAIT_L(0); PG8_BAR; PG8_MMA(0, 0, At, B0); PG8_MMA(0, 1, At, B1); PG8_BAR; PG8_SCHED;
            PG8_LDA(At, 0, 1); PG8_STAGE(PG8_SB(0, 0), b2, voffB); PG8_STAGE(PG8_SB(0, 1), b2 + hstepB, voffB); PG8_STAGE(PG8_SA(0, 0), a2, voffA);
            PG8_WAIT_V(8); PG8_WAIT_L(0); PG8_BAR; PG8_MMA(1, 0, At, B0); PG8_MMA(1, 1, At, B1); PG8_BAR; PG8_SCHED;
            PG8_LDB(B0, 1, 0); PG8_LDB(B1, 1, 1); PG8_SCHED; PG8_LDA(At, 1, 0); PG8_STAGE(PG8_SA(0, 1), a2 + hstepA, voffA);
            PG8_WAIT_V(8); PG8_WAIT_L(0); PG8_BAR; PG8_MMA(0, 0, At, B0); PG8_MMA(0, 1, At, B1); PG8_BAR; PG8_SCHED;
            PG8_LDA(At, 1, 1); PG8_STAGE(PG8_SB(1, 0), b3, voffB); PG8_STAGE(PG8_SB(1, 1), b3 + hstepB, voffB); PG8_STAGE(PG8_SA(1, 0), a3, voffA);
            PG8_WAIT_V(8); PG8_WAIT_L(0); PG8_BAR; PG8_MMA(1, 0, At, B0); PG8_MMA(1, 1, At, B1); PG8_BAR; PG8_SCHED;
            } else {
            PG8_LDB(B0, 0, 0); PG8_SCHED; PG8_LDA(At, 0, 0); PG8_STAGE(PG8_SA(1, 1), a1 + hstepA, voffA);
            PG8_WAIT_L(8); PG8_BAR; PG8_WAIT_L(0); PG8_MMA(0, 0, At, B0); PG8_BAR; PG8_SCHED;
            PG8_LDB(B1, 0, 1); PG8_STAGE(PG8_SB(0, 0), b2, voffB);
            PG8_BAR; PG8_WAIT_L(0); PG8_MMA(0, 1, At, B1); PG8_BAR;
            PG8_LDA(At, 0, 1); PG8_STAGE(PG8_SA(0, 0), a2, voffA);
            PG8_BAR; PG8_WAIT_L(0); PG8_MMA(1, 0, At, B0); PG8_BAR; PG8_SCHED;
            PG8_STAGE(PG8_SB(0, 1), b2 + hstepB, voffB);
            PG8_WAIT_V(6); PG8_BAR; PG8_MMA(1, 1, At, B1); PG8_BAR;
            PG8_LDB(B0, 1, 0); PG8_SCHED; PG8_LDA(At, 1, 0); PG8_STAGE(PG8_SA(0, 1), a2 + hstepA, voffA);
            PG8_WAIT_L(8); PG8_BAR; PG8_WAIT_L(0); PG8_MMA(0, 0, At, B0); PG8_BAR; PG8_SCHED;
            PG8_LDB(B1, 1, 1); PG8_STAGE(PG8_SB(1, 0), b3, voffB);
            PG8_BAR; PG8_WAIT_L(0); PG8_MMA(0, 1, At, B1); PG8_BAR;
            PG8_LDA(At, 1, 1); PG8_STAGE(PG8_SA(1, 0), a3, voffA);
            PG8_BAR; PG8_WAIT_L(0); PG8_MMA(1, 0, At, B0); PG8_BAR; PG8_SCHED;
            PG8_STAGE(PG8_SB(1, 1), b3 + hstepB, voffB);
            PG8_WAIT_V(6); PG8_BAR; PG8_MMA(1, 1, At, B1); PG8_BAR;
            }
        }
        if constexpr (ALIGN_EPI) { if (wr == 0) PG8_BAR; }
        if constexpr (!Epi::AFTER_DRAIN) { E(acc, cur, wr, wc, fr, fq); S.done(cur); }
        if (!has_next) break;
#pragma unroll
        for (int a = 0; a < 2; ++a)
#pragma unroll
            for (int b = 0; b < 2; ++b)
#pragma unroll
                for (int m = 0; m < 4; ++m)
#pragma unroll
                    for (int n = 0; n < 2; ++n) acc[a][b][m][n] = (f32x4){0.f, 0.f, 0.f, 0.f};
        cur = nxt; cA = nA; cB = nB; ++ui;
        if constexpr (ALIGN_EPI) { if (wr == 1) PG8_BAR; }
    }
    PG8_WAIT_V(0);
    if constexpr (!ALIGN_EPI) { if (wr == 0) PG8_BAR; }
    PG8_BAR;
    if constexpr (Epi::AFTER_DRAIN) { E.fused(acc, cur, wr, wc, fr, fq, lds, wid, lane); S.done(cur); }
#undef PG8_SA
#undef PG8_SB
#undef PG8_STAGE
#undef PG8_LDA
#undef PG8_LDB
#undef PG8_MMA
#undef PG8_WAIT_V
#undef PG8_WAIT_L
#undef PG8_BAR
#undef PG8_SCHED
}
}

#include <hip/hip_bf16.h>
#include <cmath>
namespace attn_body {
using bf16=__hip_bfloat16;
using bf16x8=__attribute__((ext_vector_type(8)))short;
using s16x4=__attribute__((ext_vector_type(4)))short;
using f32x16=__attribute__((ext_vector_type(16)))float;
using u32x4=__attribute__((ext_vector_type(4)))unsigned;
using f32x4a=__attribute__((ext_vector_type(4)))float;
typedef __attribute__((address_space(3))) const float* lds_cfptr;
typedef __attribute__((address_space(3))) const f32x4a* lds_cf4ptr;
constexpr int BATCH=16,NHEAD=16,SEQ=4096,D=64,DM=NHEAD*D;
constexpr int NW=8,QBLK=32,QB=QBLK*NW,KVBLK=64,NQB=SEQ/QB;
constexpr int ATTN_PITCH=DM, ATTN_UNIT_ROWS=QB;
__device__ __forceinline__ int crow(int r,int hi){return (r&3)+8*(r>>2)+4*hi;}
#define SBAR() __builtin_amdgcn_sched_barrier(0)
__device__ __forceinline__ void cmask(f32x16&p0,f32x16&p1,int jb,int qrel,int hi){
  const float NEG=-INFINITY; int kb=64*jb+4*hi;
  #pragma unroll
  for(int r=0;r<16;++r){int kv=kb+(r&3)+8*(r>>2); if(kv>qrel)p0[r]=NEG; if(kv+32>qrel)p1[r]=NEG;}
}

constexpr int NSLOT=3, SLOTB=8192;
constexpr int LDS_K=0, LDS_V=NSLOT*SLOTB, LDS_WS=2*NSLOT*SLOTB, LDS_OST=LDS_WS+NW*64*4, LDS_BYTES=LDS_OST+NW*4096;
constexpr float C2=0.125f*1.4426950408889634f;
__device__ __forceinline__ void glds16(const void*gsrc,unsigned lds_dst){unsigned keep;
  asm volatile("s_mov_b32 %0, m0\n\ts_mov_b32 m0, %2\n\ts_nop 0\n\tglobal_load_lds_dwordx4 %1, off\n\ts_mov_b32 m0, %0":"=&s"(keep):"v"(gsrc),"s"(lds_dst):"memory");}
__device__ __forceinline__ float max3f(float a,float b,float c){float r;asm("v_max3_f32 %0, %1, %2, %3":"=v"(r):"v"(a),"v"(b),"v"(c));return r;}
__device__ __forceinline__ float max2f(float a,float b){float r;asm("v_max_f32_e32 %0, %1, %2":"=v"(r):"v"(a),"v"(b));return r;}
__device__ __forceinline__ float fadd_s(float a,float b){float r;asm("v_add_f32_e32 %0, %1, %2":"=v"(r):"v"(a),"v"(b));return r;}
__device__ __forceinline__ float fsub_s(float a,float b){float r;asm("v_sub_f32_e32 %0, %1, %2":"=v"(r):"v"(a),"v"(b));return r;}
typedef float f32x2_t __attribute__((ext_vector_type(2))); typedef __bf16 bf16x2_t __attribute__((ext_vector_type(2)));
__device__ __forceinline__ unsigned cvtpk_s(float lo,float hi){f32x2_t v={lo,hi};bf16x2_t b=__builtin_convertvector(v,bf16x2_t);return __builtin_bit_cast(unsigned,b);}
#define WAIT_BAR(N) asm volatile("s_waitcnt vmcnt(" #N ") lgkmcnt(0)\n\ts_barrier":::"memory")

__device__ __forceinline__ void qkt(f32x16&p0,f32x16&p1,const char*Kslot,const bf16x8*qr,int r32,int hi){
  const char*kb=Kslot+hi*1024+r32*16;
  #pragma unroll
  for(int d0=0;d0<4;++d0){
    const bf16x8 b0=*reinterpret_cast<const bf16x8*>(kb+d0*2048);
    const bf16x8 b1=*reinterpret_cast<const bf16x8*>(kb+d0*2048+512);
    {p0=__builtin_amdgcn_mfma_f32_32x32x16_bf16(b0,qr[d0],p0,0,0,0);p1=__builtin_amdgcn_mfma_f32_32x32x16_bf16(b1,qr[d0],p1,0,0,0);}}
}
typedef __attribute__((address_space(3))) const char* lds_cptr;
typedef short v4i16_t __attribute__((ext_vector_type(4)));
__device__ __forceinline__ void kload8(bf16x8*kf,lds_cptr kp){
  kf[0]=*(const __attribute__((address_space(3))) bf16x8*)(kp);      kf[1]=*(const __attribute__((address_space(3))) bf16x8*)(kp+512);
  kf[2]=*(const __attribute__((address_space(3))) bf16x8*)(kp+2048); kf[3]=*(const __attribute__((address_space(3))) bf16x8*)(kp+2560);
  kf[4]=*(const __attribute__((address_space(3))) bf16x8*)(kp+4096); kf[5]=*(const __attribute__((address_space(3))) bf16x8*)(kp+4608);
  kf[6]=*(const __attribute__((address_space(3))) bf16x8*)(kp+6144); kf[7]=*(const __attribute__((address_space(3))) bf16x8*)(kp+6656);
}
__device__ __forceinline__ void kload2(bf16x8*kf,lds_cptr kp,int j){ kf[2*j]=*(const __attribute__((address_space(3))) bf16x8*)(kp+j*2048); kf[2*j+1]=*(const __attribute__((address_space(3))) bf16x8*)(kp+j*2048+512); }
__device__ __forceinline__ s16x4 vtr(lds_cptr p){ return __builtin_bit_cast(s16x4,__builtin_amdgcn_ds_read_tr16_b64_v4i16((__attribute__((address_space(3))) v4i16_t*)p)); }
__device__ __forceinline__ float rowmax(const f32x16&p0,const f32x16&p1){
  float a=max3f(p0[0],p0[1],p1[0]),b=max3f(p0[2],p0[3],p1[1]);a=max3f(a,p1[2],p1[3]);
  #pragma unroll
  for(int r=4;r<16;r+=4){a=max3f(a,p0[r],p0[r+1]);b=max3f(b,p0[r+2],p0[r+3]);a=max3f(a,p1[r],p1[r+1]);b=max3f(b,p1[r+2],p1[r+3]);}
  const float m=max2f(a,b);
  auto rr=__builtin_amdgcn_permlane32_swap(__float_as_uint(m),__float_as_uint(m),false,false);
  return max2f(__uint_as_float(rr[0]),__uint_as_float(rr[1]));
}
__device__ __forceinline__ void pv(f32x16*o,int vb,bf16x8 pa0,bf16x8 pa1,bf16x8 pa2,bf16x8 pa3){
  #pragma unroll
  for(int d0=0;d0<2;++d0){s16x4 lo[4],hi[4];
    #pragma unroll
    for(int ks=0;ks<4;++ks){
      asm volatile("ds_read_b64_tr_b16 %0,%1 offset:%c2":"=&v"(lo[ks]):"v"(vb),"i"(d0*4096+ks*1024):"memory");
      asm volatile("ds_read_b64_tr_b16 %0,%1 offset:%c2":"=&v"(hi[ks]):"v"(vb),"i"(d0*4096+ks*1024+512):"memory");}
    asm volatile("s_waitcnt lgkmcnt(0)":::"memory");SBAR();
    #define PK(k) (bf16x8){lo[k][0],lo[k][1],lo[k][2],lo[k][3],hi[k][0],hi[k][1],hi[k][2],hi[k][3]}
    o[d0]=__builtin_amdgcn_mfma_f32_32x32x16_bf16(pa0,PK(0),o[d0],0,0,0);
    o[d0]=__builtin_amdgcn_mfma_f32_32x32x16_bf16(pa1,PK(1),o[d0],0,0,0);
    o[d0]=__builtin_amdgcn_mfma_f32_32x32x16_bf16(pa2,PK(2),o[d0],0,0,0);
    o[d0]=__builtin_amdgcn_mfma_f32_32x32x16_bf16(pa3,PK(3),o[d0],0,0,0);
    #undef PK
  }
}

#ifndef ATTN_STORE16
#define ATTN_STORE16(p,v) (*(u32x4*)(p)=(v))
#endif
template<int THRL> __device__ __forceinline__ void attn_unit(int b,int h,int qb,const bf16*Q,const bf16*__restrict__ K,const bf16*__restrict__ V,bf16*O,char*shm,lds_cfptr dkl,float lowc,int t0){
  int tid_o=threadIdx.x; asm volatile("":"+v"(tid_o)); const int tid=tid_o,lane=tid&63,r32=lane&31,hi=lane>>5; const int wid=__builtin_amdgcn_readfirstlane(tid>>6);
  const long rowbase=(long)b*SEQ; const int q0=qb*QB;
  const bf16*Qw=Q+(rowbase+q0+wid*QBLK)*DM+h*D;
  const bf16*Kh=K+(rowbase+(long)t0*KVBLK)*DM+h*D,*Vh=V+(rowbase+(long)t0*KVBLK)*DM+h*D;
  const unsigned lds0=(unsigned)(uintptr_t)shm;
  float*wsf=(float*)(shm+LDS_WS)+wid*64;
  const bf16*ksrc=Kh+(long)lane*DM+wid*8;
  const bf16*vsrc=Vh+(long)(16*(wid&3)+(lane>>2))*DM+(wid>>2)*32+(lane&3)*8;
  const unsigned kdst=lds0+LDS_K+wid*1024, vdst=lds0+LDS_V+wid*1024;
  #define DMA_K(t,slot) glds16(ksrc+(long)(t)*KVBLK*DM,(unsigned)__builtin_amdgcn_readfirstlane(kdst+(slot)))
  #define DMA_V(t,slot) glds16(vsrc+(long)(t)*KVBLK*DM,(unsigned)__builtin_amdgcn_readfirstlane(vdst+(slot)))
  const int vb0=(int)(lds0+LDS_V)+((lane>>4)&1)*32+(lane&3)*8+(4*hi+((lane&15)>>2))*64;
  const char*Kbase=shm+LDS_K; bf16x8 kf[8];
  const lds_cptr shm3=(lds_cptr)shm; const lds_cptr kp0=shm3+LDS_K+hi*1024+r32*16; const lds_cptr vp0=shm3+LDS_V+((lane>>4)&1)*32+(lane&3)*8+(4*hi+((lane&15)>>2))*64;
  const int NT=(q0+QB)/KVBLK-t0;
  DMA_K(0,0);DMA_V(0,0);DMA_K(1,SLOTB);
  bf16x8 qr[4];
  #pragma unroll
  for(int d0=0;d0<4;++d0)qr[d0]=*reinterpret_cast<const bf16x8*>(&Qw[(long)r32*DM+d0*16+hi*8]);
  const float dq2=dkl[q0+wid*QBLK+r32]; const lds_cf4ptr dk4=(lds_cf4ptr)dkl+16*t0;
  float mhat=-dq2,l_reg=0.f;f32x16 o[2];o[0]=f32x16{};o[1]=f32x16{};
  #define BINIT(P0,P1,t,NM) do{ const lds_cf4ptr d4_=dk4+16*(t)+hi; _Pragma("unroll") for(int j_=0;j_<4;++j_){ const f32x4a a_=d4_[2*j_], b_=d4_[8+2*j_]; _Pragma("unroll") for(int i_=0;i_<4;++i_){P0[4*j_+i_]=(NM)-a_[i_];P1[4*j_+i_]=(NM)-b_[i_];} } }while(0)
  #define BLOAD(P0,P1,t) do{ const lds_cf4ptr d4_=dk4+16*(t)+hi; _Pragma("unroll") for(int j_=0;j_<4;++j_){ const f32x4a a_=d4_[2*j_], b_=d4_[8+2*j_]; _Pragma("unroll") for(int i_=0;i_<4;++i_){P0[4*j_+i_]=a_[i_];P1[4*j_+i_]=b_[i_];} } }while(0)
  const int qrel=wid*QBLK+r32;
  #define CMASK(P0,P1,t) do{int jb_=(t)-(NT-4); if(jb_>=0)cmask(P0,P1,jb_,qrel,hi);}while(0)
  bool resc=false;
  #define START(P0,P1) do{ const float rm=rowmax(P0,P1); resc=false; \
    { const float dl=rm; mhat=fadd_s(mhat,dl); \
      _Pragma("unroll") for(int r=0;r<16;++r){P0[r]=fsub_s(P0[r],dl);P1[r]=fsub_s(P1[r],dl);} \
      } \
    _Pragma("unroll") for(int r=0;r<16;++r)P0[r]=__builtin_amdgcn_exp2f(P0[r]); }while(0)
  #define RESC() do{ if(resc){ asm volatile("s_waitcnt lgkmcnt(0)":::"memory"); \
      _Pragma("unroll") for(int d_=0;d_<2;++d_) _Pragma("unroll") for(int r=0;r<16;++r)o[d_][r]*=wsf[crow(r,hi)]; } }while(0)
  f32x16 pA0,pA1,pB0,pB1;
  int sl_prev=0,sl_cur=0,sl_next=SLOTB;
  #define ROT() do{sl_prev=sl_cur;sl_cur=sl_next;sl_next=(sl_next==(NSLOT-1)*SLOTB)?0:sl_next+SLOTB;}while(0)
  DMA_K(2,2*SLOTB);
  WAIT_BAR(3);
  BINIT(pA0,pA1,0,dq2);
  qkt(pA0,pA1,Kbase,qr,r32,hi);asm volatile("s_nop 15\n\ts_nop 7":"+v"(pA0),"+v"(pA1));CMASK(pA0,pA1,0);
  START(pA0,pA1);
  { const float nm0_=-mhat; BINIT(pB0,pB1,1,nm0_); }
  _Pragma("unroll") for(int r=0;r<16;++r)pA1[r]=__builtin_amdgcn_exp2f(pA1[r]);
  WAIT_BAR(0);
  DMA_K(3,0);DMA_V(1,SLOTB);
  ROT();
  kload8(kf,kp0+sl_cur);
  WAIT_BAR(2);
  s16x4 vlo[8],vhi[8]; u32x4 pw0,pw1,pw2,pw3;
  #define PKW(P,B) cvtpk_s(P[B],P[B+1])
  #define PAF(k) __builtin_bit_cast(bf16x8,pw##k)
  #define VFR(i) (bf16x8){vlo[i][0],vlo[i][1],vlo[i][2],vlo[i][3],vhi[i][0],vhi[i][1],vhi[i][2],vhi[i][3]}
  #define PIN(x) asm volatile("":"+v"(x))
  #define MX3(a,b,c) __builtin_fmaxf(__builtin_fmaxf((a),(b)),(c))
  #define GAPA(MF,A0,A1,A2,A3,W0,W1,PW) do{ MF; sacc+=A0; sacc+=A1; sacc+=A2; sacc+=A3; PIN(sacc); W0; W1; PIN(PW); SBAR(); }while(0)
  #define EX(v) __builtin_amdgcn_exp2f(v)
  #define GAPB(MF,X,B,G,PI) do{ MF; X[B]=EX(X[B]); X[B+1]=EX(X[B+1]); X[B+2]=EX(X[B+2]); X[B+3]=EX(X[B+3]); PIN(X); if(G){ PI[B]=nmh_-PI[B]; PI[B+1]=nmh_-PI[B+1]; PI[B+2]=nmh_-PI[B+2]; PI[B+3]=nmh_-PI[B+3]; PIN(PI); } SBAR(); }while(0)
  #define VRD(i) do{ vlo[i]=vtr(vp_+(((i)>>2)*4096+((i)&3)*1024)); vhi[i]=vtr(vp_+(((i)>>2)*4096+((i)&3)*1024+512)); }while(0)
  #define KRD(G,j) do{ if(G){ kload2(kf,kp0+sl_next,j); SBAR(); } }while(0)
  #define STEP(C0,C1,P0,P1,t,GK,GV,GL) do{ SBAR(); \
    const lds_cptr vp_=vp0+sl_prev; \
    VRD(0); SBAR(); float sacc=(P0[0]+P0[1]); \
    GAPA(C0=__builtin_amdgcn_mfma_f32_32x32x16_bf16(kf[0],qr[0],C0,0,0,0), P0[2],P0[3],P0[4],P0[5],     pw0[0]=PKW(P0,0), pw0[1]=PKW(P0,2), pw0); \
    VRD(4); SBAR(); GAPA(C1=__builtin_amdgcn_mfma_f32_32x32x16_bf16(kf[1],qr[0],C1,0,0,0), P0[6],P0[7],P0[8],P0[9],     pw0[2]=PKW(P0,4), pw0[3]=PKW(P0,6), pw0); \
    VRD(1); SBAR(); GAPA(C0=__builtin_amdgcn_mfma_f32_32x32x16_bf16(kf[2],qr[1],C0,0,0,0),   P0[10],P0[11],P0[12],P0[13], pw1[0]=PKW(P0,8), pw1[1]=PKW(P0,10), pw1); \
    VRD(5); SBAR(); GAPA(C1=__builtin_amdgcn_mfma_f32_32x32x16_bf16(kf[3],qr[1],C1,0,0,0),   P0[14],P0[15],P1[0],P1[1],   pw1[2]=PKW(P0,12),pw1[3]=PKW(P0,14), pw1); \
    VRD(2); SBAR(); GAPA(C0=__builtin_amdgcn_mfma_f32_32x32x16_bf16(kf[4],qr[2],C0,0,0,0),   P1[2],P1[3],P1[4],P1[5],     pw2[0]=PKW(P1,0), pw2[1]=PKW(P1,2), pw2); \
    VRD(6); SBAR(); GAPA(C1=__builtin_amdgcn_mfma_f32_32x32x16_bf16(kf[5],qr[2],C1,0,0,0),   P1[6],P1[7],P1[8],P1[9],     pw2[2]=PKW(P1,4), pw2[3]=PKW(P1,6), pw2); \
    VRD(3); SBAR(); GAPA(C0=__builtin_amdgcn_mfma_f32_32x32x16_bf16(kf[6],qr[3],C0,0,0,0),   P1[10],P1[11],P1[12],P1[13], pw3[0]=PKW(P1,8), pw3[1]=PKW(P1,10), pw3); \
    VRD(7); SBAR(); GAPA(C1=__builtin_amdgcn_mfma_f32_32x32x16_bf16(kf[7],qr[3],C1,0,0,0),   P1[14],P1[15],0.f,0.f,       pw3[2]=PKW(P1,12),pw3[3]=PKW(P1,14), pw3); \
    l_reg+=sacc; \
    if(GK){DMA_K((t)+3,sl_cur);} if(GV){DMA_V((t)+1,sl_next);} \
    CMASK(C0,C1,t); \
    { float a=MX3(C0[0],C0[1],C1[0]),b=MX3(C0[2],C0[3],C1[1]); a=MX3(a,C1[2],C1[3]); \
      _Pragma("unroll") for(int r=4;r<16;r+=4){a=MX3(a,C0[r],C0[r+1]);b=MX3(b,C0[r+2],C0[r+3]);a=MX3(a,C1[r],C1[r+1]);b=MX3(b,C1[r+2],C1[r+3]);} \
      float rm=__builtin_fmaxf(a,b); { auto rr=__builtin_amdgcn_permlane32_swap(__float_as_uint(rm),__float_as_uint(rm),false,false); rm=__builtin_fmaxf(__uint_as_float(rr[0]),__uint_as_float(rr[1])); } \
      resc=false; \
      if(__builtin_expect(__any(rm>(float)THRL),0)){ const float dl=__builtin_fmaxf(rm,0.f); mhat+=dl; \
        _Pragma("unroll") for(int r=0;r<16;++r){C0[r]-=dl;C1[r]-=dl;} \
        const float f=__builtin_amdgcn_exp2f(-dl); l_reg*=f; if(hi==0)wsf[r32]=f; resc=true; } } \
    const float nmh_=-mhat; if(GL){ BLOAD(P0,P1,(t)+1); } SBAR(); \
    GAPB(o[0]=__builtin_amdgcn_mfma_f32_32x32x16_bf16(PAF(0),VFR(0),o[0],0,0,0), C0,0,GL,P0); \
    GAPB(o[1]=__builtin_amdgcn_mfma_f32_32x32x16_bf16(PAF(0),VFR(4),o[1],0,0,0), C0,4,GL,P0); \
    KRD(GL,0); GAPB(o[0]=__builtin_amdgcn_mfma_f32_32x32x16_bf16(PAF(1),VFR(1),o[0],0,0,0), C0,8,GL,P0); \
    KRD(GL,1); GAPB(o[1]=__builtin_amdgcn_mfma_f32_32x32x16_bf16(PAF(1),VFR(5),o[1],0,0,0), C0,12,GL,P0); \
    KRD(GL,2); GAPB(o[0]=__builtin_amdgcn_mfma_f32_32x32x16_bf16(PAF(2),VFR(2),o[0],0,0,0), C1,0,GL,P1); \
    KRD(GL,3); GAPB(o[1]=__builtin_amdgcn_mfma_f32_32x32x16_bf16(PAF(2),VFR(6),o[1],0,0,0), C1,4,GL,P1); \
    GAPB(o[0]=__builtin_amdgcn_mfma_f32_32x32x16_bf16(PAF(3),VFR(3),o[0],0,0,0), C1,8,GL,P1); \
    GAPB(o[1]=__builtin_amdgcn_mfma_f32_32x32x16_bf16(PAF(3),VFR(7),o[1],0,0,0), C1,12,GL,P1); \
    }while(0)
  int t=1;
  #undef CMASK
  #define CMASK(P0,P1,t) do{}while(0)
  for(;t+5<NT;t+=2){
    STEP(pB0,pB1,pA0,pA1,t,true,true,true);     WAIT_BAR(2); RESC(); ROT();
    STEP(pA0,pA1,pB0,pB1,t+1,true,true,true);   WAIT_BAR(2); RESC(); ROT();
  }
  #undef CMASK
  #define CMASK(P0,P1,t) do{int jb_=(t)-(NT-4); if(jb_>=0)cmask(P0,P1,jb_,qrel,hi);}while(0)
  #define ENDW(tt) do{ if((tt)+3<NT){WAIT_BAR(2);} else if((tt)+2<NT){WAIT_BAR(1);} else {WAIT_BAR(0);} }while(0)
  for(;t+1<NT;t+=2){
    STEP(pB0,pB1,pA0,pA1,t,(t+3<NT),(t+1<NT),(t+1<NT));       ENDW(t);   RESC(); ROT();
    STEP(pA0,pA1,pB0,pB1,t+1,(t+4<NT),(t+2<NT),(t+2<NT));     ENDW(t+1); RESC(); ROT();
  }
  STEP(pB0,pB1,pA0,pA1,NT-1,false,false,false); RESC();
  { float sacc=pB0[0]+pB0[1]; _Pragma("unroll") for(int r=2;r<16;++r)sacc+=pB0[r]; _Pragma("unroll") for(int r=0;r<16;++r)sacc+=pB1[r]; l_reg+=sacc;
    pw0=(u32x4){PKW(pB0,0),PKW(pB0,2),PKW(pB0,4),PKW(pB0,6)};pw1=(u32x4){PKW(pB0,8),PKW(pB0,10),PKW(pB0,12),PKW(pB0,14)};pw2=(u32x4){PKW(pB1,0),PKW(pB1,2),PKW(pB1,4),PKW(pB1,6)};pw3=(u32x4){PKW(pB1,8),PKW(pB1,10),PKW(pB1,12),PKW(pB1,14)};
    SBAR(); pv(o,vb0+sl_cur,PAF(0),PAF(1),PAF(2),PAF(3)); }
  #undef PKW
  #undef PAF
  #undef VFR
  #undef PIN
  #undef MX3
  #undef GAPA
  #undef GAPB
  #undef EX
  #undef VRD
  #undef KRD
  #undef STEP
  #undef ENDW
  {auto rr=__builtin_amdgcn_permlane32_swap(__float_as_uint(l_reg),__float_as_uint(l_reg),false,false);l_reg=__uint_as_float(rr[0])+__uint_as_float(rr[1]);}
  if(hi==0)wsf[32+r32]=l_reg;asm volatile("s_waitcnt lgkmcnt(0)":::"memory");
  float rli[16];
  #pragma unroll
  for(int r=0;r<16;++r)rli[r]=__builtin_amdgcn_rcpf(wsf[32+crow(r,hi)]);
  bf16*Ow=O+(rowbase+q0+wid*QBLK)*DM+h*D;
  { bf16*stg=(bf16*)(shm+LDS_OST)+wid*2048;
    #pragma unroll
    for(int r=0;r<16;++r){const int orow=crow(r,hi);
      #pragma unroll
      for(int d0=0;d0<2;++d0)stg[orow*64+d0*32+r32]=__float2bfloat16(o[d0][r]*rli[r]);}
    asm volatile("s_waitcnt lgkmcnt(0)":::"memory");
    #pragma unroll
    for(int i=0;i<4;++i){const int row=i*8+(lane>>3),ch=lane&7; const u32x4 v=*(const u32x4*)(stg+row*64+ch*8); ATTN_STORE16(Ow+(long)row*DM+ch*8,v);} }
  asm volatile("s_waitcnt lgkmcnt(0)\n\ts_barrier":::"memory");
  #undef BINIT
  #undef BLOAD
  #undef DMA_K
  #undef DMA_V
  #undef CMASK
  #undef START
  #undef RESC
  #undef ROT
}
constexpr int ATTN_LDS_BYTES=LDS_BYTES;
#undef SBAR
#undef WAIT_BAR
}

#define LAS __attribute__((address_space(3)))
typedef unsigned short bf16;
typedef unsigned v4u __attribute__((ext_vector_type(4)));
typedef unsigned v2u __attribute__((ext_vector_type(2)));
typedef float f32x4 __attribute__((ext_vector_type(4)));
typedef float f32x16 __attribute__((ext_vector_type(16)));
typedef short bf16x8 __attribute__((ext_vector_type(8)));

constexpr int MP = 65536, MS = 1024, MT = MP + MS, DMODEL = 1024, FF = 2816, SEQL = 4096, PAST = 1024, SSQ_ = 64, KVS = PAST + SSQ_;
constexpr float LOG2E = 1.4426950408889634f;
constexpr size_t MiB = 1u << 20;
constexpr size_t WS_WPOOL = 0, WS_WGU0 = 1 * MiB, WS_WGU1 = 12 * MiB, WS_WDN0 = 23 * MiB, WS_WDN1 = 29 * MiB, WS_WKVQ = 35 * MiB, WS_WO = 42 * MiB,
                 WS_RSTD = 44 * MiB, WS_SSQ = 45 * MiB, WS_DK2 = 50 * MiB, WS_DKS = 54 * MiB, WS_XB = 64 * MiB, WS_PB = 194 * MiB, WS_R1 = 324 * MiB,
                 WS_KB = WS_R1, WS_VB = WS_R1 + 130 * MiB, WS_QB = WS_R1 + 260 * MiB, WS_GN = 56 * MiB, WS_CTL = 57 * MiB, WS_KVQS = 58 * MiB, WS_END = WS_R1 + 390 * MiB;
constexpr int LDS_BYTES = 147456;
constexpr int DK_OFF = 86016;
static_assert(attn_body::ATTN_LDS_BYTES <= DK_OFF && DK_OFF + 16384 <= LDS_BYTES && pg8::STAGE_BYTES <= LDS_BYTES, "LDS map");

__device__ __forceinline__ float wave_sum(float v) {
#pragma unroll
    for (int o = 1; o < 64; o <<= 1) v += __shfl_xor(v, o);
    return v;
}
__device__ __forceinline__ float wave_max(float v) {
#pragma unroll
    for (int o = 1; o < 64; o <<= 1) v = fmaxf(v, __shfl_xor(v, o));
    return v;
}
__device__ __forceinline__ unsigned pk2(float lo, float hi) { return pg8::cvt_pk_bf16(lo, hi); }
__device__ __forceinline__ float bf2f(unsigned short b) { return __uint_as_float((unsigned)b << 16); }
__device__ __forceinline__ int crow(int r, int hi) { return (r & 3) + 8 * (r >> 2) + 4 * hi; }

struct RmOff { int off; __device__ __forceinline__ int operator()(int n) const { return off + n; } };
struct RmGU  { int up;  __device__ __forceinline__ int operator()(int n) const { return 256 * (n >> 7) + (n & 127) + up * 128; } };
struct RmKVQ { int base; __device__ __forceinline__ int operator()(int n) const { const int l = n & 255; return base + (n & ~255) + 128 * ((l >> 5) & 1) + 32 * (l >> 6) + (l & 31); } };

template <class RowMap> __device__ __forceinline__ void transpose_item(const float* W, int K, int N, bf16* WT, const RowMap rm, const float* kgain, const float* nscale, LAS float* scr, int item, int lane) {
    const int nblk = N / 32, kb = item / nblk, nb = item % nblk, k0 = 64 * kb, n0 = 32 * nb;
    const float ns = nscale ? nscale[n0 + (lane & 31)] : 1.f;
#pragma unroll 8
    for (int i = 0; i < 32; ++i) { const int kk = 2 * i + (lane >> 5); float v = W[(size_t)(k0 + kk) * N + n0 + (lane & 31)] * ns; if (kgain) v *= kgain[k0 + kk]; scr[kk * 33 + (lane & 31)] = v; }
    asm volatile("s_waitcnt lgkmcnt(0)" ::: "memory");
    const int c = lane & 7;
#pragma unroll
    for (int j = 0; j < 4; ++j) { const int n = (lane >> 3) + 8 * j; const LAS float* s = scr + (8 * c) * 33 + n;
        v4u o; o.x = pk2(s[0 * 33], s[1 * 33]); o.y = pk2(s[2 * 33], s[3 * 33]); o.z = pk2(s[4 * 33], s[5 * 33]); o.w = pk2(s[6 * 33], s[7 * 33]);
        *(v4u*)(WT + (size_t)rm(n0 + n) * K + k0 + 8 * c) = o; }
    asm volatile("s_waitcnt lgkmcnt(0)" ::: "memory");
}

#define XB_TMO      128
#define XB_XCNT(j)  (256  + 64 * (j))
#define XB_XSUB(j)  (1280 + 64 * (j))
#define XB_XGEN(j)  (2304 + 64 * (j))
#define XB_TOP      3328
#define XB_TOPGEN   3392
#define XCD_BAR_WORDS 3456
#define XB_SPIN_CAP (1u << 18)

__device__ __forceinline__ unsigned xb_ld(unsigned* p)              { return __hip_atomic_load(p, __ATOMIC_RELAXED, __HIP_MEMORY_SCOPE_AGENT); }
__device__ __forceinline__ unsigned xb_add(unsigned* p, unsigned v) { return __hip_atomic_fetch_add(p, v, __ATOMIC_RELAXED, __HIP_MEMORY_SCOPE_AGENT); }
__device__ __forceinline__ unsigned xb_xcc_id() { return (unsigned)__builtin_amdgcn_s_getreg((3 << 11) | 20) & 0xFu; }
#define XB_SPIN(cond, bar) do { unsigned _sp = 0; while (cond) { __builtin_amdgcn_s_sleep(1); \
    if ((++_sp & 255u) == 0u) { if (xb_ld(&(bar)[XB_TMO])) break; if (_sp > XB_SPIN_CAP) { atomicAdd(&(bar)[XB_TMO], 1u); break; } } } } while (0)

struct XcdBarrier {
    unsigned* bar; unsigned x;
    volatile LAS unsigned* st;
};

__device__ __forceinline__ XcdBarrier xcd_barrier_post(unsigned* bar, volatile LAS unsigned* st) {
    XcdBarrier b; b.bar = bar; b.x = xb_xcc_id(); b.st = st;
    if (threadIdx.x == 0) (void)xb_add(&bar[XB_XCNT(b.x)], 1u);
    return b;
}
__device__ __forceinline__ void xcd_barrier_complete(unsigned* bar, unsigned x, unsigned& nloc, unsigned& nx) {
    const unsigned G = gridDim.x * gridDim.y * gridDim.z;
    unsigned sum, cnt, mine, sp = 0u;
    for (;;) {
        sum = 0u; cnt = 0u; mine = 0u;
#pragma unroll
        for (unsigned j = 0; j < 16; ++j) { const unsigned c = xb_ld(&bar[XB_XCNT(j)]); sum += c; cnt += (c > 0u) ? 1u : 0u; mine = (j == x) ? c : mine; }
        if (sum == G) break;
        __builtin_amdgcn_s_sleep(1);
        if ((++sp & 255u) == 0u) { if (xb_ld(&bar[XB_TMO])) break; if (sp > XB_SPIN_CAP) { atomicAdd(&bar[XB_TMO], 1u); break; } }
    }
    nloc = mine > 0u ? mine : 1u; nx = cnt > 0u ? cnt : 1u;
}

__device__ __forceinline__ void xcd_barrier(const XcdBarrier& b) {
    asm volatile("s_waitcnt vmcnt(0)" ::: "memory");
    __syncthreads();
    if (threadIdx.x == 0) {
        unsigned* bar = b.bar;
        __builtin_amdgcn_s_waitcnt(0);
        unsigned nloc = b.st[0], nx = b.st[1];
        if (nloc == 0u) { xcd_barrier_complete(bar, b.x, nloc, nx); b.st[0] = nloc; b.st[1] = nx; }
        const unsigned old = xb_add(&bar[XB_XSUB(b.x)], 1u);
        const unsigned gen = old / nloc;
        if (old + 1u == (gen + 1u) * nloc) {
            __builtin_amdgcn_fence(__ATOMIC_RELEASE, "agent");
            asm volatile("s_waitcnt vmcnt(0)" ::: "memory");
            const unsigned og = xb_add(&bar[XB_TOP], 1u);
            const unsigned tg = og / nx;
            if (og + 1u == (tg + 1u) * nx) xb_add(&bar[XB_TOPGEN], 1u);
            else XB_SPIN(xb_ld(&bar[XB_TOPGEN]) == tg, bar);
            __builtin_amdgcn_fence(__ATOMIC_ACQUIRE, "agent");
            xb_add(&bar[XB_XGEN(b.x)], 1u);
            asm volatile("s_waitcnt vmcnt(0)" ::: "memory");
        } else {
            XB_SPIN(xb_ld(&bar[XB_XGEN(b.x)]) == gen, bar);
            __builtin_amdgcn_fence(__ATOMIC_ACQUIRE, "agent");
            asm volatile("s_waitcnt vmcnt(0)" ::: "memory");
        }
    }
    __syncthreads();
}

struct Args { const float* in[22]; float* out; unsigned char* ws; };
enum { I_XP = 0, I_XS, I_SP, I_CK, I_CV, I_CL, I_GMIX, I_GFFN, I_PW, I_PS, I_GKV, I_WK, I_WV, I_WF, I_BF, I_GKN, I_WQ, I_GQN, I_WO, I_WG, I_WU, I_WD };

template <int W> __device__ __forceinline__ void pool_item(const float* xb_, const float* rstd, const float* sp_, int t0, bool smp, f32x4 gm, bf16* pb_, float* ps_, int pst) {
    f32x4 halo[W - 1], mn[16];
    if (t0 > 0) {
#pragma unroll
        for (int i = 0; i < W - 1; ++i) { const int t = t0 - (W - 1) + i; halo[i] = (*(const f32x4*)(xb_ + (size_t)t * 1024) * rstd[t]) * gm; }
    } else if (smp) {
#pragma unroll
        for (int i = 0; i < W - 1; ++i) halo[i] = *(const f32x4*)(sp_ + (size_t)(15 - (W - 1) + i) * 1024);
    } else {
#pragma unroll
        for (int i = 0; i < W - 1; ++i) halo[i] = (f32x4){0.f, 0.f, 0.f, 0.f};
    }
#pragma unroll
    for (int r = 0; r < 16; ++r) mn[r] = (*(const f32x4*)(xb_ + (size_t)(t0 + r) * 1024) * rstd[t0 + r]) * gm;
    f32x4 s = {0.f, 0.f, 0.f, 0.f};
#pragma unroll
    for (int i = 0; i < W - 1; ++i) s += halo[i];
#pragma unroll
    for (int r = 0; r < 16; ++r) {
        const int t = t0 + r; s += mn[r];
        const int cnt = (smp || t + 1 >= W) ? W : t + 1;
        const f32x4 p = s * (1.0f / (float)cnt) - mn[r];
        v2u pw; pw.x = pk2(p[0], p[1]); pw.y = pk2(p[2], p[3]);
        *(v2u*)(pb_ + (size_t)r * 1024) = pw;
        if (t >= pst) *(f32x4*)(ps_ + (size_t)(t - pst) * 1024) = mn[r];
        s -= (r - (W - 1) >= 0) ? mn[r - (W - 1) >= 0 ? r - (W - 1) : 0] : halo[r < W - 1 ? r : 0];
    }
}

template <int W> __device__ __forceinline__ void pool_step(const f32x4 (&prev)[16], const f32x4 (&mn)[16], int t0, bool smp, bf16* pb_, float* ps_, int pst) {
    f32x4 s = {0.f, 0.f, 0.f, 0.f};
#pragma unroll
    for (int i = 0; i < W - 1; ++i) s += prev[16 - (W - 1) + i];
#pragma unroll
    for (int r = 0; r < 16; ++r) {
        const int t = t0 + r; s += mn[r];
        const int cnt = (smp || t + 1 >= W) ? W : t + 1;
        const f32x4 p = s * (1.0f / (float)cnt) - mn[r];
        v2u pw; pw.x = pk2(p[0], p[1]); pw.y = pk2(p[2], p[3]);
        *(v2u*)(pb_ + (size_t)r * 1024) = pw;
        if (t >= pst) *(f32x4*)(ps_ + (size_t)(t - pst) * 1024) = mn[r];
        s -= (r - (W - 1) >= 0) ? mn[r - (W - 1) >= 0 ? r - (W - 1) : 0] : prev[(16 - (W - 1) + r) < 16 ? (16 - (W - 1) + r) : 0];
    }
}

__device__ __forceinline__ void sample_attn(int b, int h, const float* ck, const float* cv, const bf16* KB, const bf16* VB, const bf16* QB, const float* dks, bf16* OB,
                                            LAS unsigned char* lds, int tid, int lane, int wid) {
    constexpr int RS = 144;
    LAS unsigned char* Ks = lds; LAS unsigned char* Vs = lds + 128 * RS; LAS float* comb = (LAS float*)(lds + 2 * 128 * RS);
    const int r32 = lane & 31, hi = lane >> 5, qh = wid & 1, kg = wid >> 1;
    const int qrow = MP + b * 64 + qh * 32 + r32;
    bf16x8 qf[4];
#pragma unroll
    for (int d0 = 0; d0 < 4; ++d0) qf[d0] = *(const bf16x8*)(QB + (size_t)qrow * 1024 + h * 64 + d0 * 16 + hi * 8);
    const int qpos = PAST + qh * 32 + r32; const float dq2 = dks[qpos];
    float m = -1e30f, l = 0.f; f32x16 o0 = {}, o1 = {};
    const int kk = tid >> 2, dseg = (tid & 3) * 16;
    f32x4 kr[4], vr[4];
#define SA_LOAD(c) do { const int j_ = 128 * (c) + kk; \
        if (j_ < PAST) { const f32x4* pk_ = (const f32x4*)(ck + (((size_t)b * PAST + j_) * 16 + h) * 64 + dseg); const f32x4* pv_ = (const f32x4*)(cv + (((size_t)b * PAST + j_) * 16 + h) * 64 + dseg); \
            _Pragma("unroll") for (int i_ = 0; i_ < 4; ++i_) { kr[i_] = pk_[i_]; vr[i_] = pv_[i_]; } } \
        else if (j_ < KVS) { const v4u* pk_ = (const v4u*)(KB + (size_t)(MP + b * 64 + j_ - PAST) * 1024 + h * 64 + dseg); const v4u* pv_ = (const v4u*)(VB + (size_t)(MP + b * 64 + j_ - PAST) * 1024 + h * 64 + dseg); \
            _Pragma("unroll") for (int i_ = 0; i_ < 2; ++i_) { const v4u a_ = pk_[i_], c_ = pv_[i_]; \
                kr[2 * i_] = (f32x4){__uint_as_float(a_.x << 16), __uint_as_float(a_.x & 0xffff0000u), __uint_as_float(a_.y << 16), __uint_as_float(a_.y & 0xffff0000u)}; \
                kr[2 * i_ + 1] = (f32x4){__uint_as_float(a_.z << 16), __uint_as_float(a_.z & 0xffff0000u), __uint_as_float(a_.w << 16), __uint_as_float(a_.w & 0xffff0000u)}; \
                vr[2 * i_] = (f32x4){__uint_as_float(c_.x << 16), __uint_as_float(c_.x & 0xffff0000u), __uint_as_float(c_.y << 16), __uint_as_float(c_.y & 0xffff0000u)}; \
                vr[2 * i_ + 1] = (f32x4){__uint_as_float(c_.z << 16), __uint_as_float(c_.z & 0xffff0000u), __uint_as_float(c_.w << 16), __uint_as_float(c_.w & 0xffff0000u)}; } } \
        else { _Pragma("unroll") for (int i_ = 0; i_ < 4; ++i_) { kr[i_] = (f32x4){0.f, 0.f, 0.f, 0.f}; vr[i_] = (f32x4){0.f, 0.f, 0.f, 0.f}; } } } while (0)
    SA_LOAD(0);
    for (int c = 0; c < 9; ++c) {
        __syncthreads();
        {
            v4u a, bq;
            a.x = pk2(kr[0][0], kr[0][1]); a.y = pk2(kr[0][2], kr[0][3]); a.z = pk2(kr[1][0], kr[1][1]); a.w = pk2(kr[1][2], kr[1][3]);
            bq.x = pk2(kr[2][0], kr[2][1]); bq.y = pk2(kr[2][2], kr[2][3]); bq.z = pk2(kr[3][0], kr[3][1]); bq.w = pk2(kr[3][2], kr[3][3]);
            *(LAS v4u*)(Ks + kk * RS + dseg * 2) = a; *(LAS v4u*)(Ks + kk * RS + dseg * 2 + 16) = bq;
            a.x = pk2(vr[0][0], vr[0][1]); a.y = pk2(vr[0][2], vr[0][3]); a.z = pk2(vr[1][0], vr[1][1]); a.w = pk2(vr[1][2], vr[1][3]);
            bq.x = pk2(vr[2][0], vr[2][1]); bq.y = pk2(vr[2][2], vr[2][3]); bq.z = pk2(vr[3][0], vr[3][1]); bq.w = pk2(vr[3][2], vr[3][3]);
            *(LAS v4u*)(Vs + kk * RS + dseg * 2) = a; *(LAS v4u*)(Vs + kk * RS + dseg * 2 + 16) = bq;
        }
        __syncthreads();
        if (c + 1 < 9) SA_LOAD(c + 1);
        const int kvb = 128 * c + 32 * kg;
        if (kvb < KVS) {
            f32x16 s = {};
#pragma unroll
            for (int d0 = 0; d0 < 4; ++d0) { const bf16x8 kf = *(const LAS bf16x8*)(Ks + (32 * kg + r32) * RS + (d0 * 16 + hi * 8) * 2); s = __builtin_amdgcn_mfma_f32_32x32x16_bf16(kf, qf[d0], s, 0, 0, 0); }
            float mx = -1e30f;
#pragma unroll
            for (int jj = 0; jj < 4; ++jj) { const f32x4 dk = *(const f32x4*)(dks + kvb + 8 * jj + 4 * hi);
#pragma unroll
                for (int e = 0; e < 4; ++e) { const int kv = kvb + 8 * jj + 4 * hi + e; float x = s[4 * jj + e] + dq2 - dk[e]; x = (kv > qpos) ? -1e30f : x; s[4 * jj + e] = x; mx = fmaxf(mx, x); } }
            mx = fmaxf(mx, __shfl_xor(mx, 32));
            const float mn = fmaxf(m, mx), alpha = __builtin_amdgcn_exp2f(m - mn); m = mn;
            float ps = 0.f;
#pragma unroll
            for (int r = 0; r < 16; ++r) { s[r] = __builtin_amdgcn_exp2f(s[r] - mn); ps += s[r]; }
            l = l * alpha + ps; o0 = o0 * alpha; o1 = o1 * alpha;
#pragma unroll
            for (int ks = 0; ks < 2; ++ks) {
                v4u pw; pw.x = pk2(s[8 * ks], s[8 * ks + 1]); pw.y = pk2(s[8 * ks + 2], s[8 * ks + 3]); pw.z = pk2(s[8 * ks + 4], s[8 * ks + 5]); pw.w = pk2(s[8 * ks + 6], s[8 * ks + 7]);
                const bf16x8 pb = __builtin_bit_cast(bf16x8, pw);
#pragma unroll
                for (int dh = 0; dh < 2; ++dh) { bf16x8 va;
#pragma unroll
                    for (int i = 0; i < 8; ++i) va[i] = *(const LAS short*)(Vs + (32 * kg + crow(8 * ks + i, hi)) * RS + (dh * 32 + r32) * 2);
                    if (dh == 0) o0 = __builtin_amdgcn_mfma_f32_32x32x16_bf16(va, pb, o0, 0, 0, 0); else o1 = __builtin_amdgcn_mfma_f32_32x32x16_bf16(va, pb, o1, 0, 0, 0); }
            }
        }
    }
#undef SA_LOAD
    l += __shfl_xor(l, 32);
    LAS float* cw = comb + wid * (32 * 66) + r32 * 66;
#pragma unroll
    for (int r = 0; r < 16; ++r) { cw[crow(r, hi)] = o0[r]; cw[32 + crow(r, hi)] = o1[r]; }
    if (hi == 0) { cw[64] = m; cw[65] = l; }
    __syncthreads();
    {
        const int q64 = tid >> 3, d8 = (tid & 7) * 8, qh2 = q64 >> 5, ql = q64 & 31;
        float M = -1e30f;
#pragma unroll
        for (int g = 0; g < 4; ++g) M = fmaxf(M, comb[(g * 2 + qh2) * (32 * 66) + ql * 66 + 64]);
        float den = 0.f, a8[8];
#pragma unroll
        for (int e = 0; e < 8; ++e) a8[e] = 0.f;
#pragma unroll
        for (int g = 0; g < 4; ++g) { const LAS float* base = comb + (g * 2 + qh2) * (32 * 66) + ql * 66; const float w = __builtin_amdgcn_exp2f(base[64] - M); den += w * base[65];
#pragma unroll
            for (int e = 0; e < 8; ++e) a8[e] += w * base[d8 + e]; }
        const float inv = 1.0f / den;
        v4u w; w.x = pk2(a8[0] * inv, a8[1] * inv); w.y = pk2(a8[2] * inv, a8[3] * inv); w.z = pk2(a8[4] * inv, a8[5] * inv); w.w = pk2(a8[6] * inv, a8[7] * inv);
        *(v4u*)(OB + (size_t)(MP + b * 64 + q64) * 1024 + h * 64 + d8) = w;
    }
    __syncthreads();
}

#ifndef PG_ALIGN
#define PG_ALIGN true
#endif
#ifndef PH_MASK
#define PH_MASK 0xFFFF
#endif
#define RUN(p) (((PH_MASK) >> (p)) & 1)
#ifndef REP_MASK
#define REP_MASK 0
#endif
#define NREP(p) (1 + (((REP_MASK) >> (p)) & 1))

__global__ void __launch_bounds__(512, 2) mega(Args a) {
    extern __shared__ __attribute__((aligned(16))) unsigned char lds_raw[];
    cg::grid_group grid = cg::this_grid();
    LAS unsigned char* lds = (LAS unsigned char*)lds_raw;
    const int G = gridDim.x;
    int vcu;
    {
        LAS int* vs = (LAS int*)(lds_raw + LDS_BYTES - 16);
        if (threadIdx.x == 0) {
            unsigned* cen = (unsigned*)(a.ws + WS_CTL);
            const unsigned xcc = (unsigned)__builtin_amdgcn_s_getreg((3 << 11) | 20) & 7u;
            const unsigned rank = __hip_atomic_fetch_add(cen + 64 * xcc, 1u, __ATOMIC_RELAXED, __HIP_MEMORY_SCOPE_AGENT);
            vs[0] = (G == 256 && rank < 32u) ? (int)(xcc + 8u * rank) : -1;
        }
        __syncthreads();
        vcu = __builtin_amdgcn_readfirstlane(vs[0]);
        if (threadIdx.x == 0) { vs[1] = 0; vs[2] = 0; }
        __syncthreads();
    }
#define PHASE_ENTER() int tid_o = threadIdx.x; asm volatile("" : "+v"(tid_o)); const int tid = tid_o, lane = tid & 63, wave = __builtin_amdgcn_readfirstlane(tid >> 6); (void)lane; (void)wave; \
    int bx_o = blockIdx.x; asm volatile("" : "+s"(bx_o)); const int bx = bx_o; size_t zo_ = 0; asm volatile("" : "+s"(zo_)); unsigned char* ws = a.ws + zo_; float* out = a.out + zo_; \
    const float* xp = a.in[I_XP]; const float* xs = a.in[I_XS]; (void)xp; (void)xs; \
    bf16* WPOOL = (bf16*)(ws + WS_WPOOL); bf16* WKVQ = (bf16*)(ws + WS_WKVQ); bf16* WOT = (bf16*)(ws + WS_WO); \
    float* RSTD = (float*)(ws + WS_RSTD); float* SSQ = (float*)(ws + WS_SSQ); float* DK2 = (float*)(ws + WS_DK2); float* DKS = (float*)(ws + WS_DKS); \
    bf16* XB = (bf16*)(ws + WS_XB); bf16* PB = (bf16*)(ws + WS_PB); bf16* OB = PB; bf16* ACT = (bf16*)(ws + WS_R1); \
    bf16* QB = (bf16*)(ws + WS_QB); bf16* KB = (bf16*)(ws + WS_KB); bf16* VB = (bf16*)(ws + WS_VB); \
    (void)WPOOL; (void)WKVQ; (void)WOT; (void)RSTD; (void)SSQ; (void)DK2; (void)DKS; (void)XB; (void)PB; (void)OB; (void)ACT; (void)QB; (void)KB; (void)VB;
    (void)xcd_barrier_post((unsigned*)(a.ws + WS_CTL + 4096), (volatile LAS unsigned*)(lds_raw + LDS_BYTES - 12));
#define GSYNC() do { size_t zb_ = 0; asm volatile("" : "+s"(zb_)); XcdBarrier xb_; xb_.bar = (unsigned*)(a.ws + WS_CTL + 4096) + zb_; xb_.x = xb_xcc_id(); xb_.st = (volatile LAS unsigned*)(lds_raw + LDS_BYTES - 12); xcd_barrier(xb_); } while (0)
#define GSYNC0() do { asm volatile("s_waitcnt vmcnt(0)" ::: "memory"); grid.sync(); __builtin_amdgcn_fence(__ATOMIC_ACQUIRE, "agent"); asm volatile("s_waitcnt vmcnt(0)" ::: "memory"); } while (0)

    grid.sync();
    for (int rep_ = 0; rep_ < NREP(0); ++rep_) { if (rep_) GSYNC(); PHASE_ENTER();
        LAS float* scr = (LAS float*)(lds + wave * 16384);
        const int gw = bx * 8 + wave, NGW = G * 8;
        constexpr int I_POOL = 4 * 32, I_GU = 16 * 88, I_DN = 44 * 32, I_SQ = 16 * 32;
        constexpr int NITEMS = I_POOL + 4 * I_GU + 2 * I_DN + 4 * I_SQ;
        for (int it = gw; it < NITEMS; it += NGW) {
            int r = it;
            if (r < I_POOL) { const int mtx = r >> 5; transpose_item(a.in[I_PW] + (size_t)mtx * 65536, 256, 256, WPOOL, RmOff{mtx * 256}, nullptr, a.in[I_PS] + mtx * 256, scr, r & 31, lane); continue; } r -= I_POOL;
            if (r < 4 * I_GU) { const int mtx = r / I_GU, l = mtx >> 1, up = mtx & 1; transpose_item((up ? a.in[I_WU] : a.in[I_WG]) + (size_t)l * 1024 * 2816, 1024, 2816, (bf16*)(ws + (l ? WS_WGU1 : WS_WGU0)), RmGU{up}, a.in[I_GFFN] + l * 1024, nullptr, scr, r % I_GU, lane); continue; } r -= 4 * I_GU;
            if (r < 2 * I_DN) { const int l = r / I_DN; transpose_item(a.in[I_WD] + (size_t)l * 2816 * 1024, 2816, 1024, (bf16*)(ws + (l ? WS_WDN1 : WS_WDN0)), RmOff{0}, nullptr, nullptr, scr, r % I_DN, lane); continue; } r -= 2 * I_DN;
            if (r < I_SQ) { transpose_item(a.in[I_WK], 1024, 1024, WKVQ, RmKVQ{0}, a.in[I_GKV], nullptr, scr, r, lane); continue; } r -= I_SQ;
            if (r < I_SQ) { transpose_item(a.in[I_WV], 1024, 1024, WKVQ, RmKVQ{1024}, a.in[I_GKV], nullptr, scr, r, lane); continue; } r -= I_SQ;
            if (r < I_SQ) { transpose_item(a.in[I_WQ], 1024, 1024, WKVQ, RmKVQ{2048}, a.in[I_GMIX] + 1024, nullptr, scr, r, lane); continue; } r -= I_SQ;
            transpose_item(a.in[I_WO], 1024, 1024, WOT, RmOff{0}, nullptr, nullptr, scr, r, lane);
        }
        const int gt = bx * 512 + tid, NT = G * 512;
        for (int i = gt; i < 16 * 1024; i += NT) { const int n = i >> 10, k = i & 1023; WKVQ[(size_t)(3072 + n) * 1024 + k] = (bf16)(pk2(a.in[I_WF][k * 16 + n] * a.in[I_GKV][k], 0.f) & 0xffffu); }
        if (gt < 192) ((float*)(ws + WS_GN))[gt] = gt < 64 ? a.in[I_GKN][gt] : gt < 128 ? 1.0f : a.in[I_GQN][gt - 128] * (0.125f * LOG2E);
        for (int i = gt; i < 240 * 1024 / 8; i += NT) ((v4u*)(WKVQ + (size_t)3088 * 1024))[i] = (v4u){0u, 0u, 0u, 0u};
    }
    __syncthreads();

    for (int rep_ = 0; rep_ < NREP(1); ++rep_) { if (rep_) GSYNC(); PHASE_ENTER();
        const int half = tid >> 8, c4 = (tid & 255) * 4, grp = __builtin_amdgcn_readfirstlane(c4 >> 8), wq = (tid >> 6) & 3;
        const f32x4 gm = *(const f32x4*)(a.in[I_GMIX] + c4);
        LAS float* redb = (LAS float*)lds + half * 64; int par = 0;
        f32x4 prev[16], raw[16]; float rs[16];
#define P1_LOAD(src, t_first) do { _Pragma("unroll") for (int r_ = 0; r_ < 16; ++r_) raw[r_] = *(const f32x4*)((src) + (size_t)((t_first) + r_) * 1024); } while (0)
#define P1_RSTD(valid) do { float ss_[16]; \
            _Pragma("unroll") for (int r_ = 0; r_ < 16; ++r_) { const f32x4 v_ = raw[r_]; ss_[r_] = (valid) ? wave_sum((v_[0] * v_[0] + v_[1] * v_[1]) + (v_[2] * v_[2] + v_[3] * v_[3])) : 0.f; } \
            LAS float* red_ = redb + par * 128; par ^= 1; \
            if (lane == 0) { _Pragma("unroll") for (int r_ = 0; r_ < 16; r_ += 4) *(LAS f32x4*)(red_ + wq * 16 + r_) = (f32x4){ss_[r_], ss_[r_ + 1], ss_[r_ + 2], ss_[r_ + 3]}; } \
            __syncthreads(); \
            _Pragma("unroll") for (int r_ = 0; r_ < 16; ++r_) rs[r_] = __builtin_amdgcn_rsqf(((red_[r_] + red_[16 + r_]) + (red_[32 + r_] + red_[48 + r_])) * (1.0f / 1024.0f) + 1e-6f); } while (0)
#define P1_STEP(t0_, smp_, pb_, ps_, pst_) do { if (grp == 0) pool_step<2>(prev, raw, t0_, smp_, pb_, ps_, pst_); else if (grp == 1) pool_step<4>(prev, raw, t0_, smp_, pb_, ps_, pst_); \
            else if (grp == 2) pool_step<8>(prev, raw, t0_, smp_, pb_, ps_, pst_); else pool_step<16>(prev, raw, t0_, smp_, pb_, ps_, pst_); } while (0)
        for (int run = bx * 2 + half; run < 512; run += G * 2) {
            const int row0 = run * 128, b = row0 >> 12, tr = row0 & 4095;
            const float* xb_ = xp + (size_t)(row0 - tr) * 1024 + c4;
            float* ps_ = out + pg8::O_PSP + (size_t)b * 15 * 1024 + c4;
            if (tr > 0) P1_LOAD(xb_, tr - 16);
            P1_RSTD(tr > 0);
#pragma unroll
            for (int r = 0; r < 16; ++r) prev[r] = (tr > 0) ? (raw[r] * rs[r]) * gm : (f32x4){0.f, 0.f, 0.f, 0.f};
            for (int st = 0; st < 8; ++st) {
                const int t0 = tr + 16 * st;
                P1_LOAD(xb_, t0);
                P1_RSTD(true);
#pragma unroll
                for (int r = 0; r < 16; ++r) raw[r] = (raw[r] * rs[r]) * gm;
                P1_STEP(t0, false, PB + (size_t)(row0 + 16 * st) * 1024 + c4, ps_, 4081);
#pragma unroll
                for (int r = 0; r < 16; ++r) prev[r] = raw[r];
            }
        }
        for (int si = bx * 2 + half; si < 64; si += G * 2) {
            const int b = si >> 2, t0 = 16 * (si & 3);
            const float* xb_ = xs + (size_t)b * 64 * 1024 + c4;
            const float* sp_ = a.in[I_SP] + (size_t)b * 15 * 1024 + c4;
            if (t0 > 0) P1_LOAD(xb_, t0 - 16);
            P1_RSTD(t0 > 0);
            if (t0 > 0) {
#pragma unroll
                for (int r = 0; r < 16; ++r) prev[r] = (raw[r] * rs[r]) * gm;
            } else {
                prev[0] = (f32x4){0.f, 0.f, 0.f, 0.f};
#pragma unroll
                for (int r = 1; r < 16; ++r) prev[r] = *(const f32x4*)(sp_ + (size_t)(r - 1) * 1024);
            }
            P1_LOAD(xb_, t0);
            P1_RSTD(true);
#pragma unroll
            for (int r = 0; r < 16; ++r) raw[r] = (raw[r] * rs[r]) * gm;
            P1_STEP(t0, true, PB + (size_t)(MP + 16 * si) * 1024 + c4, out + pg8::O_PSS + (size_t)b * 15 * 1024 + c4, 49);
        }
#undef P1_LOAD
#undef P1_RSTD
#undef P1_STEP
    }
    GSYNC();
    {
        const unsigned* cen = (const unsigned*)(a.ws + WS_CTL); bool okc = (G == 256);
#pragma unroll
        for (int x = 0; x < 8; ++x) okc = okc && (__hip_atomic_load(cen + 64 * x, __ATOMIC_RELAXED, __HIP_MEMORY_SCOPE_AGENT) == 32u);
        if (!okc) vcu = blockIdx.x;
    }

    for (int rep_ = 0; rep_ < NREP(2); ++rep_) { if (rep_) GSYNC(); PHASE_ENTER();
        pg8::Gemm g{PB, WPOOL, MT, 1024, 256, 1024, 256}; pg8::StaticOrder S; S.init(MP, 1024, G, vcu);
        pg8::EpiRes<true, false, false> E{xp, xs, out, XB, SSQ, nullptr};
        pg8::gemm_phase<pg8::EpiRes<true, false, false>, pg8::StaticOrder, PG_ALIGN, true>(lds, g, S, E);
    }
    GSYNC();

    for (int l = 0; l < 2; ++l) {
        if (l == 1) {
            for (int rep_ = 0; rep_ < NREP(5); ++rep_) { if (rep_) GSYNC(); PHASE_ENTER();
                pg8::Gemm g{XB, WKVQ, MT, 3328, 1024, 1024, 0}; pg8::StaticOrder S; S.init(MP, 3328, G, vcu);
                pg8::EpiKVQ E{SSQ, (const float*)(ws + WS_GN), a.in[I_BF], out, KB, (size_t)(130 * MiB / 2)};
                pg8::gemm_phase<pg8::EpiKVQ, pg8::StaticOrder, PG_ALIGN, true>(lds, g, S, E);
            }
            GSYNC();
            for (int rep_ = 0; rep_ < NREP(7); ++rep_) { if (rep_) GSYNC(); PHASE_ENTER();
                const float mq = wave_max(fabsf(a.in[I_GQN][lane])), mk = wave_max(fabsf(a.in[I_GKN][lane]));
                const float lowc = -(0.125f * LOG2E * 64.f) * mq * mk;
                for (int u = bx; u < 256; u += G) {
                    const int b = u >> 4, h = u & 15;
                    {
                        const float* lp = out + pg8::O_LP + ((size_t)b * 4096 + 8 * tid) * 16 + h; float v[8];
#pragma unroll
                        for (int k = 0; k < 8; ++k) v[k] = lp[(size_t)k * 16];
#pragma unroll
                        for (int k = 1; k < 8; ++k) v[k] += v[k - 1];
                        float inc = v[7];
#pragma unroll
                        for (int o = 1; o < 64; o <<= 1) { const float t = __shfl_up(inc, o); if (lane >= o) inc += t; }
                        LAS float* wt = (LAS float*)(lds + DK_OFF + 16384);
                        if (lane == 63) wt[wave] = inc;
                        __syncthreads();
                        float pre = 0.f;
#pragma unroll
                        for (int w = 0; w < 8; ++w) pre += (w < wave) ? wt[w] : 0.f;
                        const float ex = pre + inc - v[7];
                        LAS f32x4* dstl = (LAS f32x4*)(lds + DK_OFF) + 2 * tid;
                        dstl[0] = (f32x4){(v[0] + ex) * LOG2E, (v[1] + ex) * LOG2E, (v[2] + ex) * LOG2E, (v[3] + ex) * LOG2E};
                        dstl[1] = (f32x4){(v[4] + ex) * LOG2E, (v[5] + ex) * LOG2E, (v[6] + ex) * LOG2E, (v[7] + ex) * LOG2E};
                    }
                    __syncthreads();
                    for (int qb = 15; qb >= 0; --qb) {
                        const LAS float* dl = (const LAS float*)(lds + DK_OFF);
                        const float thr = dl[256 * qb] - 2.f * lowc + 45.f;
                        const int jmax = 4 * qb;
                        const bool sk = (lane < jmax) && (dl[64 * lane + 63] > thr);
                        const int t0 = (int)__builtin_popcountll(__ballot(sk)) & ~1;
                        attn_body::attn_unit<8>(b, h, qb, (const attn_body::bf16*)QB, (const attn_body::bf16*)KB, (const attn_body::bf16*)VB, (attn_body::bf16*)OB, (char*)lds_raw,
                                                (const LAS float*)(lds + DK_OFF), lowc, t0);
                    }
                    __syncthreads();
                }
            }
            for (int rep_ = 0; rep_ < NREP(7); ++rep_) { if (rep_) GSYNC(); PHASE_ENTER();
                for (int u = bx; u < 256; u += G) {
                    {
                        const int b = u >> 4, h = u & 15; const float* ls = out + pg8::O_LS + (size_t)b * 64 * 16 + h; const float* cl = a.in[I_CL] + (size_t)b * 1024 * 16 + h; float v[4];
#pragma unroll
                        for (int k = 0; k < 4; ++k) { const int j = 4 * tid + k; v[k] = j < PAST ? cl[(size_t)j * 16] : (j < KVS ? ls[(size_t)(j - PAST) * 16] : 0.f); }
#pragma unroll
                        for (int k = 1; k < 4; ++k) v[k] += v[k - 1];
                        float inc = v[3];
#pragma unroll
                        for (int o = 1; o < 64; o <<= 1) { const float t = __shfl_up(inc, o); if (lane >= o) inc += t; }
                        LAS float* wt = (LAS float*)(lds + DK_OFF + 16384);
                        if (lane == 63) wt[wave] = inc;
                        __syncthreads();
                        float pre = 0.f;
#pragma unroll
                        for (int w = 0; w < 8; ++w) pre += (w < wave) ? wt[w] : 0.f;
                        const float ex = pre + inc - v[3];
                        if (4 * tid < KVS) *(f32x4*)(DKS + (size_t)u * KVS + 4 * tid) = (f32x4){(v[0] + ex) * LOG2E, (v[1] + ex) * LOG2E, (v[2] + ex) * LOG2E, (v[3] + ex) * LOG2E};
                        asm volatile("s_waitcnt vmcnt(0)" ::: "memory"); __syncthreads();
                    }
                    sample_attn(u >> 4, u & 15, a.in[I_CK], a.in[I_CV], (bf16*)(ws + WS_KVQS) - (size_t)MP * 1024, (bf16*)(ws + WS_KVQS + 2 * MiB) - (size_t)MP * 1024, (bf16*)(ws + WS_KVQS + 4 * MiB) - (size_t)MP * 1024, DKS + (size_t)u * KVS, OB, lds, tid, lane, wave);
                }
            }
            GSYNC();
            for (int rep_ = 0; rep_ < NREP(8); ++rep_) { if (rep_) GSYNC(); PHASE_ENTER();
                pg8::Gemm g{OB, WOT, MT, 1024, 1024, 1024, 0}; pg8::StaticOrder S; S.init(MP, 1024, G, vcu);
                pg8::EpiRes<true, true, false> E{out, out + (size_t)MP * 1024, out, XB, SSQ, nullptr};
                pg8::gemm_phase<pg8::EpiRes<true, true, false>, pg8::StaticOrder, PG_ALIGN, true>(lds, g, S, E);
            }
            GSYNC();
        }
#define SROLE_NB(v) ((v) < 16 ? 0 : (v) < 104 ? 2 : (v) < 120 ? 5 : ((v) < 172 && l == 0) ? 9 : 0)
        {
            PHASE_ENTER();
            pg8::Gemm g{XB, (bf16*)(ws + (l ? WS_WGU1 : WS_WGU0)), MT, 5632, 1024, 1024, 0}; pg8::StaticOrder base; base.init(MP, 5632, G, vcu);
            pg8::EpiGU E{SSQ, ACT};
            pg8::RangeOrder S{base, 0, SROLE_NB(vcu), -1, 0};
            pg8::gemm_phase<pg8::EpiGU, pg8::RangeOrder, PG_ALIGN, true>(lds, g, S, E);
        }
        if (vcu < 120 || (vcu < 172 && l == 0)) {
            PHASE_ENTER();
            int role, sidx;
            if (vcu < 16) { role = 1; sidx = vcu; } else if (vcu < 104) { role = 2; sidx = vcu - 16; } else if (vcu < 120) { role = 3; sidx = vcu - 104; } else { role = 4; sidx = vcu - 120; }
            unsigned* cnt = (unsigned*)(ws + WS_CTL + 32768) + l * 256;
            if (role > 1) {
                if (tid == 0) { const unsigned need = role == 3 ? 88u : 16u; unsigned sp = 0;
                    while (__hip_atomic_load(cnt + 64 * (role - 2), __ATOMIC_RELAXED, __HIP_MEMORY_SCOPE_AGENT) < need && ++sp < (1u << 22)) __builtin_amdgcn_s_sleep(2);
                    __builtin_amdgcn_fence(__ATOMIC_ACQUIRE, "agent"); asm volatile("s_waitcnt vmcnt(0)" ::: "memory"); }
                __syncthreads();
            }
            if (role == 1) {
                pg8::OneUnit S1{256 + (sidx >> 2), sidx & 3};
                if (l) { pg8::Gemm g2{OB, WOT, MT, 1024, 1024, 1024, 0}; pg8::EpiRes<true, true, false> E3{xp, xs, out, XB, SSQ, nullptr}; pg8::gemm_phase<pg8::EpiRes<true, true, false>, pg8::OneUnit, PG_ALIGN, true>(lds, g2, S1, E3); }
                else { pg8::Gemm g2{PB, WPOOL, MT, 1024, 256, 1024, 256}; pg8::EpiRes<true, false, false> E2{xp, xs, out, XB, SSQ, nullptr}; pg8::gemm_phase<pg8::EpiRes<true, false, false>, pg8::OneUnit, PG_ALIGN, true>(lds, g2, S1, E2); }
            } else if (role == 2) {
                pg8::Gemm g2{XB, (bf16*)(ws + (l ? WS_WGU1 : WS_WGU0)), MT, 5632, 1024, 1024, 0}; pg8::EpiGU E2{SSQ, ACT};
                pg8::OneUnit S1{256 + sidx / 22, sidx % 22};
                pg8::gemm_phase<pg8::EpiGU, pg8::OneUnit, PG_ALIGN, true>(lds, g2, S1, E2);
            } else if (role == 3) {
                pg8::Gemm g2{ACT, (bf16*)(ws + (l ? WS_WDN1 : WS_WDN0)), MT, 1024, 2816, 2816, 0}; pg8::OneUnit S1{256 + (sidx >> 2), sidx & 3};
                pg8::EpiRes<true, true, true> E2{out, out + (size_t)MP * 1024, out, XB, SSQ, nullptr};
                pg8::gemm_phase<pg8::EpiRes<true, true, true>, pg8::OneUnit, PG_ALIGN, true>(lds, g2, S1, E2);
            } else {
                pg8::Gemm g2{XB, WKVQ, MT, 3328, 1024, 1024, 0}; pg8::OneUnit S1{256 + sidx / 13, sidx % 13};
                pg8::EpiKVQ E2{SSQ, (const float*)(ws + WS_GN), a.in[I_BF], out, (bf16*)(ws + WS_KVQS) - (size_t)MP * 1024, (size_t)(2 * MiB / 2)};
                pg8::gemm_phase<pg8::EpiKVQ, pg8::OneUnit, PG_ALIGN, true>(lds, g2, S1, E2);
            }
            asm volatile("s_waitcnt vmcnt(0)" ::: "memory"); __syncthreads();
            if (tid == 0) { __builtin_amdgcn_fence(__ATOMIC_RELEASE, "agent"); asm volatile("s_waitcnt vmcnt(0)" ::: "memory");
                __hip_atomic_fetch_add(cnt + 64 * (role - 1), 1u, __ATOMIC_RELAXED, __HIP_MEMORY_SCOPE_AGENT); }
        }
        {
            PHASE_ENTER();
            pg8::Gemm g{XB, (bf16*)(ws + (l ? WS_WGU1 : WS_WGU0)), MT, 5632, 1024, 1024, 0}; pg8::StaticOrder base; base.init(MP, 5632, G, vcu);
            pg8::EpiGU E{SSQ, ACT};
            const bool dns = vcu >= 104 && vcu < 120, tk = vcu >= 172 && vcu < 188;
            pg8::RangeOrder S{base, SROLE_NB(vcu), dns ? 21 : 22, tk ? vcu - 172 + 104 : -1, 21};
            pg8::gemm_phase<pg8::EpiGU, pg8::RangeOrder, PG_ALIGN, true>(lds, g, S, E);
        }
#undef SROLE_NB
        GSYNC();
        for (int rep_ = 0; rep_ < NREP(4); ++rep_) { if (rep_) GSYNC(); PHASE_ENTER();
            pg8::Gemm g{ACT, (bf16*)(ws + (l ? WS_WDN1 : WS_WDN0)), MT, 1024, 2816, 2816, 0}; pg8::StaticOrder S; S.init(MP, 1024, G, vcu);
            if (l == 0) { pg8::EpiRes<true, true, false> E{out, out + (size_t)MP * 1024, out, XB, SSQ, nullptr}; pg8::gemm_phase<pg8::EpiRes<true, true, false>, pg8::StaticOrder, PG_ALIGN, true>(lds, g, S, E); }
            else { pg8::EpiRes<false, true, true> E{out, out + (size_t)MP * 1024, out, XB, nullptr, nullptr}; pg8::gemm_phase<pg8::EpiRes<false, true, true>, pg8::StaticOrder, PG_ALIGN, true>(lds, g, S, E); }
        }
        if (l == 0) GSYNC();
    }
}

extern "C" void kernel_launch(void* const* d_in, const int* in_sizes, int n_in, void* d_out, int out_size, void* d_ws, size_t ws_size, hipStream_t stream) {
    static int grid = 0;
    if (grid == 0) {
        if (n_in != 22 || (size_t)out_size != pg8::O_END || ws_size < WS_END) { fprintf(stderr, "kernel_launch: unexpected shapes: n_in %d out %d ws %zu (need %zu)\n", n_in, out_size, ws_size, (size_t)WS_END); grid = -1; return; }
        int dev = 0, cus = 0, per_cu = 0;
        (void)hipGetDevice(&dev); (void)hipDeviceGetAttribute(&cus, hipDeviceAttributeMultiprocessorCount, dev);
        if (hipFuncSetAttribute((const void*)mega, hipFuncAttributeMaxDynamicSharedMemorySize, LDS_BYTES) != hipSuccess) fprintf(stderr, "kernel_launch: hipFuncSetAttribute failed\n");
        if (hipOccupancyMaxActiveBlocksPerMultiprocessor(&per_cu, (const void*)mega, 512, LDS_BYTES) != hipSuccess || per_cu < 1) { fprintf(stderr, "kernel_launch: occupancy query says %d\n", per_cu); per_cu = 1; }
        (void)hipGetLastError();
        if (cus <= 0) cus = 256;
        grid = cus;
    }
    if (grid < 0) return;
    if (hipMemsetAsync((char*)d_ws + WS_CTL, 0, 65536, stream) != hipSuccess) { fprintf(stderr, "kernel_launch: memset failed\n"); return; }
    Args a{};
    for (int i = 0; i < 22; ++i) a.in[i] = (const float*)d_in[i];
    a.out = (float*)d_out; a.ws = (unsigned char*)d_ws;
    void* args[] = {&a};
    const hipError_t e = hipLaunchCooperativeKernel((const void*)mega, dim3(grid), dim3(512), args, LDS_BYTES, stream);
    if (e != hipSuccess) fprintf(stderr, "kernel_launch: cooperative launch failed: %s (grid %d)\n", hipGetErrorString(e), grid);
}
```

```cpp
#include <hip/hip_runtime.h>
#include <hip/hip_cooperative_groups.h>
#include <cstdio>
#include <cstdint>
namespace cg = cooperative_groups;
namespace pg8 {
#define PG8_LAS __attribute__((address_space(3)))
typedef unsigned short bf16_t;
typedef short bf16x8 __attribute__((ext_vector_type(8)));
typedef float f32x4 __attribute__((ext_vector_type(4)));
typedef unsigned u32x4 __attribute__((ext_vector_type(4)));
constexpr int BM = 256, BK = 64, HALF = 128, HTB = HALF * BK * 2  , STAGE_BYTES = 8 * HTB, NXCD = 8, WGM = 8;

__host__ __device__ __forceinline__ int lds_byte(int r, int c) { const int st = (r >> 4) * 2 + (c >> 5), rr = r & 15, cc = c & 31, ob = rr * 64 + cc * 2; return st * 1024 + (ob ^ (((ob >> 9) & 1) << 5)); }
__host__ __device__ __forceinline__ void stage_rc(int b, int& R, int& C) { const int st = b / 1024, sb = b % 1024, swz = sb ^ (((sb >> 9) & 1) << 5); R = (st >> 1) * 16 + swz / 64; C = (st & 1) * 32 + (swz % 64) / 2; }
__host__ __device__ __forceinline__ int perm32(int rho) { const int n = rho >> 4, i = rho & 15; return 8 * (i >> 2) + 4 * n + (i & 3); }

struct Unit { int pm, pn; };
struct Gemm { const bf16_t* A; const bf16_t* Bt; int M, N, K; int lda; int acol_pn; };

struct StaticOrder {
    int nM, nN, nwg, G, c;
    __host__ __device__ void init(int M, int N, int G_, int c_) { nM = M / BM; nN = N / BM; nwg = nM * nN; G = G_; c = c_; }
    __host__ __device__ bool next(int i, Unit& u) const {
        const long L = (long)i * G + c; if (L >= nwg) return false;
        int wgid = (int)L; { const int q = nwg / NXCD, r = nwg % NXCD, xcd = wgid % NXCD, off = wgid / NXCD; wgid = (xcd < r ? xcd * (q + 1) : r * (q + 1) + (xcd - r) * q) + off; }
        const int nig = WGM * nN, gid = wgid / nig, fm = gid * WGM, gsz = (nM - fm) < WGM ? (nM - fm) : WGM;
        u.pm = fm + ((wgid % nig) % gsz); u.pn = (wgid % nig) / gsz; return true;
    }
    __device__ __forceinline__ void a_ready(const Unit&) const {}
    __device__ __forceinline__ void done(const Unit&) const {}
};
__device__ __forceinline__ unsigned cvt_pk_bf16(float lo, float hi) { unsigned r; asm volatile("v_cvt_pk_bf16_f32 %0, %1, %2" : "=v"(r) : "v"(lo), "v"(hi)); return r; }
typedef float f32x2 __attribute__((ext_vector_type(2)));
typedef unsigned u32x2 __attribute__((ext_vector_type(2)));
typedef float f32x2e __attribute__((ext_vector_type(2))); typedef __bf16 bf16x2e __attribute__((ext_vector_type(2)));
__device__ __forceinline__ unsigned pkbf(float lo, float hi) { f32x2e v = {lo, hi}; bf16x2e b = __builtin_convertvector(v, bf16x2e); return __builtin_bit_cast(unsigned, b); }
__device__ __forceinline__ float xsum16(float s) { const unsigned b = __float_as_uint(s); auto r = __builtin_amdgcn_permlane16_swap(b, b, false, false); return __uint_as_float(r[0]) + __uint_as_float(r[1]); }
__device__ __forceinline__ float xsum32(float s) { const unsigned b = __float_as_uint(s); auto r = __builtin_amdgcn_permlane32_swap(b, b, false, false); return __uint_as_float(r[0]) + __uint_as_float(r[1]); }
__device__ __forceinline__ void rstd8(const float* ssq, int row00, int fq, float (&rr)[2][4]) {
    f32x4 sv[2][4];
#pragma unroll
    for (int ai = 0; ai < 2; ++ai)
#pragma unroll
        for (int m = 0; m < 4; ++m) sv[ai][m] = *(const f32x4*)(ssq + (size_t)(row00 + ai * HALF + m * 16) * 16 + fq * 4);
    float s[2][4];
#pragma unroll
    for (int ai = 0; ai < 2; ++ai)
#pragma unroll
        for (int m = 0; m < 4; ++m) s[ai][m] = (sv[ai][m][0] + sv[ai][m][1]) + (sv[ai][m][2] + sv[ai][m][3]);
#pragma unroll
    for (int ai = 0; ai < 2; ++ai)
#pragma unroll
        for (int m = 0; m < 4; ++m) s[ai][m] = xsum16(s[ai][m]);
#pragma unroll
    for (int ai = 0; ai < 2; ++ai)
#pragma unroll
        for (int m = 0; m < 4; ++m) s[ai][m] = xsum32(s[ai][m]);
#pragma unroll
    for (int ai = 0; ai < 2; ++ai)
#pragma unroll
        for (int m = 0; m < 4; ++m) rr[ai][m] = __builtin_amdgcn_rsqf(s[ai][m] * (1.0f / 1024.0f) + 1e-6f);
}
constexpr int EMP = 65536;
constexpr size_t O_YP = 0, O_YS = 67108864, O_PSP = O_YS + 1048576, O_PSS = O_PSP + 245760, O_KP = O_PSS + 245760, O_VP = O_KP + 67108864,
                 O_LP = O_VP + 67108864, O_KS = O_LP + 1048576, O_VS = O_KS + 1048576, O_LS = O_VS + 1048576, O_END = O_LS + 16384;
__device__ __forceinline__ float rstd_from_ssq(const float* ssq, int row, int fq) {
    const f32x4 v = *(const f32x4*)(ssq + (size_t)row * 16 + fq * 4);
    float s = (v[0] + v[1]) + (v[2] + v[3]);
    s += __shfl_xor(s, 16); s += __shfl_xor(s, 32);
    return __builtin_amdgcn_rsqf(s * (1.0f / 1024.0f) + 1e-6f);
}
template <bool HAS_XB, bool SRC_BF16, bool WR_F32> struct EpiRes {
    static constexpr bool PERM = false, AFTER_DRAIN = false;
    const float* srcP; const float* srcS; float* dst; bf16_t* xb; float* ssq; const float* cscale;
    __device__ __forceinline__ void operator()(const f32x4 (&acc)[2][2][4][2], const Unit& u, int wr, int wc, int fr_in, int fq_in) const {
        int ln_ = threadIdx.x & 63; asm volatile("" : "+v"(ln_)); const int fr = ln_ & 15, fq = ln_ >> 4; (void)fr_in; (void)fq_in;
        const int col0 = u.pn * BM + wc * 32 + 4 * fq;
#pragma unroll
        for (int ai = 0; ai < 2; ++ai) {
            f32x4 res[4][2][2];
#pragma unroll
            for (int m = 0; m < 4; ++m) {
                const int row = u.pm * BM + ai * HALF + wr * 64 + m * 16 + fr;
#pragma unroll
                for (int bj = 0; bj < 2; ++bj)
#pragma unroll
                    for (int n = 0; n < 2; ++n) {
                        if (SRC_BF16) { const u32x2 rb = *(const u32x2*)(xb + (size_t)row * 1024 + col0 + bj * HALF + n * 16);
                            res[m][bj][n] = (f32x4){__uint_as_float(rb.x << 16), __uint_as_float(rb.x & 0xffff0000u), __uint_as_float(rb.y << 16), __uint_as_float(rb.y & 0xffff0000u)}; }
                        else { const float* src = (row < EMP ? srcP + (size_t)row * 1024 : srcS + (size_t)(row - EMP) * 1024) + col0; res[m][bj][n] = *(const f32x4*)(src + bj * HALF + n * 16); }
                    }
            }
            float ssv[4];
#pragma unroll
            for (int m = 0; m < 4; ++m) {
                const int row = u.pm * BM + ai * HALF + wr * 64 + m * 16 + fr;
                float* d = dst + (size_t)row * 1024 + col0;
                float ss = 0.f;
#pragma unroll
                for (int bj = 0; bj < 2; ++bj)
#pragma unroll
                    for (int n = 0; n < 2; ++n) {
                        const f32x4 x = res[m][bj][n] + acc[ai][bj][m][n];
                        if (WR_F32) *(f32x4*)(d + bj * HALF + n * 16) = x;
                        if (HAS_XB) { u32x2 w; w.x = pkbf(x[0], x[1]); w.y = pkbf(x[2], x[3]); *(u32x2*)(xb + (size_t)row * 1024 + col0 + bj * HALF + n * 16) = w;
                            ss += (x[0] * x[0] + x[1] * x[1]) + (x[2] * x[2] + x[3] * x[3]); }
                    }
                ssv[m] = ss;
            }
            if (HAS_XB) {
#pragma unroll
                for (int m = 0; m < 4; ++m) ssv[m] = xsum16(ssv[m]);
#pragma unroll
                for (int m = 0; m < 4; ++m) ssv[m] = xsum32(ssv[m]);
#pragma unroll
                for (int m = 0; m < 4; ++m) if (fq == 0) ssq[(size_t)(u.pm * BM + ai * HALF + wr * 64 + m * 16 + fr) * 16 + u.pn * 4 + wc] = ssv[m];
            }
        }
    }
};
struct EpiGU {
    static constexpr bool PERM = true, AFTER_DRAIN = false;
    const float* ssq; bf16_t* act;
    __device__ __forceinline__ void operator()(const f32x4 (&acc)[2][2][4][2], const Unit& u, int wr, int wc, int fr_in, int fq_in) const {
        int ln_ = threadIdx.x & 63; asm volatile("" : "+v"(ln_)); const int fr = ln_ & 15, fq = ln_ >> 4; (void)fr_in; (void)fq_in;
        const int col = u.pn * 128 + wc * 32 + 8 * fq;
        float rr[2][4]; rstd8(ssq, u.pm * BM + wr * 64 + fr, fq, rr);
#pragma unroll
        for (int ai = 0; ai < 2; ++ai)
#pragma unroll
            for (int m = 0; m < 4; ++m) {
                const int row = u.pm * BM + ai * HALF + wr * 64 + m * 16 + fr;
                const float r = rr[ai][m];
                u32x4 w;
#pragma unroll
                for (int n = 0; n < 2; ++n) {
                    const f32x4 g = acc[ai][0][m][n] * r, up = acc[ai][1][m][n] * r; float hh[4];
#pragma unroll
                    for (int e = 0; e < 4; ++e) hh[e] = g[e] * __builtin_amdgcn_rcpf(1.0f + __builtin_amdgcn_exp2f(-1.4426950408889634f * g[e])) * up[e];
                    w[2 * n] = pkbf(hh[0], hh[1]); w[2 * n + 1] = pkbf(hh[2], hh[3]);
                }
                *(u32x4*)(act + (size_t)row * 2816 + col) = w;
            }
    }
};
struct EpiKVQ {
    static constexpr bool PERM = true, AFTER_DRAIN = false;
    const float* ssq; const float* gn; const float* bfp; float* out; bf16_t* kvq; size_t kvq_stride;
    __device__ __forceinline__ void operator()(const f32x4 (&acc)[2][2][4][2], const Unit& u, int wr, int wc, int fr_in, int fq_in) const {
        int ln_ = threadIdx.x & 63; asm volatile("" : "+v"(ln_)); const int fr = ln_ & 15, fq = ln_ >> 4; (void)fr_in; (void)fq_in;
        const int t = u.pn >> 2, j = u.pn & 3;
        if (t == 3) {
            if (wc != 0) return;
            const int h0 = 8 * (fq & 1);
            const f32x4 b0 = *(const f32x4*)(bfp + h0), b1 = *(const f32x4*)(bfp + h0 + 4);
            float rrf[2][4]; rstd8(ssq, u.pm * BM + wr * 64 + fr, fq, rrf);
#pragma unroll
            for (int ai = 0; ai < 2; ++ai)
#pragma unroll
                for (int m = 0; m < 4; ++m) {
                    const int row = u.pm * BM + ai * HALF + wr * 64 + m * 16 + fr;
                    const float r = rrf[ai][m];
                    if (fq < 2) {
                        float* o = (row < EMP ? out + O_LP + (size_t)row * 16 : out + O_LS + (size_t)(row - EMP) * 16) + h0;
#pragma unroll
                        for (int n = 0; n < 2; ++n) { const f32x4 z = acc[ai][0][m][n] * r + (n == 0 ? b0 : b1); f32x4 lf;
#pragma unroll
                            for (int e = 0; e < 4; ++e) lf[e] = fminf(z[e], 0.f) - 0.6931471805599453f * __builtin_amdgcn_logf(1.0f + __builtin_amdgcn_exp2f(-1.4426950408889634f * fabsf(z[e])));
                            *(f32x4*)(o + 4 * n) = lf; }
                    }
                }
            return;
        }
        f32x4 gain[2][2];
#pragma unroll
        for (int bj = 0; bj < 2; ++bj)
#pragma unroll
            for (int n = 0; n < 2; ++n) gain[bj][n] = *(const f32x4*)(gn + 64 * t + 32 * bj + 8 * fq + 4 * n);
        const int cl = 256 * j + 64 * wc + 8 * fq;
        bf16_t* const ob0 = kvq + (size_t)t * kvq_stride;
        float rr[2][4]; rstd8(ssq, u.pm * BM + wr * 64 + fr, fq, rr);
        float rn8[2][4];
        if (t != 1) {
#pragma unroll
            for (int ai = 0; ai < 2; ++ai)
#pragma unroll
                for (int m = 0; m < 4; ++m) { float ss = 0.f;
#pragma unroll
                    for (int bj = 0; bj < 2; ++bj)
#pragma unroll
                        for (int n = 0; n < 2; ++n) { const f32x4 x = acc[ai][bj][m][n]; ss += (x[0] * x[0] + x[1] * x[1]) + (x[2] * x[2] + x[3] * x[3]); }
                    rn8[ai][m] = ss * rr[ai][m] * rr[ai][m]; }
#pragma unroll
            for (int ai = 0; ai < 2; ++ai)
#pragma unroll
                for (int m = 0; m < 4; ++m) rn8[ai][m] = xsum16(rn8[ai][m]);
#pragma unroll
            for (int ai = 0; ai < 2; ++ai)
#pragma unroll
                for (int m = 0; m < 4; ++m) rn8[ai][m] = __builtin_amdgcn_rsqf(xsum32(rn8[ai][m]) * (1.0f / 64.0f) + 1e-6f);
        }
#pragma unroll
        for (int ai = 0; ai < 2; ++ai)
#pragma unroll
            for (int m = 0; m < 4; ++m) {
                const int row = u.pm * BM + ai * HALF + wr * 64 + m * 16 + fr;
                const float r = rr[ai][m];
                f32x4 v[2][2];
#pragma unroll
                for (int bj = 0; bj < 2; ++bj)
#pragma unroll
                    for (int n = 0; n < 2; ++n) v[bj][n] = acc[ai][bj][m][n] * r;
                if (t != 1) { const float rn = rn8[ai][m];
#pragma unroll
                    for (int bj = 0; bj < 2; ++bj)
#pragma unroll
                        for (int n = 0; n < 2; ++n) v[bj][n] = v[bj][n] * rn * gain[bj][n]; }
                if (t < 2) { float* o = (row < EMP ? out + (t == 0 ? O_KP : O_VP) + (size_t)row * 1024 : out + (t == 0 ? O_KS : O_VS) + (size_t)(row - EMP) * 1024) + cl;
#pragma unroll
                    for (int bj = 0; bj < 2; ++bj) { *(f32x4*)(o + 32 * bj) = v[bj][0]; *(f32x4*)(o + 32 * bj + 4) = v[bj][1]; } }
                bf16_t* ob = ob0 + (size_t)row * 1024 + cl;
#pragma unroll
                for (int bj = 0; bj < 2; ++bj) { u32x4 w; w.x = pkbf(v[bj][0][0], v[bj][0][1]); w.y = pkbf(v[bj][0][2], v[bj][0][3]); w.z = pkbf(v[bj][1][0], v[bj][1][1]); w.w = pkbf(v[bj][1][2], v[bj][1][3]);
                    *(u32x4*)(ob + 32 * bj) = w; }
            }
    }
};

struct RangeOrder {
    StaticOrder b; int i0, i1; int xc, xi;
    __device__ __forceinline__ bool next(int i, Unit& u) const {
        if (i0 + i < i1) return b.next(i0 + i, u);
        if (xc >= 0 && i0 + i == i1) { StaticOrder b2 = b; b2.c = xc; return b2.next(xi, u); }
        return false; }
    __device__ __forceinline__ void a_ready(const Unit&) const {}
    __device__ __forceinline__ void done(const Unit&) const {}
};
struct OneUnit {
    int pm, pn;
    __device__ __forceinline__ bool next(int i, Unit& u) const { if (i != 0) return false; u.pm = pm; u.pn = pn; return true; }
    __device__ __forceinline__ void a_ready(const Unit&) const {}
    __device__ __forceinline__ void done(const Unit&) const {}
};
template <class Epi, class Sched, bool ALIGN_EPI = false, bool SP2 = false>
__device__ __forceinline__ void gemm_phase(PG8_LAS unsigned char* lds, const Gemm g, const Sched& S, const Epi& E) {
    int tid_o = threadIdx.x; asm volatile("" : "+v"(tid_o)); const int tid = tid_o, wid = __builtin_amdgcn_readfirstlane(tid >> 6), lane = tid & 63, wr = wid >> 2, wc = wid & 3, fr = lane & 15, fq = lane >> 4;
    const int K = g.K, nt = K / BK;
    unsigned voffA[2], voffB[2];
#pragma unroll
    for (int i = 0; i < 2; ++i) { int R, C; stage_rc(tid * 16 + i * 8192, R, C); const int Rb = Epi::PERM ? ((R & ~31) + perm32(R & 31)) : R;
        voffA[i] = (unsigned)(R * g.lda + C) * 2u; voffB[i] = (unsigned)(Rb * K + C) * 2u; }
    const size_t kstep = (size_t)(BK * 2);
    const size_t hstepB = (size_t)HALF * K * 2, hstepA = (size_t)HALF * g.lda * 2;
    const size_t tstepB = 2 * hstepB, tstepA = 2 * hstepA;
    const unsigned ldsw = (unsigned)wid * 1024u;
    const int aoff = lds_byte(wr * 64 + fr, fq * 8), boff = lds_byte(wc * 32 + fr, fq * 8);
#define PG8_SA(b, h) (((b) * 2 + (h)) * HTB)
#define PG8_SB(b, h) ((4 + (b) * 2 + (h)) * HTB)
#define PG8_STAGE(bufoff, gbase, voff) do { _Pragma("unroll") for (int _i = 0; _i < 2; ++_i) \
        __builtin_amdgcn_global_load_lds((const unsigned*)((const char*)(gbase) + (voff)[_i]), (PG8_LAS unsigned*)(lds + (bufoff) + ldsw + _i * 8192), 16, 0, 0); } while (0)
#define PG8_LDA(dst, b, h) do { _Pragma("unroll") for (int m = 0; m < 4; ++m) _Pragma("unroll") for (int k = 0; k < 2; ++k) dst[m][k] = *(const PG8_LAS bf16x8*)(lds + PG8_SA(b, h) + aoff + m * 2048 + k * 1024); } while (0)
#define PG8_LDB(dst, b, h) do { _Pragma("unroll") for (int n = 0; n < 2; ++n) _Pragma("unroll") for (int k = 0; k < 2; ++k) dst[n][k] = *(const PG8_LAS bf16x8*)(lds + PG8_SB(b, h) + boff + n * 2048 + k * 1024); } while (0)
#define PG8_MMA(ai, bj, At, Bt) do { __builtin_amdgcn_s_setprio(1); _Pragma("unroll") for (int m = 0; m < 4; ++m) _Pragma("unroll") for (int n = 0; n < 2; ++n) _Pragma("unroll") for (int k = 0; k < 2; ++k) \
        acc[ai][bj][m][n] = __builtin_amdgcn_mfma_f32_16x16x32_bf16(Bt[n][k], At[m][k], acc[ai][bj][m][n], 0, 0, 0); __builtin_amdgcn_s_setprio(0); } while (0)
#define PG8_WAIT_V(n) asm volatile("s_waitcnt vmcnt(" #n ")" ::: "memory")
#define PG8_WAIT_L(n) asm volatile("s_waitcnt lgkmcnt(" #n ")" ::: "memory")
#define PG8_BAR __builtin_amdgcn_s_barrier()
#define PG8_SCHED __builtin_amdgcn_sched_barrier(0)
    Unit cur, nxt; int ui = 0;
    if (!S.next(0, cur)) return;
    f32x4 acc[2][2][4][2];
#pragma unroll
    for (int a = 0; a < 2; ++a)
#pragma unroll
        for (int b = 0; b < 2; ++b)
#pragma unroll
            for (int m = 0; m < 4; ++m)
#pragma unroll
                for (int n = 0; n < 2; ++n) acc[a][b][m][n] = (f32x4){0.f, 0.f, 0.f, 0.f};
    bf16x8 At[4][2], B0[2][2], B1[2][2];
    const char* cA = (const char*)g.A + (size_t)cur.pm * tstepA + (size_t)cur.pn * g.acol_pn * 2; const char* cB = (const char*)g.Bt + (size_t)cur.pn * tstepB;
    S.a_ready(cur);
    if constexpr (SP2) {
        PG8_STAGE(PG8_SB(0, 0), cB, voffB); PG8_STAGE(PG8_SB(0, 1), cB + hstepB, voffB); PG8_STAGE(PG8_SA(0, 0), cA, voffA); PG8_STAGE(PG8_SA(0, 1), cA + hstepA, voffA);
        if (wr == 1) PG8_BAR;
        PG8_WAIT_V(2); PG8_BAR;
        PG8_STAGE(PG8_SB(1, 0), cB + kstep, voffB); PG8_STAGE(PG8_SA(1, 0), cA + kstep, voffA); PG8_STAGE(PG8_SB(1, 1), cB + hstepB + kstep, voffB);
        PG8_WAIT_V(6); PG8_BAR;
    } else {
        PG8_STAGE(PG8_SB(0, 0), cB, voffB); PG8_STAGE(PG8_SA(0, 0), cA, voffA); PG8_STAGE(PG8_SB(0, 1), cB + hstepB, voffB); PG8_STAGE(PG8_SA(0, 1), cA + hstepA, voffA);
        if (wr == 1) PG8_BAR;
        PG8_WAIT_V(4); PG8_BAR;
        PG8_STAGE(PG8_SB(1, 0), cB + kstep, voffB); PG8_STAGE(PG8_SA(1, 0), cA + kstep, voffA); PG8_STAGE(PG8_SB(1, 1), cB + hstepB + kstep, voffB);
        PG8_WAIT_V(6); PG8_BAR;
    }
    for (;;) {
        const bool has_next = S.next(ui + 1, nxt);
        const char* nA = has_next ? (const char*)g.A + (size_t)nxt.pm * tstepA + (size_t)nxt.pn * g.acol_pn * 2 : cA; const char* nB = has_next ? (const char*)g.Bt + (size_t)nxt.pn * tstepB : cB;
        for (int t = 0; t < nt; t += 2) {
            const bool last = (t == nt - 2);
            const char* a1 = cA + (size_t)(t + 1) * kstep;
            const char* a2 = last ? nA : cA + (size_t)(t + 2) * kstep; const char* b2 = last ? nB : cB + (size_t)(t + 2) * kstep;
            const char* a3 = a2 + kstep; const char* b3 = b2 + kstep;
            if (last && has_next) S.a_ready(nxt);
            if constexpr (SP2) {
            PG8_LDB(B0, 0, 0); PG8_LDB(B1, 0, 1); PG8_SCHED; PG8_LDA(At, 0, 0); PG8_STAGE(PG8_SA(1, 1), a1 + hstepA, voffA);
            PG8_WAIT_V(8); PG8_WAIT_L(0); PG8_BAR; PG8_MMA(0, 0, At, B0); PG8_MMA(0, 1, At, B1); PG8_BAR; PG8_SCHED;
            PG8_LDA(At, 0, 1); PG8_STAGE(PG8_SB(0, 0), b2, voffB); PG8_STAGE(PG8_SB(0, 1), b2 + hstepB, voffB); PG8_STAGE(PG8_SA(0, 0), a2, voffA);
            PG8_WAIT_V(8); PG8_WAIT_L(0); PG8_BAR; PG8_MMA(1, 0, At, B0); PG8_MMA(1, 1, At, B1); PG8_BAR; PG8_SCHED;
            PG8_LDB(B0, 1, 0); PG8_LDB(B1, 1, 1); PG8_SCHED; PG8_LDA(At, 1, 0); PG8_STAGE(PG8_SA(0, 1), a2 + hstepA, voffA);
            PG8_WAIT_V(8); PG8_WAIT_L(0); PG8_BAR; PG8_MMA(0, 0, At, B0); PG8_MMA(0, 1, At, B1); PG8_BAR; PG8_SCHED;
            PG8_LDA(At, 1, 1); PG8_STAGE(PG8_SB(1, 0), b3, voffB); PG8_STAGE(PG8_SB(1, 1), b3 + hstepB, voffB); PG8_STAGE(PG8_SA(1, 0), a3, voffA);
            PG8_WAIT_V(8); PG8_WAIT_L(0); PG8_BAR; PG8_MMA(1, 0, At, B0); PG8_MMA(1, 1, At, B1); PG8_BAR; PG8_SCHED;
            } else {
            PG8_LDB(B0, 0, 0); PG8_SCHED; PG8_LDA(At, 0, 0); PG8_STAGE(PG8_SA(1, 1), a1 + hstepA, voffA);
            PG8_WAIT_L(8); PG8_BAR; PG8_WAIT_L(0); PG8_MMA(0, 0, At, B0); PG8_BAR; PG8_SCHED;
            PG8_LDB(B1, 0, 1); PG8_STAGE(PG8_SB(0, 0), b2, voffB);
            PG8_BAR; PG8_WAIT_L(0); PG8_MMA(0, 1, At, B1); PG8_BAR;
            PG8_LDA(At, 0, 1); PG8_STAGE(PG8_SA(0, 0), a2, voffA);
            PG8_BAR; PG8_WAIT_L(0); PG8_MMA(1, 0, At, B0); PG8_BAR; PG8_SCHED;
            PG8_STAGE(PG8_SB(0, 1), b2 + hstepB, voffB);
            PG8_WAIT_V(6); PG8_BAR; PG8_MMA(1, 1, At, B1); PG8_BAR;
            PG8_LDB(B0, 1, 0); PG8_SCHED; PG8_LDA(At, 1, 0); PG8_STAGE(PG8_SA(0, 1), a2 + hstepA, voffA);
            PG8_WAIT_L(8); PG8_BAR; PG8_WAIT_L(0); PG8_MMA(0, 0, At, B0); PG8_BAR; PG8_SCHED;
            PG8_LDB(B1, 1, 1); PG8_STAGE(PG8_SB(1, 0), b3, voffB);
            PG8_BAR; PG8_WAIT_L(0); PG8_MMA(0, 1, At, B1); PG8_BAR;
            PG8_LDA(At, 1, 1); PG8_STAGE(PG8_SA(1, 0), a3, voffA);
            PG8_BAR; PG8_WAIT_L(0); PG8_MMA(1, 0, At, B0); PG8_BAR; PG8_SCHED;
            PG8_STAGE(PG8_SB(1, 1), b3 + hstepB, voffB);
            PG8_WAIT_V(6); PG8_BAR; PG8_MMA(1, 1, At, B1); PG8_BAR;
            }
        }
        if constexpr (ALIGN_EPI) { if (wr == 0) PG8_BAR; }
        if constexpr (!Epi::AFTER_DRAIN) { E(acc, cur, wr, wc, fr, fq); S.done(cur); }
        if (!has_next) break;
#pragma unroll
        for (int a = 0; a < 2; ++a)
#pragma unroll
            for (int b = 0; b < 2; ++b)
#pragma unroll
                for (int m = 0; m < 4; ++m)
#pragma unroll
                    for (int n = 0; n < 2; ++n) acc[a][b][m][n] = (f32x4){0.f, 0.f, 0.f, 0.f};
        cur = nxt; cA = nA; cB = nB; ++ui;
        if constexpr (ALIGN_EPI) { if (wr == 1) PG8_BAR; }
    }
    PG8_WAIT_V(0);
    if constexpr (!ALIGN_EPI) { if (wr == 0) PG8_BAR; }
    PG8_BAR;
    if constexpr (Epi::AFTER_DRAIN) { E.fused(acc, cur, wr, wc, fr, fq, lds, wid, lane); S.done(cur); }
#undef PG8_SA
#undef PG8_SB
#undef PG8_STAGE
#undef PG8_LDA
#undef PG8_LDB
#undef PG8_MMA
#undef PG8_WAIT_V
#undef PG8_WAIT_L
#undef PG8_BAR
#undef PG8_SCHED
}
}

#include <hip/hip_bf16.h>
#include <cmath>
namespace attn_body {
using bf16=__hip_bfloat16;
using bf16x8=__attribute__((ext_vector_type(8)))short;
using s16x4=__attribute__((ext_vector_type(4)))short;
using f32x16=__attribute__((ext_vector_type(16)))float;
using u32x4=__attribute__((ext_vector_type(4)))unsigned;
using f32x4a=__attribute__((ext_vector_type(4)))float;
typedef __attribute__((address_space(3))) const float* lds_cfptr;
typedef __attribute__((address_space(3))) const f32x4a* lds_cf4ptr;
constexpr int BATCH=16,NHEAD=16,SEQ=4096,D=64,DM=NHEAD*D;
constexpr int NW=8,QBLK=32,QB=QBLK*NW,KVBLK=64,NQB=SEQ/QB;
constexpr int ATTN_PITCH=DM, ATTN_UNIT_ROWS=QB;
__device__ __forceinline__ int crow(int r,int hi){return (r&3)+8*(r>>2)+4*hi;}
#define SBAR() __builtin_amdgcn_sched_barrier(0)
__device__ __forceinline__ void cmask(f32x16&p0,f32x16&p1,int jb,int qrel,int hi){
  const float NEG=-INFINITY; int kb=64*jb+4*hi;
  #pragma unroll
  for(int r=0;r<16;++r){int kv=kb+(r&3)+8*(r>>2); if(kv>qrel)p0[r]=NEG; if(kv+32>qrel)p1[r]=NEG;}
}

constexpr int NSLOT=3, SLOTB=8192;
constexpr int LDS_K=0, LDS_V=NSLOT*SLOTB, LDS_WS=2*NSLOT*SLOTB, LDS_OST=LDS_WS+NW*64*4, LDS_BYTES=LDS_OST+NW*4096;
constexpr float C2=0.125f*1.4426950408889634f;
__device__ __forceinline__ void glds16(const void*gsrc,unsigned lds_dst){unsigned keep;
  asm volatile("s_mov_b32 %0, m0\n\ts_mov_b32 m0, %2\n\ts_nop 0\n\tglobal_load_lds_dwordx4 %1, off\n\ts_mov_b32 m0, %0":"=&s"(keep):"v"(gsrc),"s"(lds_dst):"memory");}
__device__ __forceinline__ float max3f(float a,float b,float c){float r;asm("v_max3_f32 %0, %1, %2, %3":"=v"(r):"v"(a),"v"(b),"v"(c));return r;}
__device__ __forceinline__ float max2f(float a,float b){float r;asm("v_max_f32_e32 %0, %1, %2":"=v"(r):"v"(a),"v"(b));return r;}
__device__ __forceinline__ float fadd_s(float a,float b){float r;asm("v_add_f32_e32 %0, %1, %2":"=v"(r):"v"(a),"v"(b));return r;}
__device__ __forceinline__ float fsub_s(float a,float b){float r;asm("v_sub_f32_e32 %0, %1, %2":"=v"(r):"v"(a),"v"(b));return r;}
typedef float f32x2_t __attribute__((ext_vector_type(2))); typedef __bf16 bf16x2_t __attribute__((ext_vector_type(2)));
__device__ __forceinline__ unsigned cvtpk_s(float lo,float hi){f32x2_t v={lo,hi};bf16x2_t b=__builtin_convertvector(v,bf16x2_t);return __builtin_bit_cast(unsigned,b);}
#define WAIT_BAR(N) asm volatile("s_waitcnt vmcnt(" #N ") lgkmcnt(0)\n\ts_barrier":::"memory")

__device__ __forceinline__ void qkt(f32x16&p0,f32x16&p1,const char*Kslot,const bf16x8*qr,int r32,int hi){
  const char*kb=Kslot+hi*1024+r32*16;
  #pragma unroll
  for(int d0=0;d0<4;++d0){
    const bf16x8 b0=*reinterpret_cast<const bf16x8*>(kb+d0*2048);
    const bf16x8 b1=*reinterpret_cast<const bf16x8*>(kb+d0*2048+512);
    {p0=__builtin_amdgcn_mfma_f32_32x32x16_bf16(b0,qr[d0],p0,0,0,0);p1=__builtin_amdgcn_mfma_f32_32x32x16_bf16(b1,qr[d0],p1,0,0,0);}}
}
typedef __attribute__((address_space(3))) const char* lds_cptr;
typedef short v4i16_t __attribute__((ext_vector_type(4)));
__device__ __forceinline__ void kload8(bf16x8*kf,lds_cptr kp){
  kf[0]=*(const __attribute__((address_space(3))) bf16x8*)(kp);      kf[1]=*(const __attribute__((address_space(3))) bf16x8*)(kp+512);
  kf[2]=*(const __attribute__((address_space(3))) bf16x8*)(kp+2048); kf[3]=*(const __attribute__((address_space(3))) bf16x8*)(kp+2560);
  kf[4]=*(const __attribute__((address_space(3))) bf16x8*)(kp+4096); kf[5]=*(const __attribute__((address_space(3))) bf16x8*)(kp+4608);
  kf[6]=*(const __attribute__((address_space(3))) bf16x8*)(kp+6144); kf[7]=*(const __attribute__((address_space(3))) bf16x8*)(kp+6656);
}
__device__ __forceinline__ void kload2(bf16x8*kf,lds_cptr kp,int j){ kf[2*j]=*(const __attribute__((address_space(3))) bf16x8*)(kp+j*2048); kf[2*j+1]=*(const __attribute__((address_space(3))) bf16x8*)(kp+j*2048+512); }
__device__ __forceinline__ s16x4 vtr(lds_cptr p){ return __builtin_bit_cast(s16x4,__builtin_amdgcn_ds_read_tr16_b64_v4i16((__attribute__((address_space(3))) v4i16_t*)p)); }
__device__ __forceinline__ float rowmax(const f32x16&p0,const f32x16&p1){
  float a=max3f(p0[0],p0[1],p1[0]),b=max3f(p0[2],p0[3],p1[1]);a=max3f(a,p1[2],p1[3]);
  #pragma unroll
  for(int r=4;r<16;r+=4){a=max3f(a,p0[r],p0[r+1]);b=max3f(b,p0[r+2],p0[r+3]);a=max3f(a,p1[r],p1[r+1]);b=max3f(b,p1[r+2],p1[r+3]);}
  const float m=max2f(a,b);
  auto rr=__builtin_amdgcn_permlane32_swap(__float_as_uint(m),__float_as_uint(m),false,false);
  return max2f(__uint_as_float(rr[0]),__uint_as_float(rr[1]));
}
__device__ __forceinline__ void pv(f32x16*o,int vb,bf16x8 pa0,bf16x8 pa1,bf16x8 pa2,bf16x8 pa3){
  #pragma unroll
  for(int d0=0;d0<2;++d0){s16x4 lo[4],hi[4];
    #pragma unroll
    for(int ks=0;ks<4;++ks){
      asm volatile("ds_read_b64_tr_b16 %0,%1 offset:%c2":"=&v"(lo[ks]):"v"(vb),"i"(d0*4096+ks*1024):"memory");
      asm volatile("ds_read_b64_tr_b16 %0,%1 offset:%c2":"=&v"(hi[ks]):"v"(vb),"i"(d0*4096+ks*1024+512):"memory");}
    asm volatile("s_waitcnt lgkmcnt(0)":::"memory");SBAR();
    #define PK(k) (bf16x8){lo[k][0],lo[k][1],lo[k][2],lo[k][3],hi[k][0],hi[k][1],hi[k][2],hi[k][3]}
    o[d0]=__builtin_amdgcn_mfma_f32_32x32x16_bf16(pa0,PK(0),o[d0],0,0,0);
    o[d0]=__builtin_amdgcn_mfma_f32_32x32x16_bf16(pa1,PK(1),o[d0],0,0,0);
    o[d0]=__builtin_amdgcn_mfma_f32_32x32x16_bf16(pa2,PK(2),o[d0],0,0,0);
    o[d0]=__builtin_amdgcn_mfma_f32_32x32x16_bf16(pa3,PK(3),o[d0],0,0,0);
    #undef PK
  }
}

#ifndef ATTN_STORE16
#define ATTN_STORE16(p,v) (*(u32x4*)(p)=(v))
#endif
template<int THRL> __device__ __forceinline__ void attn_unit(int b,int h,int qb,const bf16*Q,const bf16*__restrict__ K,const bf16*__restrict__ V,bf16*O,char*shm,lds_cfptr dkl,float lowc,int t0){
  int tid_o=threadIdx.x; asm volatile("":"+v"(tid_o)); const int tid=tid_o,lane=tid&63,r32=lane&31,hi=lane>>5; const int wid=__builtin_amdgcn_readfirstlane(tid>>6);
  const long rowbase=(long)b*SEQ; const int q0=qb*QB;
  const bf16*Qw=Q+(rowbase+q0+wid*QBLK)*DM+h*D;
  const bf16*Kh=K+(rowbase+(long)t0*KVBLK)*DM+h*D,*Vh=V+(rowbase+(long)t0*KVBLK)*DM+h*D;
  const unsigned lds0=(unsigned)(uintptr_t)shm;
  float*wsf=(float*)(shm+LDS_WS)+wid*64;
  const bf16*ksrc=Kh+(long)lane*DM+wid*8;
  const bf16*vsrc=Vh+(long)(16*(wid&3)+(lane>>2))*DM+(wid>>2)*32+(lane&3)*8;
  const unsigned kdst=lds0+LDS_K+wid*1024, vdst=lds0+LDS_V+wid*1024;
  #define DMA_K(t,slot) glds16(ksrc+(long)(t)*KVBLK*DM,(unsigned)__builtin_amdgcn_readfirstlane(kdst+(slot)))
  #define DMA_V(t,slot) glds16(vsrc+(long)(t)*KVBLK*DM,(unsigned)__builtin_amdgcn_readfirstlane(vdst+(slot)))
  const int vb0=(int)(lds0+LDS_V)+((lane>>4)&1)*32+(lane&3)*8+(4*hi+((lane&15)>>2))*64;
  const char*Kbase=shm+LDS_K; bf16x8 kf[8];
  const lds_cptr shm3=(lds_cptr)shm; const lds_cptr kp0=shm3+LDS_K+hi*1024+r32*16; const lds_cptr vp0=shm3+LDS_V+((lane>>4)&1)*32+(lane&3)*8+(4*hi+((lane&15)>>2))*64;
  const int NT=(q0+QB)/KVBLK-t0;
  DMA_K(0,0);DMA_V(0,0);DMA_K(1,SLOTB);
  bf16x8 qr[4];
  #pragma unroll
  for(int d0=0;d0<4;++d0)qr[d0]=*reinterpret_cast<const bf16x8*>(&Qw[(long)r32*DM+d0*16+hi*8]);
  const float dq2=dkl[q0+wid*QBLK+r32]; const lds_cf4ptr dk4=(lds_cf4ptr)dkl+16*t0;
  float mhat=-dq2,l_reg=0.f;f32x16 o[2];o[0]=f32x16{};o[1]=f32x16{};
  #define BINIT(P0,P1,t,NM) do{ const lds_cf4ptr d4_=dk4+16*(t)+hi; _Pragma("unroll") for(int j_=0;j_<4;++j_){ const f32x4a a_=d4_[2*j_], b_=d4_[8+2*j_]; _Pragma("unroll") for(int i_=0;i_<4;++i_){P0[4*j_+i_]=(NM)-a_[i_];P1[4*j_+i_]=(NM)-b_[i_];} } }while(0)
  #define BLOAD(P0,P1,t) do{ const lds_cf4ptr d4_=dk4+16*(t)+hi; _Pragma("unroll") for(int j_=0;j_<4;++j_){ const f32x4a a_=d4_[2*j_], b_=d4_[8+2*j_]; _Pragma("unroll") for(int i_=0;i_<4;++i_){P0[4*j_+i_]=a_[i_];P1[4*j_+i_]=b_[i_];} } }while(0)
  const int qrel=wid*QBLK+r32;
  #define CMASK(P0,P1,t) do{int jb_=(t)-(NT-4); if(jb_>=0)cmask(P0,P1,jb_,qrel,hi);}while(0)
  bool resc=false;
  #define START(P0,P1) do{ const float rm=rowmax(P0,P1); resc=false; \
    { const float dl=rm; mhat=fadd_s(mhat,dl); \
      _Pragma("unroll") for(int r=0;r<16;++r){P0[r]=fsub_s(P0[r],dl);P1[r]=fsub_s(P1[r],dl);} \
      } \
    _Pragma("unroll") for(int r=0;r<16;++r)P0[r]=__builtin_amdgcn_exp2f(P0[r]); }while(0)
  #define RESC() do{ if(resc){ asm volatile("s_waitcnt lgkmcnt(0)":::"memory"); \
      _Pragma("unroll") for(int d_=0;d_<2;++d_) _Pragma("unroll") for(int r=0;r<16;++r)o[d_][r]*=wsf[crow(r,hi)]; } }while(0)
  f32x16 pA0,pA1,pB0,pB1;
  int sl_prev=0,sl_cur=0,sl_next=SLOTB;
  #define ROT() do{sl_prev=sl_cur;sl_cur=sl_next;sl_next=(sl_next==(NSLOT-1)*SLOTB)?0:sl_next+SLOTB;}while(0)
  DMA_K(2,2*SLOTB);
  WAIT_BAR(3);
  BINIT(pA0,pA1,0,dq2);
  qkt(pA0,pA1,Kbase,qr,r32,hi);asm volatile("s_nop 15\n\ts_nop 7":"+v"(pA0),"+v"(pA1));CMASK(pA0,pA1,0);
  START(pA0,pA1);
  { const float nm0_=-mhat; BINIT(pB0,pB1,1,nm0_); }
  _Pragma("unroll") for(int r=0;r<16;++r)pA1[r]=__builtin_amdgcn_exp2f(pA1[r]);
  WAIT_BAR(0);
  DMA_K(3,0);DMA_V(1,SLOTB);
  ROT();
  kload8(kf,kp0+sl_cur);
  WAIT_BAR(2);
  s16x4 vlo[8],vhi[8]; u32x4 pw0,pw1,pw2,pw3;
  #define PKW(P,B) cvtpk_s(P[B],P[B+1])
  #define PAF(k) __builtin_bit_cast(bf16x8,pw##k)
  #define VFR(i) (bf16x8){vlo[i][0],vlo[i][1],vlo[i][2],vlo[i][3],vhi[i][0],vhi[i][1],vhi[i][2],vhi[i][3]}
  #define PIN(x) asm volatile("":"+v"(x))
  #define MX3(a,b,c) __builtin_fmaxf(__builtin_fmaxf((a),(b)),(c))
  #define GAPA(MF,A0,A1,A2,A3,W0,W1,PW) do{ MF; sacc+=A0; sacc+=A1; sacc+=A2; sacc+=A3; PIN(sacc); W0; W1; PIN(PW); SBAR(); }while(0)
  #define EX(v) __builtin_amdgcn_exp2f(v)
  #define GAPB(MF,X,B,G,PI) do{ MF; X[B]=EX(X[B]); X[B+1]=EX(X[B+1]); X[B+2]=EX(X[B+2]); X[B+3]=EX(X[B+3]); PIN(X); if(G){ PI[B]=nmh_-PI[B]; PI[B+1]=nmh_-PI[B+1]; PI[B+2]=nmh_-PI[B+2]; PI[B+3]=nmh_-PI[B+3]; PIN(PI); } SBAR(); }while(0)
  #define VRD(i) do{ vlo[i]=vtr(vp_+(((i)>>2)*4096+((i)&3)*1024)); vhi[i]=vtr(vp_+(((i)>>2)*4096+((i)&3)*1024+512)); }while(0)
  #define KRD(G,j) do{ if(G){ kload2(kf,kp0+sl_next,j); SBAR(); } }while(0)
  #define STEP(C0,C1,P0,P1,t,GK,GV,GL) do{ SBAR(); \
    const lds_cptr vp_=vp0+sl_prev; \
    VRD(0); SBAR(); float sacc=(P0[0]+P0[1]); \
    GAPA(C0=__builtin_amdgcn_mfma_f32_32x32x16_bf16(kf[0],qr[0],C0,0,0,0), P0[2],P0[3],P0[4],P0[5],     pw0[0]=PKW(P0,0), pw0[1]=PKW(P0,2), pw0); \
    VRD(4); SBAR(); GAPA(C1=__builtin_amdgcn_mfma_f32_32x32x16_bf16(kf[1],qr[0],C1,0,0,0), P0[6],P0[7],P0[8],P0[9],     pw0[2]=PKW(P0,4), pw0[3]=PKW(P0,6), pw0); \
    VRD(1); SBAR(); GAPA(C0=__builtin_amdgcn_mfma_f32_32x32x16_bf16(kf[2],qr[1],C0,0,0,0),   P0[10],P0[11],P0[12],P0[13], pw1[0]=PKW(P0,8), pw1[1]=PKW(P0,10), pw1); \
    VRD(5); SBAR(); GAPA(C1=__builtin_amdgcn_mfma_f32_32x32x16_bf16(kf[3],qr[1],C1,0,0,0),   P0[14],P0[15],P1[0],P1[1],   pw1[2]=PKW(P0,12),pw1[3]=PKW(P0,14), pw1); \
    VRD(2); SBAR(); GAPA(C0=__builtin_amdgcn_mfma_f32_32x32x16_bf16(kf[4],qr[2],C0,0,0,0),   P1[2],P1[3],P1[4],P1[5],     pw2[0]=PKW(P1,0), pw2[1]=PKW(P1,2), pw2); \
    VRD(6); SBAR(); GAPA(C1=__builtin_amdgcn_mfma_f32_32x32x16_bf16(kf[5],qr[2],C1,0,0,0),   P1[6],P1[7],P1[8],P1[9],     pw2[2]=PKW(P1,4), pw2[3]=PKW(P1,6), pw2); \
    VRD(3); SBAR(); GAPA(C0=__builtin_amdgcn_mfma_f32_32x32x16_bf16(kf[6],qr[3],C0,0,0,0),   P1[10],P1[11],P1[12],P1[13], pw3[0]=PKW(P1,8), pw3[1]=PKW(P1,10), pw3); \
    VRD(7); SBAR(); GAPA(C1=__builtin_amdgcn_mfma_f32_32x32x16_bf16(kf[7],qr[3],C1,0,0,0),   P1[14],P1[15],0.f,0.f,       pw3[2]=PKW(P1,12),pw3[3]=PKW(P1,14), pw3); \
    l_reg+=sacc; \
    if(GK){DMA_K((t)+3,sl_cur);} if(GV){DMA_V((t)+1,sl_next);} \
    CMASK(C0,C1,t); \
    { float a=MX3(C0[0],C0[1],C1[0]),b=MX3(C0[2],C0[3],C1[1]); a=MX3(a,C1[2],C1[3]); \
      _Pragma("unroll") for(int r=4;r<16;r+=4){a=MX3(a,C0[r],C0[r+1]);b=MX3(b,C0[r+2],C0[r+3]);a=MX3(a,C1[r],C1[r+1]);b=MX3(b,C1[r+2],C1[r+3]);} \
      float rm=__builtin_fmaxf(a,b); { auto rr=__builtin_amdgcn_permlane32_swap(__float_as_uint(rm),__float_as_uint(rm),false,false); rm=__builtin_fmaxf(__uint_as_float(rr[0]),__uint_as_float(rr[1])); } \
      resc=false; \
      if(__builtin_expect(__any(rm>(float)THRL),0)){ const float dl=__builtin_fmaxf(rm,0.f); mhat+=dl; \
        _Pragma("unroll") for(int r=0;r<16;++r){C0[r]-=dl;C1[r]-=dl;} \
        const float f=__builtin_amdgcn_exp2f(-dl); l_reg*=f; if(hi==0)wsf[r32]=f; resc=true; } } \
    const float nmh_=-mhat; if(GL){ BLOAD(P0,P1,(t)+1); } SBAR(); \
    GAPB(o[0]=__builtin_amdgcn_mfma_f32_32x32x16_bf16(PAF(0),VFR(0),o[0],0,0,0), C0,0,GL,P0); \
    GAPB(o[1]=__builtin_amdgcn_mfma_f32_32x32x16_bf16(PAF(0),VFR(4),o[1],0,0,0), C0,4,GL,P0); \
    KRD(GL,0); GAPB(o[0]=__builtin_amdgcn_mfma_f32_32x32x16_bf16(PAF(1),VFR(1),o[0],0,0,0), C0,8,GL,P0); \
    KRD(GL,1); GAPB(o[1]=__builtin_amdgcn_mfma_f32_32x32x16_bf16(PAF(1),VFR(5),o[1],0,0,0), C0,12,GL,P0); \
    KRD(GL,2); GAPB(o[0]=__builtin_amdgcn_mfma_f32_32x32x16_bf16(PAF(2),VFR(2),o[0],0,0,0), C1,0,GL,P1); \
    KRD(GL,3); GAPB(o[1]=__builtin_amdgcn_mfma_f32_32x32x16_bf16(PAF(2),VFR(6),o[1],0,0,0), C1,4,GL,P1); \
    GAPB(o[0]=__builtin_amdgcn_mfma_f32_32x32x16_bf16(PAF(3),VFR(3),o[0],0,0,0), C1,8,GL,P1); \
    GAPB(o[1]=__builtin_amdgcn_mfma_f32_32x32x16_bf16(PAF(3),VFR(7),o[1],0,0,0), C1,12,GL,P1); \
    }while(0)
  int t=1;
  #undef CMASK
  #define CMASK(P0,P1,t) do{}while(0)
  for(;t+5<NT;t+=2){
    STEP(pB0,pB1,pA0,pA1,t,true,true,true);     WAIT_BAR(2); RESC(); ROT();
    STEP(pA0,pA1,pB0,pB1,t+1,true,true,true);   WAIT_BAR(2); RESC(); ROT();
  }
  #undef CMASK
  #define CMASK(P0,P1,t) do{int jb_=(t)-(NT-4); if(jb_>=0)cmask(P0,P1,jb_,qrel,hi);}while(0)
  #define ENDW(tt) do{ if((tt)+3<NT){WAIT_BAR(2);} else if((tt)+2<NT){WAIT_BAR(1);} else {WAIT_BAR(0);} }while(0)
  for(;t+1<NT;t+=2){
    STEP(pB0,pB1,pA0,pA1,t,(t+3<NT),(t+1<NT),(t+1<NT));       ENDW(t);   RESC(); ROT();
    STEP(pA0,pA1,pB0,pB1,t+1,(t+4<NT),(t+2<NT),(t+2<NT));     ENDW(t+1); RESC(); ROT();
  }
  STEP(pB0,pB1,pA0,pA1,NT-1,false,false,false); RESC();
  { float sacc=pB0[0]+pB0[1]; _Pragma("unroll") for(int r=2;r<16;++r)sacc+=pB0[r]; _Pragma("unroll") for(int r=0;r<16;++r)sacc+=pB1[r]; l_reg+=sacc;
    pw0=(u32x4){PKW(pB0,0),PKW(pB0,2),PKW(pB0,4),PKW(pB0,6)};pw1=(u32x4){PKW(pB0,8),PKW(pB0,10),PKW(pB0,12),PKW(pB0,14)};pw2=(u32x4){PKW(pB1,0),PKW(pB1,2),PKW(pB1,4),PKW(pB1,6)};pw3=(u32x4){PKW(pB1,8),PKW(pB1,10),PKW(pB1,12),PKW(pB1,14)};
    SBAR(); pv(o,vb0+sl_cur,PAF(0),PAF(1),PAF(2),PAF(3)); }
  #undef PKW
  #undef PAF
  #undef VFR
  #undef PIN
  #undef MX3
  #undef GAPA
  #undef GAPB
  #undef EX
  #undef VRD
  #undef KRD
  #undef STEP
  #undef ENDW
  {auto rr=__builtin_amdgcn_permlane32_swap(__float_as_uint(l_reg),__float_as_uint(l_reg),false,false);l_reg=__uint_as_float(rr[0])+__uint_as_float(rr[1]);}
  if(hi==0)wsf[32+r32]=l_reg;asm volatile("s_waitcnt lgkmcnt(0)":::"memory");
  float rli[16];
  #pragma unroll
  for(int r=0;r<16;++r)rli[r]=__builtin_amdgcn_rcpf(wsf[32+crow(r,hi)]);
  bf16*Ow=O+(rowbase+q0+wid*QBLK)*DM+h*D;
  { bf16*stg=(bf16*)(shm+LDS_OST)+wid*2048;
    #pragma unroll
    for(int r=0;r<16;++r){const int orow=crow(r,hi);
      #pragma unroll
      for(int d0=0;d0<2;++d0)stg[orow*64+d0*32+r32]=__float2bfloat16(o[d0][r]*rli[r]);}
    asm volatile("s_waitcnt lgkmcnt(0)":::"memory");
    #pragma unroll
    for(int i=0;i<4;++i){const int row=i*8+(lane>>3),ch=lane&7; const u32x4 v=*(const u32x4*)(stg+row*64+ch*8); ATTN_STORE16(Ow+(long)row*DM+ch*8,v);} }
  asm volatile("s_waitcnt lgkmcnt(0)\n\ts_barrier":::"memory");
  #undef BINIT
  #undef BLOAD
  #undef DMA_K
  #undef DMA_V
  #undef CMASK
  #undef START
  #undef RESC
  #undef ROT
}
constexpr int ATTN_LDS_BYTES=LDS_BYTES;
#undef SBAR
#undef WAIT_BAR
}

#define LAS __attribute__((address_space(3)))
typedef unsigned short bf16;
typedef unsigned v4u __attribute__((ext_vector_type(4)));
typedef unsigned v2u __attribute__((ext_vector_type(2)));
typedef float f32x4 __attribute__((ext_vector_type(4)));
typedef float f32x16 __attribute__((ext_vector_type(16)));
typedef short bf16x8 __attribute__((ext_vector_type(8)));

constexpr int MP = 65536, MS = 1024, MT = MP + MS, DMODEL = 1024, FF = 2816, SEQL = 4096, PAST = 1024, SSQ_ = 64, KVS = PAST + SSQ_;
constexpr float LOG2E = 1.4426950408889634f;
constexpr size_t MiB = 1u << 20;
constexpr size_t WS_WPOOL = 0, WS_WGU0 = 1 * MiB, WS_WGU1 = 12 * MiB, WS_WDN0 = 23 * MiB, WS_WDN1 = 29 * MiB, WS_WKVQ = 35 * MiB, WS_WO = 42 * MiB,
                 WS_RSTD = 44 * MiB, WS_SSQ = 45 * MiB, WS_DK2 = 50 * MiB, WS_DKS = 54 * MiB, WS_XB = 64 * MiB, WS_PB = 194 * MiB, WS_R1 = 324 * MiB,
                 WS_KB = WS_R1, WS_VB = WS_R1 + 130 * MiB, WS_QB = WS_R1 + 260 * MiB, WS_GN = 56 * MiB, WS_CTL = 57 * MiB, WS_KVQS = 58 * MiB, WS_END = WS_R1 + 390 * MiB;
constexpr int LDS_BYTES = 147456;
constexpr int DK_OFF = 86016;
static_assert(attn_body::ATTN_LDS_BYTES <= DK_OFF && DK_OFF + 16384 <= LDS_BYTES && pg8::STAGE_BYTES <= LDS_BYTES, "LDS map");

__device__ __forceinline__ float wave_sum(float v) {
#pragma unroll
    for (int o = 1; o < 64; o <<= 1) v += __shfl_xor(v, o);
    return v;
}
__device__ __forceinline__ float wave_max(float v) {
#pragma unroll
    for (int o = 1; o < 64; o <<= 1) v = fmaxf(v, __shfl_xor(v, o));
    return v;
}
__device__ __forceinline__ unsigned pk2(float lo, float hi) { return pg8::cvt_pk_bf16(lo, hi); }
__device__ __forceinline__ float bf2f(unsigned short b) { return __uint_as_float((unsigned)b << 16); }
__device__ __forceinline__ int crow(int r, int hi) { return (r & 3) + 8 * (r >> 2) + 4 * hi; }

struct RmOff { int off; __device__ __forceinline__ int operator()(int n) const { return off + n; } };
struct RmGU  { int up;  __device__ __forceinline__ int operator()(int n) const { return 256 * (n >> 7) + (n & 127) + up * 128; } };
struct RmKVQ { int base; __device__ __forceinline__ int operator()(int n) const { const int l = n & 255; return base + (n & ~255) + 128 * ((l >> 5) & 1) + 32 * (l >> 6) + (l & 31); } };

template <class RowMap> __device__ __forceinline__ void transpose_item(const float* W, int K, int N, bf16* WT, const RowMap rm, const float* kgain, const float* nscale, LAS float* scr, int item, int lane) {
    const int nblk = N / 32, kb = item / nblk, nb = item % nblk, k0 = 64 * kb, n0 = 32 * nb;
    const float ns = nscale ? nscale[n0 + (lane & 31)] : 1.f;
#pragma unroll 8
    for (int i = 0; i < 32; ++i) { const int kk = 2 * i + (lane >> 5); float v = W[(size_t)(k0 + kk) * N + n0 + (lane & 31)] * ns; if (kgain) v *= kgain[k0 + kk]; scr[kk * 33 + (lane & 31)] = v; }
    asm volatile("s_waitcnt lgkmcnt(0)" ::: "memory");
    const int c = lane & 7;
#pragma unroll
    for (int j = 0; j < 4; ++j) { const int n = (lane >> 3) + 8 * j; const LAS float* s = scr + (8 * c) * 33 + n;
        v4u o; o.x = pk2(s[0 * 33], s[1 * 33]); o.y = pk2(s[2 * 33], s[3 * 33]); o.z = pk2(s[4 * 33], s[5 * 33]); o.w = pk2(s[6 * 33], s[7 * 33]);
        *(v4u*)(WT + (size_t)rm(n0 + n) * K + k0 + 8 * c) = o; }
    asm volatile("s_waitcnt lgkmcnt(0)" ::: "memory");
}

#define XB_TMO      128
#define XB_XCNT(j)  (256  + 64 * (j))
#define XB_XSUB(j)  (1280 + 64 * (j))
#define XB_XGEN(j)  (2304 + 64 * (j))
#define XB_TOP      3328
#define XB_TOPGEN   3392
#define XCD_BAR_WORDS 3456
#define XB_SPIN_CAP (1u << 18)

__device__ __forceinline__ unsigned xb_ld(unsigned* p)              { return __hip_atomic_load(p, __ATOMIC_RELAXED, __HIP_MEMORY_SCOPE_AGENT); }
__device__ __forceinline__ unsigned xb_add(unsigned* p, unsigned v) { return __hip_atomic_fetch_add(p, v, __ATOMIC_RELAXED, __HIP_MEMORY_SCOPE_AGENT); }
__device__ __forceinline__ unsigned xb_xcc_id() { return (unsigned)__builtin_amdgcn_s_getreg((3 << 11) | 20) & 0xFu; }
#define XB_SPIN(cond, bar) do { unsigned _sp = 0; while (cond) { __builtin_amdgcn_s_sleep(1); \
    if ((++_sp & 255u) == 0u) { if (xb_ld(&(bar)[XB_TMO])) break; if (_sp > XB_SPIN_CAP) { atomicAdd(&(bar)[XB_TMO], 1u); break; } } } } while (0)

struct XcdBarrier {
    unsigned* bar; unsigned x;
    volatile LAS unsigned* st;
};

__device__ __forceinline__ XcdBarrier xcd_barrier_post(unsigned* bar, volatile LAS unsigned* st) {
    XcdBarrier b; b.bar = bar; b.x = xb_xcc_id(); b.st = st;
    if (threadIdx.x == 0) (void)xb_add(&bar[XB_XCNT(b.x)], 1u);
    return b;
}
__device__ __forceinline__ void xcd_barrier_complete(unsigned* bar, unsigned x, unsigned& nloc, unsigned& nx) {
    const unsigned G = gridDim.x * gridDim.y * gridDim.z;
    unsigned sum, cnt, mine, sp = 0u;
    for (;;) {
        sum = 0u; cnt = 0u; mine = 0u;
#pragma unroll
        for (unsigned j = 0; j < 16; ++j) { const unsigned c = xb_ld(&bar[XB_XCNT(j)]); sum += c; cnt += (c > 0u) ? 1u : 0u; mine = (j == x) ? c : mine; }
        if (sum == G) break;
        __builtin_amdgcn_s_sleep(1);
        if ((++sp & 255u) == 0u) { if (xb_ld(&bar[XB_TMO])) break; if (sp > XB_SPIN_CAP) { atomicAdd(&bar[XB_TMO], 1u); break; } }
    }
    nloc = mine > 0u ? mine : 1u; nx = cnt > 0u ? cnt : 1u;
}

__device__ __forceinline__ void xcd_barrier(const XcdBarrier& b) {
    asm volatile("s_waitcnt vmcnt(0)" ::: "memory");
    __syncthreads();
    if (threadIdx.x == 0) {
        unsigned* bar = b.bar;
        __builtin_amdgcn_s_waitcnt(0);
        unsigned nloc = b.st[0], nx = b.st[1];
        if (nloc == 0u) { xcd_barrier_complete(bar, b.x, nloc, nx); b.st[0] = nloc; b.st[1] = nx; }
        const unsigned old = xb_add(&bar[XB_XSUB(b.x)], 1u);
        const unsigned gen = old / nloc;
        if (old + 1u == (gen + 1u) * nloc) {
            __builtin_amdgcn_fence(__ATOMIC_RELEASE, "agent");
            asm volatile("s_waitcnt vmcnt(0)" ::: "memory");
            const unsigned og = xb_add(&bar[XB_TOP], 1u);
            const unsigned tg = og / nx;
            if (og + 1u == (tg + 1u) * nx) xb_add(&bar[XB_TOPGEN], 1u);
            else XB_SPIN(xb_ld(&bar[XB_TOPGEN]) == tg, bar);
            __builtin_amdgcn_fence(__ATOMIC_ACQUIRE, "agent");
            xb_add(&bar[XB_XGEN(b.x)], 1u);
            asm volatile("s_waitcnt vmcnt(0)" ::: "memory");
        } else {
            XB_SPIN(xb_ld(&bar[XB_XGEN(b.x)]) == gen, bar);
            __builtin_amdgcn_fence(__ATOMIC_ACQUIRE, "agent");
            asm volatile("s_waitcnt vmcnt(0)" ::: "memory");
        }
    }
    __syncthreads();
}

struct Args { const float* in[22]; float* out; unsigned char* ws; };
enum { I_XP = 0, I_XS, I_SP, I_CK, I_CV, I_CL, I_GMIX, I_GFFN, I_PW, I_PS, I_GKV, I_WK, I_WV, I_WF, I_BF, I_GKN, I_WQ, I_GQN, I_WO, I_WG, I_WU, I_WD };

template <int W> __device__ __forceinline__ void pool_item(const float* xb_, const float* rstd, const float* sp_, int t0, bool smp, f32x4 gm, bf16* pb_, float* ps_, int pst) {
    f32x4 halo[W - 1], mn[16];
    if (t0 > 0) {
#pragma unroll
        for (int i = 0; i < W - 1; ++i) { const int t = t0 - (W - 1) + i; halo[i] = (*(const f32x4*)(xb_ + (size_t)t * 1024) * rstd[t]) * gm; }
    } else if (smp) {
#pragma unroll
        for (int i = 0; i < W - 1; ++i) halo[i] = *(const f32x4*)(sp_ + (size_t)(15 - (W - 1) + i) * 1024);
    } else {
#pragma unroll
        for (int i = 0; i < W - 1; ++i) halo[i] = (f32x4){0.f, 0.f, 0.f, 0.f};
    }
#pragma unroll
    for (int r = 0; r < 16; ++r) mn[r] = (*(const f32x4*)(xb_ + (size_t)(t0 + r) * 1024) * rstd[t0 + r]) * gm;
    f32x4 s = {0.f, 0.f, 0.f, 0.f};
#pragma unroll
    for (int i = 0; i < W - 1; ++i) s += halo[i];
#pragma unroll
    for (int r = 0; r < 16; ++r) {
        const int t = t0 + r; s += mn[r];
        const int cnt = (smp || t + 1 >= W) ? W : t + 1;
        const f32x4 p = s * (1.0f / (float)cnt) - mn[r];
        v2u pw; pw.x = pk2(p[0], p[1]); pw.y = pk2(p[2], p[3]);
        *(v2u*)(pb_ + (size_t)r * 1024) = pw;
        if (t >= pst) *(f32x4*)(ps_ + (size_t)(t - pst) * 1024) = mn[r];
        s -= (r - (W - 1) >= 0) ? mn[r - (W - 1) >= 0 ? r - (W - 1) : 0] : halo[r < W - 1 ? r : 0];
    }
}

template <int W> __device__ __forceinline__ void pool_step(const f32x4 (&prev)[16], const f32x4 (&mn)[16], int t0, bool smp, bf16* pb_, float* ps_, int pst) {
    f32x4 s = {0.f, 0.f, 0.f, 0.f};
#pragma unroll
    for (int i = 0; i < W - 1; ++i) s += prev[16 - (W - 1) + i];
#pragma unroll
    for (int r = 0; r < 16; ++r) {
        const int t = t0 + r; s += mn[r];
        const int cnt = (smp || t + 1 >= W) ? W : t + 1;
        const f32x4 p = s * (1.0f / (float)cnt) - mn[r];
        v2u pw; pw.x = pk2(p[0], p[1]); pw.y = pk2(p[2], p[3]);
        *(v2u*)(pb_ + (size_t)r * 1024) = pw;
        if (t >= pst) *(f32x4*)(ps_ + (size_t)(t - pst) * 1024) = mn[r];
        s -= (r - (W - 1) >= 0) ? mn[r - (W - 1) >= 0 ? r - (W - 1) : 0] : prev[(16 - (W - 1) + r) < 16 ? (16 - (W - 1) + r) : 0];
    }
}

__device__ __forceinline__ void sample_attn(int b, int h, const float* ck, const float* cv, const bf16* KB, const bf16* VB, const bf16* QB, const float* dks, bf16* OB,
                                            LAS unsigned char* lds, int tid, int lane, int wid) {
    constexpr int RS = 144;
    LAS unsigned char* Ks = lds; LAS unsigned char* Vs = lds + 128 * RS; LAS float* comb = (LAS float*)(lds + 2 * 128 * RS);
    const int r32 = lane & 31, hi = lane >> 5, qh = wid & 1, kg = wid >> 1;
    const int qrow = MP + b * 64 + qh * 32 + r32;
    bf16x8 qf[4];
#pragma unroll
    for (int d0 = 0; d0 < 4; ++d0) qf[d0] = *(const bf16x8*)(QB + (size_t)qrow * 1024 + h * 64 + d0 * 16 + hi * 8);
    const int qpos = PAST + qh * 32 + r32; const float dq2 = dks[qpos];
    float m = -1e30f, l = 0.f; f32x16 o0 = {}, o1 = {};
    const int kk = tid >> 2, dseg = (tid & 3) * 16;
    f32x4 kr[4], vr[4];
#define SA_LOAD(c) do { const int j_ = 128 * (c) + kk; \
        if (j_ < PAST) { const f32x4* pk_ = (const f32x4*)(ck + (((size_t)b * PAST + j_) * 16 + h) * 64 + dseg); const f32x4* pv_ = (const f32x4*)(cv + (((size_t)b * PAST + j_) * 16 + h) * 64 + dseg); \
            _Pragma("unroll") for (int i_ = 0; i_ < 4; ++i_) { kr[i_] = pk_[i_]; vr[i_] = pv_[i_]; } } \
        else if (j_ < KVS) { const v4u* pk_ = (const v4u*)(KB + (size_t)(MP + b * 64 + j_ - PAST) * 1024 + h * 64 + dseg); const v4u* pv_ = (const v4u*)(VB + (size_t)(MP + b * 64 + j_ - PAST) * 1024 + h * 64 + dseg); \
            _Pragma("unroll") for (int i_ = 0; i_ < 2; ++i_) { const v4u a_ = pk_[i_], c_ = pv_[i_]; \
                kr[2 * i_] = (f32x4){__uint_as_float(a_.x << 16), __uint_as_float(a_.x & 0xffff0000u), __uint_as_float(a_.y << 16), __uint_as_float(a_.y & 0xffff0000u)}; \
                kr[2 * i_ + 1] = (f32x4){__uint_as_float(a_.z << 16), __uint_as_float(a_.z & 0xffff0000u), __uint_as_float(a_.w << 16), __uint_as_float(a_.w & 0xffff0000u)}; \
                vr[2 * i_] = (f32x4){__uint_as_float(c_.x << 16), __uint_as_float(c_.x & 0xffff0000u), __uint_as_float(c_.y << 16), __uint_as_float(c_.y & 0xffff0000u)}; \
                vr[2 * i_ + 1] = (f32x4){__uint_as_float(c_.z << 16), __uint_as_float(c_.z & 0xffff0000u), __uint_as_float(c_.w << 16), __uint_as_float(c_.w & 0xffff0000u)}; } } \
        else { _Pragma("unroll") for (int i_ = 0; i_ < 4; ++i_) { kr[i_] = (f32x4){0.f, 0.f, 0.f, 0.f}; vr[i_] = (f32x4){0.f, 0.f, 0.f, 0.f}; } } } while (0)
    SA_LOAD(0);
    for (int c = 0; c < 9; ++c) {
        __syncthreads();
        {
            v4u a, bq;
            a.x = pk2(kr[0][0], kr[0][1]); a.y = pk2(kr[0][2], kr[0][3]); a.z = pk2(kr[1][0], kr[1][1]); a.w = pk2(kr[1][2], kr[1][3]);
            bq.x = pk2(kr[2][0], kr[2][1]); bq.y = pk2(kr[2][2], kr[2][3]); bq.z = pk2(kr[3][0], kr[3][1]); bq.w = pk2(kr[3][2], kr[3][3]);
            *(LAS v4u*)(Ks + kk * RS + dseg * 2) = a; *(LAS v4u*)(Ks + kk * RS + dseg * 2 + 16) = bq;
            a.x = pk2(vr[0][0], vr[0][1]); a.y = pk2(vr[0][2], vr[0][3]); a.z = pk2(vr[1][0], vr[1][1]); a.w = pk2(vr[1][2], vr[1][3]);
            bq.x = pk2(vr[2][0], vr[2][1]); bq.y = pk2(vr[2][2], vr[2][3]); bq.z = pk2(vr[3][0], vr[3][1]); bq.w = pk2(vr[3][2], vr[3][3]);
            *(LAS v4u*)(Vs + kk * RS + dseg * 2) = a; *(LAS v4u*)(Vs + kk * RS + dseg * 2 + 16) = bq;
        }
        __syncthreads();
        if (c + 1 < 9) SA_LOAD(c + 1);
        const int kvb = 128 * c + 32 * kg;
        if (kvb < KVS) {
            f32x16 s = {};
#pragma unroll
            for (int d0 = 0; d0 < 4; ++d0) { const bf16x8 kf = *(const LAS bf16x8*)(Ks + (32 * kg + r32) * RS + (d0 * 16 + hi * 8) * 2); s = __builtin_amdgcn_mfma_f32_32x32x16_bf16(kf, qf[d0], s, 0, 0, 0); }
            float mx = -1e30f;
#pragma unroll
            for (int jj = 0; jj < 4; ++jj) { const f32x4 dk = *(const f32x4*)(dks + kvb + 8 * jj + 4 * hi);
#pragma unroll
                for (int e = 0; e < 4; ++e) { const int kv = kvb + 8 * jj + 4 * hi + e; float x = s[4 * jj + e] + dq2 - dk[e]; x = (kv > qpos) ? -1e30f : x; s[4 * jj + e] = x; mx = fmaxf(mx, x); } }
            mx = fmaxf(mx, __shfl_xor(mx, 32));
            const float mn = fmaxf(m, mx), alpha = __builtin_amdgcn_exp2f(m - mn); m = mn;
            float ps = 0.f;
#pragma unroll
            for (int r = 0; r < 16; ++r) { s[r] = __builtin_amdgcn_exp2f(s[r] - mn); ps += s[r]; }
            l = l * alpha + ps; o0 = o0 * alpha; o1 = o1 * alpha;
#pragma unroll
            for (int ks = 0; ks < 2; ++ks) {
                v4u pw; pw.x = pk2(s[8 * ks], s[8 * ks + 1]); pw.y = pk2(s[8 * ks + 2], s[8 * ks + 3]); pw.z = pk2(s[8 * ks + 4], s[8 * ks + 5]); pw.w = pk2(s[8 * ks + 6], s[8 * ks + 7]);
                const bf16x8 pb = __builtin_bit_cast(bf16x8, pw);
#pragma unroll
                for (int dh = 0; dh < 2; ++dh) { bf16x8 va;
#pragma unroll
                    for (int i = 0; i < 8; ++i) va[i] = *(const LAS short*)(Vs + (32 * kg + crow(8 * ks + i, hi)) * RS + (dh * 32 + r32) * 2);
                    if (dh == 0) o0 = __builtin_amdgcn_mfma_f32_32x32x16_bf16(va, pb, o0, 0, 0, 0); else o1 = __builtin_amdgcn_mfma_f32_32x32x16_bf16(va, pb, o1, 0, 0, 0); }
            }
        }
    }
#undef SA_LOAD
    l += __shfl_xor(l, 32);
    LAS float* cw = comb + wid * (32 * 66) + r32 * 66;
#pragma unroll
    for (int r = 0; r < 16; ++r) { cw[crow(r, hi)] = o0[r]; cw[32 + crow(r, hi)] = o1[r]; }
    if (hi == 0) { cw[64] = m; cw[65] = l; }
    __syncthreads();
    {
        const int q64 = tid >> 3, d8 = (tid & 7) * 8, qh2 = q64 >> 5, ql = q64 & 31;
        float M = -1e30f;
#pragma unroll
        for (int g = 0; g < 4; ++g) M = fmaxf(M, comb[(g * 2 + qh2) * (32 * 66) + ql * 66 + 64]);
        float den = 0.f, a8[8];
#pragma unroll
        for (int e = 0; e < 8; ++e) a8[e] = 0.f;
#pragma unroll
        for (int g = 0; g < 4; ++g) { const LAS float* base = comb + (g * 2 + qh2) * (32 * 66) + ql * 66; const float w = __builtin_amdgcn_exp2f(base[64] - M); den += w * base[65];
#pragma unroll
            for (int e = 0; e < 8; ++e) a8[e] += w * base[d8 + e]; }
        const float inv = 1.0f / den;
        v4u w; w.x = pk2(a8[0] * inv, a8[1] * inv); w.y = pk2(a8[2] * inv, a8[3] * inv); w.z = pk2(a8[4] * inv, a8[5] * inv); w.w = pk2(a8[6] * inv, a8[7] * inv);
        *(v4u*)(OB + (size_t)(MP + b * 64 + q64) * 1024 + h * 64 + d8) = w;
    }
    __syncthreads();
}

#ifndef PG_ALIGN
#define PG_ALIGN true
#endif
#ifndef PH_MASK
#define PH_MASK 0xFFFF
#endif
#define RUN(p) (((PH_MASK) >> (p)) & 1)
#ifndef REP_MASK
#define REP_MASK 0
#endif
#define NREP(p) (1 + (((REP_MASK) >> (p)) & 1))

__global__ void __launch_bounds__(512, 2) mega(Args a) {
    extern __shared__ __attribute__((aligned(16))) unsigned char lds_raw[];
    cg::grid_group grid = cg::this_grid();
    LAS unsigned char* lds = (LAS unsigned char*)lds_raw;
    const int G = gridDim.x;
    int vcu;
    {
        LAS int* vs = (LAS int*)(lds_raw + LDS_BYTES - 16);
        if (threadIdx.x == 0) {
            unsigned* cen = (unsigned*)(a.ws + WS_CTL);
            const unsigned xcc = (unsigned)__builtin_amdgcn_s_getreg((3 << 11) | 20) & 7u;
            const unsigned rank = __hip_atomic_fetch_add(cen + 64 * xcc, 1u, __ATOMIC_RELAXED, __HIP_MEMORY_SCOPE_AGENT);
            vs[0] = (G == 256 && rank < 32u) ? (int)(xcc + 8u * rank) : -1;
        }
        __syncthreads();
        vcu = __builtin_amdgcn_readfirstlane(vs[0]);
        if (threadIdx.x == 0) { vs[1] = 0; vs[2] = 0; }
        __syncthreads();
    }
#define PHASE_ENTER() int tid_o = threadIdx.x; asm volatile("" : "+v"(tid_o)); const int tid = tid_o, lane = tid & 63, wave = __builtin_amdgcn_readfirstlane(tid >> 6); (void)lane; (void)wave; \
    int bx_o = blockIdx.x; asm volatile("" : "+s"(bx_o)); const int bx = bx_o; size_t zo_ = 0; asm volatile("" : "+s"(zo_)); unsigned char* ws = a.ws + zo_; float* out = a.out + zo_; \
    const float* xp = a.in[I_XP]; const float* xs = a.in[I_XS]; (void)xp; (void)xs; \
    bf16* WPOOL = (bf16*)(ws + WS_WPOOL); bf16* WKVQ = (bf16*)(ws + WS_WKVQ); bf16* WOT = (bf16*)(ws + WS_WO); \
    float* RSTD = (float*)(ws + WS_RSTD); float* SSQ = (float*)(ws + WS_SSQ); float* DK2 = (float*)(ws + WS_DK2); float* DKS = (float*)(ws + WS_DKS); \
    bf16* XB = (bf16*)(ws + WS_XB); bf16* PB = (bf16*)(ws + WS_PB); bf16* OB = PB; bf16* ACT = (bf16*)(ws + WS_R1); \
    bf16* QB = (bf16*)(ws + WS_QB); bf16* KB = (bf16*)(ws + WS_KB); bf16* VB = (bf16*)(ws + WS_VB); \
    (void)WPOOL; (void)WKVQ; (void)WOT; (void)RSTD; (void)SSQ; (void)DK2; (void)DKS; (void)XB; (void)PB; (void)OB; (void)ACT; (void)QB; (void)KB; (void)VB;
    (void)xcd_barrier_post((unsigned*)(a.ws + WS_CTL + 4096), (volatile LAS unsigned*)(lds_raw + LDS_BYTES - 12));
#define GSYNC() do { size_t zb_ = 0; asm volatile("" : "+s"(zb_)); XcdBarrier xb_; xb_.bar = (unsigned*)(a.ws + WS_CTL + 4096) + zb_; xb_.x = xb_xcc_id(); xb_.st = (volatile LAS unsigned*)(lds_raw + LDS_BYTES - 12); xcd_barrier(xb_); } while (0)
#define GSYNC0() do { asm volatile("s_waitcnt vmcnt(0)" ::: "memory"); grid.sync(); __builtin_amdgcn_fence(__ATOMIC_ACQUIRE, "agent"); asm volatile("s_waitcnt vmcnt(0)" ::: "memory"); } while (0)

    grid.sync();
    for (int rep_ = 0; rep_ < NREP(0); ++rep_) { if (rep_) GSYNC(); PHASE_ENTER();
        LAS float* scr = (LAS float*)(lds + wave * 16384);
        const int gw = bx * 8 + wave, NGW = G * 8;
        constexpr int I_POOL = 4 * 32, I_GU = 16 * 88, I_DN = 44 * 32, I_SQ = 16 * 32;
        constexpr int NITEMS = I_POOL + 4 * I_GU + 2 * I_DN + 4 * I_SQ;
        for (int it = gw; it < NITEMS; it += NGW) {
            int r = it;
            if (r < I_POOL) { const int mtx = r >> 5; transpose_item(a.in[I_PW] + (size_t)mtx * 65536, 256, 256, WPOOL, RmOff{mtx * 256}, nullptr, a.in[I_PS] + mtx * 256, scr, r & 31, lane); continue; } r -= I_POOL;
            if (r < 4 * I_GU) { const int mtx = r / I_GU, l = mtx >> 1, up = mtx & 1; transpose_item((up ? a.in[I_WU] : a.in[I_WG]) + (size_t)l * 1024 * 2816, 1024, 2816, (bf16*)(ws + (l ? WS_WGU1 : WS_WGU0)), RmGU{up}, a.in[I_GFFN] + l * 1024, nullptr, scr, r % I_GU, lane); continue; } r -= 4 * I_GU;
            if (r < 2 * I_DN) { const int l = r / I_DN; transpose_item(a.in[I_WD] + (size_t)l * 2816 * 1024, 2816, 1024, (bf16*)(ws + (l ? WS_WDN1 : WS_WDN0)), RmOff{0}, nullptr, nullptr, scr, r % I_DN, lane); continue; } r -= 2 * I_DN;
            if (r < I_SQ) { transpose_item(a.in[I_WK], 1024, 1024, WKVQ, RmKVQ{0}, a.in[I_GKV], nullptr, scr, r, lane); continue; } r -= I_SQ;
            if (r < I_SQ) { transpose_item(a.in[I_WV], 1024, 1024, WKVQ, RmKVQ{1024}, a.in[I_GKV], nullptr, scr, r, lane); continue; } r -= I_SQ;
            if (r < I_SQ) { transpose_item(a.in[I_WQ], 1024, 1024, WKVQ, RmKVQ{2048}, a.in[I_GMIX] + 1024, nullptr, scr, r, lane); continue; } r -= I_SQ;
            transpose_item(a.in[I_WO], 1024, 1024, WOT, RmOff{0}, nullptr, nullptr, scr, r, lane);
        }
        const int gt = bx * 512 + tid, NT = G * 512;
        for (int i = gt; i < 16 * 1024; i += NT) { const int n = i >> 10, k = i & 1023; WKVQ[(size_t)(3072 + n) * 1024 + k] = (bf16)(pk2(a.in[I_WF][k * 16 + n] * a.in[I_GKV][k], 0.f) & 0xffffu); }
        if (gt < 192) ((float*)(ws + WS_GN))[gt] = gt < 64 ? a.in[I_GKN][gt] : gt < 128 ? 1.0f : a.in[I_GQN][gt - 128] * (0.125f * LOG2E);
        for (int i = gt; i < 240 * 1024 / 8; i += NT) ((v4u*)(WKVQ + (size_t)3088 * 1024))[i] = (v4u){0u, 0u, 0u, 0u};
    }
    __syncthreads();

    for (int rep_ = 0; rep_ < NREP(1); ++rep_) { if (rep_) GSYNC(); PHASE_ENTER();
        const int half = tid >> 8, c4 = (tid & 255) * 4, grp = __builtin_amdgcn_readfirstlane(c4 >> 8), wq = (tid >> 6) & 3;
        const f32x4 gm = *(const f32x4*)(a.in[I_GMIX] + c4);
        LAS float* redb = (LAS float*)lds + half * 64; int par = 0;
        f32x4 prev[16], raw[16]; float rs[16];
#define P1_LOAD(src, t_first) do { _Pragma("unroll") for (int r_ = 0; r_ < 16; ++r_) raw[r_] = *(const f32x4*)((src) + (size_t)((t_first) + r_) * 1024); } while (0)
#define P1_RSTD(valid) do { float ss_[16]; \
            _Pragma("unroll") for (int r_ = 0; r_ < 16; ++r_) { const f32x4 v_ = raw[r_]; ss_[r_] = (valid) ? wave_sum((v_[0] * v_[0] + v_[1] * v_[1]) + (v_[2] * v_[2] + v_[3] * v_[3])) : 0.f; } \
            LAS float* red_ = redb + par * 128; par ^= 1; \
            if (lane == 0) { _Pragma("unroll") for (int r_ = 0; r_ < 16; r_ += 4) *(LAS f32x4*)(red_ + wq * 16 + r_) = (f32x4){ss_[r_], ss_[r_ + 1], ss_[r_ + 2], ss_[r_ + 3]}; } \
            __syncthreads(); \
            _Pragma("unroll") for (int r_ = 0; r_ < 16; ++r_) rs[r_] = __builtin_amdgcn_rsqf(((red_[r_] + red_[16 + r_]) + (red_[32 + r_] + red_[48 + r_])) * (1.0f / 1024.0f) + 1e-6f); } while (0)
#define P1_STEP(t0_, smp_, pb_, ps_, pst_) do { if (grp == 0) pool_step<2>(prev, raw, t0_, smp_, pb_, ps_, pst_); else if (grp == 1) pool_step<4>(prev, raw, t0_, smp_, pb_, ps_, pst_); \
            else if (grp == 2) pool_step<8>(prev, raw, t0_, smp_, pb_, ps_, pst_); else pool_step<16>(prev, raw, t0_, smp_, pb_, ps_, pst_); } while (0)
        for (int run = bx * 2 + half; run < 512; run += G * 2) {
            const int row0 = run * 128, b = row0 >> 12, tr = row0 & 4095;
            const float* xb_ = xp + (size_t)(row0 - tr) * 1024 + c4;
            float* ps_ = out + pg8::O_PSP + (size_t)b * 15 * 1024 + c4;
            if (tr > 0) P1_LOAD(xb_, tr - 16);
            P1_RSTD(tr > 0);
#pragma unroll
            for (int r = 0; r < 16; ++r) prev[r] = (tr > 0) ? (raw[r] * rs[r]) * gm : (f32x4){0.f, 0.f, 0.f, 0.f};
            for (int st = 0; st < 8; ++st) {
                const int t0 = tr + 16 * st;
                P1_LOAD(xb_, t0);
                P1_RSTD(true);
#pragma unroll
                for (int r = 0; r < 16; ++r) raw[r] = (raw[r] * rs[r]) * gm;
                P1_STEP(t0, false, PB + (size_t)(row0 + 16 * st) * 1024 + c4, ps_, 4081);
#pragma unroll
                for (int r = 0; r < 16; ++r) prev[r] = raw[r];
            }
        }
        for (int si = bx * 2 + half; si < 64; si += G * 2) {
            const int b = si >> 2, t0 = 16 * (si & 3);
            const float* xb_ = xs + (size_t)b * 64 * 1024 + c4;
            const float* sp_ = a.in[I_SP] + (size_t)b * 15 * 1024 + c4;
            if (t0 > 0) P1_LOAD(xb_, t0 - 16);
            P1_RSTD(t0 > 0);
            if (t0 > 0) {
#pragma unroll
                for (int r = 0; r < 16; ++r) prev[r] = (raw[r] * rs[r]) * gm;
            } else {
                prev[0] = (f32x4){0.f, 0.f, 0.f, 0.f};
#pragma unroll
                for (int r = 1; r < 16; ++r) prev[r] = *(const f32x4*)(sp_ + (size_t)(r - 1) * 1024);
            }
            P1_LOAD(xb_, t0);
            P1_RSTD(true);
#pragma unroll
            for (int r = 0; r < 16; ++r) raw[r] = (raw[r] * rs[r]) * gm;
            P1_STEP(t0, true, PB + (size_t)(MP + 16 * si) * 1024 + c4, out + pg8::O_PSS + (size_t)b * 15 * 1024 + c4, 49);
        }
#undef P1_LOAD
#undef P1_RSTD
#undef P1_STEP
    }
    GSYNC();
    {
        const unsigned* cen = (const unsigned*)(a.ws + WS_CTL); bool okc = (G == 256);
#pragma unroll
        for (int x = 0; x < 8; ++x) okc = okc && (__hip_atomic_load(cen + 64 * x, __ATOMIC_RELAXED, __HIP_MEMORY_SCOPE_AGENT) == 32u);
        if (!okc) vcu = blockIdx.x;
    }

    for (int rep_ = 0; rep_ < NREP(2); ++rep_) { if (rep_) GSYNC(); PHASE_ENTER();
        pg8::Gemm g{PB, WPOOL, MT, 1024, 256, 1024, 256}; pg8::StaticOrder S; S.init(MP, 1024, G, vcu);
        pg8::EpiRes<true, false, false> E{xp, xs, out, XB, SSQ, nullptr};
        pg8::gemm_phase<pg8::EpiRes<true, false, false>, pg8::StaticOrder, PG_ALIGN, true>(lds, g, S, E);
    }
    GSYNC();

    for (int l = 0; l < 2; ++l) {
        if (l == 1) {
            for (int rep_ = 0; rep_ < NREP(5); ++rep_) { if (rep_) GSYNC(); PHASE_ENTER();
                pg8::Gemm g{XB, WKVQ, MT, 3328, 1024, 1024, 0}; pg8::StaticOrder S; S.init(MP, 3328, G, vcu);
                pg8::EpiKVQ E{SSQ, (const float*)(ws + WS_GN), a.in[I_BF], out, KB, (size_t)(130 * MiB / 2)};
                pg8::gemm_phase<pg8::EpiKVQ, pg8::StaticOrder, PG_ALIGN, true>(lds, g, S, E);
            }
            GSYNC();
            for (int rep_ = 0; rep_ < NREP(7); ++rep_) { if (rep_) GSYNC(); PHASE_ENTER();
                const float mq = wave_max(fabsf(a.in[I_GQN][lane])), mk = wave_max(fabsf(a.in[I_GKN][lane]));
                const float lowc = -(0.125f * LOG2E * 64.f) * mq * mk;
                for (int u = bx; u < 256; u += G) {
                    const int b = u >> 4, h = u & 15;
                    {
                        const float* lp = out + pg8::O_LP + ((size_t)b * 4096 + 8 * tid) * 16 + h; float v[8];
#pragma unroll
                        for (int k = 0; k < 8; ++k) v[k] = lp[(size_t)k * 16];
#pragma unroll
                        for (int k = 1; k < 8; ++k) v[k] += v[k - 1];
                        float inc = v[7];
#pragma unroll
                        for (int o = 1; o < 64; o <<= 1) { const float t = __shfl_up(inc, o); if (lane >= o) inc += t; }
                        LAS float* wt = (LAS float*)(lds + DK_OFF + 16384);
                        if (lane == 63) wt[wave] = inc;
                        __syncthreads();
                        float pre = 0.f;
#pragma unroll
                        for (int w = 0; w < 8; ++w) pre += (w < wave) ? wt[w] : 0.f;
                        const float ex = pre + inc - v[7];
                        LAS f32x4* dstl = (LAS f32x4*)(lds + DK_OFF) + 2 * tid;
                        dstl[0] = (f32x4){(v[0] + ex) * LOG2E, (v[1] + ex) * LOG2E, (v[2] + ex) * LOG2E, (v[3] + ex) * LOG2E};
                        dstl[1] = (f32x4){(v[4] + ex) * LOG2E, (v[5] + ex) * LOG2E, (v[6] + ex) * LOG2E, (v[7] + ex) * LOG2E};
                    }
                    __syncthreads();
                    for (int qb = 15; qb >= 0; --qb) {
                        const LAS float* dl = (const LAS float*)(lds + DK_OFF);
                        const float thr = dl[256 * qb] - 2.f * lowc + 45.f;
                        const int jmax = 4 * qb;
                        const bool sk = (lane < jmax) && (dl[64 * lane + 63] > thr);
                        const int t0 = (int)__builtin_popcountll(__ballot(sk)) & ~1;
                        attn_body::attn_unit<8>(b, h, qb, (const attn_body::bf16*)QB, (const attn_body::bf16*)KB, (const attn_body::bf16*)VB, (attn_body::bf16*)OB, (char*)lds_raw,
                                                (const LAS float*)(lds + DK_OFF), lowc, t0);
                    }
                    __syncthreads();
                }
            }
            for (int rep_ = 0; rep_ < NREP(7); ++rep_) { if (rep_) GSYNC(); PHASE_ENTER();
                for (int u = bx; u < 256; u += G) {
                    {
                        const int b = u >> 4, h = u & 15; const float* ls = out + pg8::O_LS + (size_t)b * 64 * 16 + h; const float* cl = a.in[I_CL] + (size_t)b * 1024 * 16 + h; float v[4];
#pragma unroll
                        for (int k = 0; k < 4; ++k) { const int j = 4 * tid + k; v[k] = j < PAST ? cl[(size_t)j * 16] : (j < KVS ? ls[(size_t)(j - PAST) * 16] : 0.f); }
#pragma unroll
                        for (int k = 1; k < 4; ++k) v[k] += v[k - 1];
                        float inc = v[3];
#pragma unroll
                        for (int o = 1; o < 64; o <<= 1) { const float t = __shfl_up(inc, o); if (lane >= o) inc += t; }
                        LAS float* wt = (LAS float*)(lds + DK_OFF + 16384);
                        if (lane == 63) wt[wave] = inc;
                        __syncthreads();
                        float pre = 0.f;
#pragma unroll
                        for (int w = 0; w < 8; ++w) pre += (w < wave) ? wt[w] : 0.f;
                        const float ex = pre + inc - v[3];
                        if (4 * tid < KVS) *(f32x4*)(DKS + (size_t)u * KVS + 4 * tid) = (f32x4){(v[0] + ex) * LOG2E, (v[1] + ex) * LOG2E, (v[2] + ex) * LOG2E, (v[3] + ex) * LOG2E};
                        asm volatile("s_waitcnt vmcnt(0)" ::: "memory"); __syncthreads();
                    }
                    sample_attn(u >> 4, u & 15, a.in[I_CK], a.in[I_CV], (bf16*)(ws + WS_KVQS) - (size_t)MP * 1024, (bf16*)(ws + WS_KVQS + 2 * MiB) - (size_t)MP * 1024, (bf16*)(ws + WS_KVQS + 4 * MiB) - (size_t)MP * 1024, DKS + (size_t)u * KVS, OB, lds, tid, lane, wave);
                }
            }
            GSYNC();
            for (int rep_ = 0; rep_ < NREP(8); ++rep_) { if (rep_) GSYNC(); PHASE_ENTER();
                pg8::Gemm g{OB, WOT, MT, 1024, 1024, 1024, 0}; pg8::StaticOrder S; S.init(MP, 1024, G, vcu);
                pg8::EpiRes<true, true, false> E{out, out + (size_t)MP * 1024, out, XB, SSQ, nullptr};
                pg8::gemm_phase<pg8::EpiRes<true, true, false>, pg8::StaticOrder, PG_ALIGN, true>(lds, g, S, E);
            }
            GSYNC();
        }
#define SROLE_NB(v) ((v) < 16 ? 0 : (v) < 104 ? 2 : (v) < 120 ? 5 : ((v) < 172 && l == 0) ? 9 : 0)
        {
            PHASE_ENTER();
            pg8::Gemm g{XB, (bf16*)(ws + (l ? WS_WGU1 : WS_WGU0)), MT, 5632, 1024, 1024, 0}; pg8::StaticOrder base; base.init(MP, 5632, G, vcu);
            pg8::EpiGU E{SSQ, ACT};
            pg8::RangeOrder S{base, 0, SROLE_NB(vcu), -1, 0};
            pg8::gemm_phase<pg8::EpiGU, pg8::RangeOrder, PG_ALIGN, true>(lds, g, S, E);
        }
        if (vcu < 120 || (vcu < 172 && l == 0)) {
            PHASE_ENTER();
            int role, sidx;
            if (vcu < 16) { role = 1; sidx = vcu; } else if (vcu < 104) { role = 2; sidx = vcu - 16; } else if (vcu < 120) { role = 3; sidx = vcu - 104; } else { role = 4; sidx = vcu - 120; }
            unsigned* cnt = (unsigned*)(ws + WS_CTL + 32768) + l * 256;
            if (role > 1) {
                if (tid == 0) { const unsigned need = role == 3 ? 88u : 16u; unsigned sp = 0;
                    while (__hip_atomic_load(cnt + 64 * (role - 2), __ATOMIC_RELAXED, __HIP_MEMORY_SCOPE_AGENT) < need && ++sp < (1u << 22)) __builtin_amdgcn_s_sleep(2);
                    __builtin_amdgcn_fence(__ATOMIC_ACQUIRE, "agent"); asm volatile("s_waitcnt vmcnt(0)" ::: "memory"); }
                __syncthreads();
            }
            if (role == 1) {
                pg8::OneUnit S1{256 + (sidx >> 2), sidx & 3};
                if (l) { pg8::Gemm g2{OB, WOT, MT, 1024, 1024, 1024, 0}; pg8::EpiRes<true, true, false> E3{xp, xs, out, XB, SSQ, nullptr}; pg8::gemm_phase<pg8::EpiRes<true, true, false>, pg8::OneUnit, PG_ALIGN, true>(lds, g2, S1, E3); }
                else { pg8::Gemm g2{PB, WPOOL, MT, 1024, 256, 1024, 256}; pg8::EpiRes<true, false, false> E2{xp, xs, out, XB, SSQ, nullptr}; pg8::gemm_phase<pg8::EpiRes<true, false, false>, pg8::OneUnit, PG_ALIGN, true>(lds, g2, S1, E2); }
            } else if (role == 2) {
                pg8::Gemm g2{XB, (bf16*)(ws + (l ? WS_WGU1 : WS_WGU0)), MT, 5632, 1024, 1024, 0}; pg8::EpiGU E2{SSQ, ACT};
                pg8::OneUnit S1{256 + sidx / 22, sidx % 22};
                pg8::gemm_phase<pg8::EpiGU, pg8::OneUnit, PG_ALIGN, true>(lds, g2, S1, E2);
            } else if (role == 3) {
                pg8::Gemm g2{ACT, (bf16*)(ws + (l ? WS_WDN1 : WS_WDN0)), MT, 1024, 2816, 2816, 0}; pg8::OneUnit S1{256 + (sidx >> 2), sidx & 3};
                pg8::EpiRes<true, true, true> E2{out, out + (size_t)MP * 1024, out, XB, SSQ, nullptr};
                pg8::gemm_phase<pg8::EpiRes<true, true, true>, pg8::OneUnit, PG_ALIGN, true>(lds, g2, S1, E2);
            } else {
                pg8::Gemm g2{XB, WKVQ, MT, 3328, 1024, 1024, 0}; pg8::OneUnit S1{256 + sidx / 13, sidx % 13};
                pg8::EpiKVQ E2{SSQ, (const float*)(ws + WS_GN), a.in[I_BF], out, (bf16*)(ws + WS_KVQS) - (size_t)MP * 1024, (size_t)(2 * MiB / 2)};
                pg8::gemm_phase<pg8::EpiKVQ, pg8::OneUnit, PG_ALIGN, true>(lds, g2, S1, E2);
            }
            asm volatile("s_waitcnt vmcnt(0)" ::: "memory"); __syncthreads();
            if (tid == 0) { __builtin_amdgcn_fence(__ATOMIC_RELEASE, "agent"); asm volatile("s_waitcnt vmcnt(0)" ::: "memory");
                __hip_atomic_fetch_add(cnt + 64 * (role - 1), 1u, __ATOMIC_RELAXED, __HIP_MEMORY_SCOPE_AGENT); }
        }
        {
            PHASE_ENTER();
            pg8::Gemm g{XB, (bf16*)(ws + (l ? WS_WGU1 : WS_WGU0)), MT, 5632, 1024, 1024, 0}; pg8::StaticOrder base; base.init(MP, 5632, G, vcu);
            pg8::EpiGU E{SSQ, ACT};
            const bool dns = vcu >= 104 && vcu < 120, tk = vcu >= 172 && vcu < 188;
            pg8::RangeOrder S{base, SROLE_NB(vcu), dns ? 21 : 22, tk ? vcu - 172 + 104 : -1, 21};
            pg8::gemm_phase<pg8::EpiGU, pg8::RangeOrder, PG_ALIGN, true>(lds, g, S, E);
        }
#undef SROLE_NB
        GSYNC();
        for (int rep_ = 0; rep_ < NREP(4); ++rep_) { if (rep_) GSYNC(); PHASE_ENTER();
            pg8::Gemm g{ACT, (bf16*)(ws + (l ? WS_WDN1 : WS_WDN0)), MT, 1024, 2816, 2816, 0}; pg8::StaticOrder S; S.init(MP, 1024, G, vcu);
            if (l == 0) { pg8::EpiRes<true, true, false> E{out, out + (size_t)MP * 1024, out, XB, SSQ, nullptr}; pg8::gemm_phase<pg8::EpiRes<true, true, false>, pg8::StaticOrder, PG_ALIGN, true>(lds, g, S, E); }
            else { pg8::EpiRes<false, true, true> E{out, out + (size_t)MP * 1024, out, XB, nullptr, nullptr}; pg8::gemm_phase<pg8::EpiRes<false, true, true>, pg8::StaticOrder, PG_ALIGN, true>(lds, g, S, E); }
        }
        if (l == 0) GSYNC();
    }
}

extern "C" void kernel_launch(void* const* d_in, const int* in_sizes, int n_in, void* d_out, int out_size, void* d_ws, size_t ws_size, hipStream_t stream) {
    static int grid = 0;
    if (grid == 0) {
        if (n_in != 22 || (size_t)out_size != pg8::O_END || ws_size < WS_END) { fprintf(stderr, "kernel_launch: unexpected shapes: n_in %d out %d ws %zu (need %zu)\n", n_in, out_size, ws_size, (size_t)WS_END); grid = -1; return; }
        int dev = 0, cus = 0, per_cu = 0;
        (void)hipGetDevice(&dev); (void)hipDeviceGetAttribute(&cus, hipDeviceAttributeMultiprocessorCount, dev);
        if (hipFuncSetAttribute((const void*)mega, hipFuncAttributeMaxDynamicSharedMemorySize, LDS_BYTES) != hipSuccess) fprintf(stderr, "kernel_launch: hipFuncSetAttribute failed\n");
        if (hipOccupancyMaxActiveBlocksPerMultiprocessor(&per_cu, (const void*)mega, 512, LDS_BYTES) != hipSuccess || per_cu < 1) { fprintf(stderr, "kernel_launch: occupancy query says %d\n", per_cu); per_cu = 1; }
        (void)hipGetLastError();
        if (cus <= 0) cus = 256;
        grid = cus;
    }
    if (grid < 0) return;
    if (hipMemsetAsync((char*)d_ws + WS_CTL, 0, 65536, stream) != hipSuccess) { fprintf(stderr, "kernel_launch: memset failed\n"); return; }
    Args a{};
    for (int i = 0; i < 22; ++i) a.in[i] = (const float*)d_in[i];
    a.out = (float*)d_out; a.ws = (unsigned char*)d_ws;
    void* args[] = {&a};
    const hipError_t e = hipLaunchCooperativeKernel((const void*)mega, dim3(grid), dim3(512), args, LDS_BYTES, stream);
    if (e != hipSuccess) fprintf(stderr, "kernel_launch: cooperative launch failed: %s (grid %d)\n", hipGetErrorString(e), grid);
}
```

```cpp
#include <hip/hip_runtime.h>
#include <hip/hip_cooperative_groups.h>
#include <cstdio>
#include <cstdint>
namespace cg = cooperative_groups;
namespace pg8 {
#define PG8_LAS __attribute__((address_space(3)))
typedef unsigned short bf16_t;
typedef short bf16x8 __attribute__((ext_vector_type(8)));
typedef float f32x4 __attribute__((ext_vector_type(4)));
typedef unsigned u32x4 __attribute__((ext_vector_type(4)));
constexpr int BM = 256, BK = 64, HALF = 128, HTB = HALF * BK * 2  , STAGE_BYTES = 8 * HTB, NXCD = 8, WGM = 8;

__host__ __device__ __forceinline__ int lds_byte(int r, int c) { const int st = (r >> 4) * 2 + (c >> 5), rr = r & 15, cc = c & 31, ob = rr * 64 + cc * 2; return st * 1024 + (ob ^ (((ob >> 9) & 1) << 5)); }
__host__ __device__ __forceinline__ void stage_rc(int b, int& R, int& C) { const int st = b / 1024, sb = b % 1024, swz = sb ^ (((sb >> 9) & 1) << 5); R = (st >> 1) * 16 + swz / 64; C = (st & 1) * 32 + (swz % 64) / 2; }
__host__ __device__ __forceinline__ int perm32(int rho) { const int n = rho >> 4, i = rho & 15; return 8 * (i >> 2) + 4 * n + (i & 3); }

struct Unit { int pm, pn; };
struct Gemm { const bf16_t* A; const bf16_t* Bt; int M, N, K; int lda; int acol_pn; };

struct StaticOrder {
    int nM, nN, nwg, G, c;
    __host__ __device__ void init(int M, int N, int G_, int c_) { nM = M / BM; nN = N / BM; nwg = nM * nN; G = G_; c = c_; }
    __host__ __device__ bool next(int i, Unit& u) const {
        const long L = (long)i * G + c; if (L >= nwg) return false;
        int wgid = (int)L; { const int q = nwg / NXCD, r = nwg % NXCD, xcd = wgid % NXCD, off = wgid / NXCD; wgid = (xcd < r ? xcd * (q + 1) : r * (q + 1) + (xcd - r) * q) + off; }
        const int nig = WGM * nN, gid = wgid / nig, fm = gid * WGM, gsz = (nM - fm) < WGM ? (nM - fm) : WGM;
        u.pm = fm + ((wgid % nig) % gsz); u.pn = (wgid % nig) / gsz; return true;
    }
    __device__ __forceinline__ void a_ready(const Unit&) const {}
    __device__ __forceinline__ void done(const Unit&) const {}
};
__device__ __forceinline__ unsigned cvt_pk_bf16(float lo, float hi) { unsigned r; asm volatile("v_cvt_pk_bf16_f32 %0, %1, %2" : "=v"(r) : "v"(lo), "v"(hi)); return r; }
typedef float f32x2 __attribute__((ext_vector_type(2)));
typedef unsigned u32x2 __attribute__((ext_vector_type(2)));
typedef float f32x2e __attribute__((ext_vector_type(2))); typedef __bf16 bf16x2e __attribute__((ext_vector_type(2)));
__device__ __forceinline__ unsigned pkbf(float lo, float hi) { f32x2e v = {lo, hi}; bf16x2e b = __builtin_convertvector(v, bf16x2e); return __builtin_bit_cast(unsigned, b); }
__device__ __forceinline__ float xsum16(float s) { const unsigned b = __float_as_uint(s); auto r = __builtin_amdgcn_permlane16_swap(b, b, false, false); return __uint_as_float(r[0]) + __uint_as_float(r[1]); }
__device__ __forceinline__ float xsum32(float s) { const unsigned b = __float_as_uint(s); auto r = __builtin_amdgcn_permlane32_swap(b, b, false, false); return __uint_as_float(r[0]) + __uint_as_float(r[1]); }
__device__ __forceinline__ void rstd8(const float* ssq, int row00, int fq, float (&rr)[2][4]) {
    f32x4 sv[2][4];
#pragma unroll
    for (int ai = 0; ai < 2; ++ai)
#pragma unroll
        for (int m = 0; m < 4; ++m) sv[ai][m] = *(const f32x4*)(ssq + (size_t)(row00 + ai * HALF + m * 16) * 16 + fq * 4);
    float s[2][4];
#pragma unroll
    for (int ai = 0; ai < 2; ++ai)
#pragma unroll
        for (int m = 0; m < 4; ++m) s[ai][m] = (sv[ai][m][0] + sv[ai][m][1]) + (sv[ai][m][2] + sv[ai][m][3]);
#pragma unroll
    for (int ai = 0; ai < 2; ++ai)
#pragma unroll
        for (int m = 0; m < 4; ++m) s[ai][m] = xsum16(s[ai][m]);
#pragma unroll
    for (int ai = 0; ai < 2; ++ai)
#pragma unroll
        for (int m = 0; m < 4; ++m) s[ai][m] = xsum32(s[ai][m]);
#pragma unroll
    for (int ai = 0; ai < 2; ++ai)
#pragma unroll
        for (int m = 0; m < 4; ++m) rr[ai][m] = __builtin_amdgcn_rsqf(s[ai][m] * (1.0f / 1024.0f) + 1e-6f);
}
constexpr int EMP = 65536;
constexpr size_t O_YP = 0, O_YS = 67108864, O_PSP = O_YS + 1048576, O_PSS = O_PSP + 245760, O_KP = O_PSS + 245760, O_VP = O_KP + 67108864,
                 O_LP = O_VP + 67108864, O_KS = O_LP + 1048576, O_VS = O_KS + 1048576, O_LS = O_VS + 1048576, O_END = O_LS + 16384;
__device__ __forceinline__ float rstd_from_ssq(const float* ssq, int row, int fq) {
    const f32x4 v = *(const f32x4*)(ssq + (size_t)row * 16 + fq * 4);
    float s = (v[0] + v[1]) + (v[2] + v[3]);
    s += __shfl_xor(s, 16); s += __shfl_xor(s, 32);
    return __builtin_amdgcn_rsqf(s * (1.0f / 1024.0f) + 1e-6f);
}
template <bool HAS_XB, bool SRC_BF16, bool WR_F32> struct EpiRes {
    static constexpr bool PERM = false, AFTER_DRAIN = false;
    const float* srcP; const float* srcS; float* dst; bf16_t* xb; float* ssq; const float* cscale;
    __device__ __forceinline__ void operator()(const f32x4 (&acc)[2][2][4][2], const Unit& u, int wr, int wc, int fr_in, int fq_in) const {
        int ln_ = threadIdx.x & 63; asm volatile("" : "+v"(ln_)); const int fr = ln_ & 15, fq = ln_ >> 4; (void)fr_in; (void)fq_in;
        const int col0 = u.pn * BM + wc * 32 + 4 * fq;
#pragma unroll
        for (int ai = 0; ai < 2; ++ai) {
            f32x4 res[4][2][2];
#pragma unroll
            for (int m = 0; m < 4; ++m) {
                const int row = u.pm * BM + ai * HALF + wr * 64 + m * 16 + fr;
#pragma unroll
                for (int bj = 0; bj < 2; ++bj)
#pragma unroll
                    for (int n = 0; n < 2; ++n) {
                        if (SRC_BF16) { const u32x2 rb = *(const u32x2*)(xb + (size_t)row * 1024 + col0 + bj * HALF + n * 16);
                            res[m][bj][n] = (f32x4){__uint_as_float(rb.x << 16), __uint_as_float(rb.x & 0xffff0000u), __uint_as_float(rb.y << 16), __uint_as_float(rb.y & 0xffff0000u)}; }
                        else { const float* src = (row < EMP ? srcP + (size_t)row * 1024 : srcS + (size_t)(row - EMP) * 1024) + col0; res[m][bj][n] = *(const f32x4*)(src + bj * HALF + n * 16); }
                    }
            }
            float ssv[4];
#pragma unroll
            for (int m = 0; m < 4; ++m) {
                const int row = u.pm * BM + ai * HALF + wr * 64 + m * 16 + fr;
                float* d = dst + (size_t)row * 1024 + col0;
                float ss = 0.f;
#pragma unroll
                for (int bj = 0; bj < 2; ++bj)
#pragma unroll
                    for (int n = 0; n < 2; ++n) {
                        const f32x4 x = res[m][bj][n] + acc[ai][bj][m][n];
                        if (WR_F32) *(f32x4*)(d + bj * HALF + n * 16) = x;
                        if (HAS_XB) { u32x2 w; w.x = pkbf(x[0], x[1]); w.y = pkbf(x[2], x[3]); *(u32x2*)(xb + (size_t)row * 1024 + col0 + bj * HALF + n * 16) = w;
                            ss += (x[0] * x[0] + x[1] * x[1]) + (x[2] * x[2] + x[3] * x[3]); }
                    }
                ssv[m] = ss;
            }
            if (HAS_XB) {
#pragma unroll
                for (int m = 0; m < 4; ++m) ssv[m] = xsum16(ssv[m]);
#pragma unroll
                for (int m = 0; m < 4; ++m) ssv[m] = xsum32(ssv[m]);
#pragma unroll
                for (int m = 0; m < 4; ++m) if (fq == 0) ssq[(size_t)(u.pm * BM + ai * HALF + wr * 64 + m * 16 + fr) * 16 + u.pn * 4 + wc] = ssv[m];
            }
        }
    }
};
struct EpiGU {
    static constexpr bool PERM = true, AFTER_DRAIN = false;
    const float* ssq; bf16_t* act;
    __device__ __forceinline__ void operator()(const f32x4 (&acc)[2][2][4][2], const Unit& u, int wr, int wc, int fr_in, int fq_in) const {
        int ln_ = threadIdx.x & 63; asm volatile("" : "+v"(ln_)); const int fr = ln_ & 15, fq = ln_ >> 4; (void)fr_in; (void)fq_in;
        const int col = u.pn * 128 + wc * 32 + 8 * fq;
        float rr[2][4]; rstd8(ssq, u.pm * BM + wr * 64 + fr, fq, rr);
#pragma unroll
        for (int ai = 0; ai < 2; ++ai)
#pragma unroll
            for (int m = 0; m < 4; ++m) {
                const int row = u.pm * BM + ai * HALF + wr * 64 + m * 16 + fr;
                const float r = rr[ai][m];
                u32x4 w;
#pragma unroll
                for (int n = 0; n < 2; ++n) {
                    const f32x4 g = acc[ai][0][m][n] * r, up = acc[ai][1][m][n] * r; float hh[4];
#pragma unroll
                    for (int e = 0; e < 4; ++e) hh[e] = g[e] * __builtin_amdgcn_rcpf(1.0f + __builtin_amdgcn_exp2f(-1.4426950408889634f * g[e])) * up[e];
                    w[2 * n] = pkbf(hh[0], hh[1]); w[2 * n + 1] = pkbf(hh[2], hh[3]);
                }
                *(u32x4*)(act + (size_t)row * 2816 + col) = w;
            }
    }
};
struct EpiKVQ {
    static constexpr bool PERM = true, AFTER_DRAIN = false;
    const float* ssq; const float* gn; const float* bfp; float* out; bf16_t* kvq; size_t kvq_stride;
    __device__ __forceinline__ void operator()(const f32x4 (&acc)[2][2][4][2], const Unit& u, int wr, int wc, int fr_in, int fq_in) const {
        int ln_ = threadIdx.x & 63; asm volatile("" : "+v"(ln_)); const int fr = ln_ & 15, fq = ln_ >> 4; (void)fr_in; (void)fq_in;
        const int t = u.pn >> 2, j = u.pn & 3;
        if (t == 3) {
            if (wc != 0) return;
            const int h0 = 8 * (fq & 1);
            const f32x4 b0 = *(const f32x4*)(bfp + h0), b1 = *(const f32x4*)(bfp + h0 + 4);
            float rrf[2][4]; rstd8(ssq, u.pm * BM + wr * 64 + fr, fq, rrf);
#pragma unroll
            for (int ai = 0; ai < 2; ++ai)
#pragma unroll
                for (int m = 0; m < 4; ++m) {
                    const int row = u.pm * BM + ai * HALF + wr * 64 + m * 16 + fr;
                    const float r = rrf[ai][m];
                    if (fq < 2) {
                        float* o = (row < EMP ? out + O_LP + (size_t)row * 16 : out + O_LS + (size_t)(row - EMP) * 16) + h0;
#pragma unroll
                        for (int n = 0; n < 2; ++n) { const f32x4 z = acc[ai][0][m][n] * r + (n == 0 ? b0 : b1); f32x4 lf;
#pragma unroll
                            for (int e = 0; e < 4; ++e) lf[e] = fminf(z[e], 0.f) - 0.6931471805599453f * __builtin_amdgcn_logf(1.0f + __builtin_amdgcn_exp2f(-1.4426950408889634f * fabsf(z[e])));
                            *(f32x4*)(o + 4 * n) = lf; }
                    }
                }
            return;
        }
        f32x4 gain[2][2];
#pragma unroll
        for (int bj = 0; bj < 2; ++bj)
#pragma unroll
            for (int n = 0; n < 2; ++n) gain[bj][n] = *(const f32x4*)(gn + 64 * t + 32 * bj + 8 * fq + 4 * n);
        const int cl = 256 * j + 64 * wc + 8 * fq;
        bf16_t* const ob0 = kvq + (size_t)t * kvq_stride;
        float rr[2][4]; rstd8(ssq, u.pm * BM + wr * 64 + fr, fq, rr);
        float rn8[2][4];
        if (t != 1) {
#pragma unroll
            for (int ai = 0; ai < 2; ++ai)
#pragma unroll
                for (int m = 0; m < 4; ++m) { float ss = 0.f;
#pragma unroll
                    for (int bj = 0; bj < 2; ++bj)
#pragma unroll
                        for (int n = 0; n < 2; ++n) { const f32x4 x = acc[ai][bj][m][n]; ss += (x[0] * x[0] + x[1] * x[1]) + (x[2] * x[2] + x[3] * x[3]); }
                    rn8[ai][m] = ss * rr[ai][m] * rr[ai][m]; }
#pragma unroll
            for (int ai = 0; ai < 2; ++ai)
#pragma unroll
                for (int m = 0; m < 4; ++m) rn8[ai][m] = xsum16(rn8[ai][m]);
#pragma unroll
            for (int ai = 0; ai < 2; ++ai)
#pragma unroll
                for (int m = 0; m < 4; ++m) rn8[ai][m] = __builtin_amdgcn_rsqf(xsum32(rn8[ai][m]) * (1.0f / 64.0f) + 1e-6f);
        }
#pragma unroll
        for (int ai = 0; ai < 2; ++ai)
#pragma unroll
            for (int m = 0; m < 4; ++m) {
                const int row = u.pm * BM + ai * HALF + wr * 64 + m * 16 + fr;
                const float r = rr[ai][m];
                f32x4 v[2][2];
#pragma unroll
                for (int bj = 0; bj < 2; ++bj)
#pragma unroll
                    for (int n = 0; n < 2; ++n) v[bj][n] = acc[ai][bj][m][n] * r;
                if (t != 1) { const float rn = rn8[ai][m];
#pragma unroll
                    for (int bj = 0; bj < 2; ++bj)
#pragma unroll
                        for (int n = 0; n < 2; ++n) v[bj][n] = v[bj][n] * rn * gain[bj][n]; }
                if (t < 2) { float* o = (row < EMP ? out + (t == 0 ? O_KP : O_VP) + (size_t)row * 1024 : out + (t == 0 ? O_KS : O_VS) + (size_t)(row - EMP) * 1024) + cl;
#pragma unroll
                    for (int bj = 0; bj < 2; ++bj) { *(f32x4*)(o + 32 * bj) = v[bj][0]; *(f32x4*)(o + 32 * bj + 4) = v[bj][1]; } }
                bf16_t* ob = ob0 + (size_t)row * 1024 + cl;
#pragma unroll
                for (int bj = 0; bj < 2; ++bj) { u32x4 w; w.x = pkbf(v[bj][0][0], v[bj][0][1]); w.y = pkbf(v[bj][0][2], v[bj][0][3]); w.z = pkbf(v[bj][1][0], v[bj][1][1]); w.w = pkbf(v[bj][1][2], v[bj][1][3]);
                    *(u32x4*)(ob + 32 * bj) = w; }
            }
    }
};

struct RangeOrder {
    StaticOrder b; int i0, i1; int xc, xi;
    __device__ __forceinline__ bool next(int i, Unit& u) const {
        if (i0 + i < i1) return b.next(i0 + i, u);
        if (xc >= 0 && i0 + i == i1) { StaticOrder b2 = b; b2.c = xc; return b2.next(xi, u); }
        return false; }
    __device__ __forceinline__ void a_ready(const Unit&) const {}
    __device__ __forceinline__ void done(const Unit&) const {}
};
struct OneUnit {
    int pm, pn;
    __device__ __forceinline__ bool next(int i, Unit& u) const { if (i != 0) return false; u.pm = pm; u.pn = pn; return true; }
    __device__ __forceinline__ void a_ready(const Unit&) const {}
    __device__ __forceinline__ void done(const Unit&) const {}
};
template <class Epi, class Sched, bool ALIGN_EPI = false, bool SP2 = false>
__device__ __forceinline__ void gemm_phase(PG8_LAS unsigned char* lds, const Gemm g, const Sched& S, const Epi& E) {
    int tid_o = threadIdx.x; asm volatile("" : "+v"(tid_o)); const int tid = tid_o, wid = __builtin_amdgcn_readfirstlane(tid >> 6), lane = tid & 63, wr = wid >> 2, wc = wid & 3, fr = lane & 15, fq = lane >> 4;
    const int K = g.K, nt = K / BK;
    unsigned voffA[2], voffB[2];
#pragma unroll
    for (int i = 0; i < 2; ++i) { int R, C; stage_rc(tid * 16 + i * 8192, R, C); const int Rb = Epi::PERM ? ((R & ~31) + perm32(R & 31)) : R;
        voffA[i] = (unsigned)(R * g.lda + C) * 2u; voffB[i] = (unsigned)(Rb * K + C) * 2u; }
    const size_t kstep = (size_t)(BK * 2);
    const size_t hstepB = (size_t)HALF * K * 2, hstepA = (size_t)HALF * g.lda * 2;
    const size_t tstepB = 2 * hstepB, tstepA = 2 * hstepA;
    const unsigned ldsw = (unsigned)wid * 1024u;
    const int aoff = lds_byte(wr * 64 + fr, fq * 8), boff = lds_byte(wc * 32 + fr, fq * 8);
#define PG8_SA(b, h) (((b) * 2 + (h)) * HTB)
#define PG8_SB(b, h) ((4 + (b) * 2 + (h)) * HTB)
#define PG8_STAGE(bufoff, gbase, voff) do { _Pragma("unroll") for (int _i = 0; _i < 2; ++_i) \
        __builtin_amdgcn_global_load_lds((const unsigned*)((const char*)(gbase) + (voff)[_i]), (PG8_LAS unsigned*)(lds + (bufoff) + ldsw + _i * 8192), 16, 0, 0); } while (0)
#define PG8_LDA(dst, b, h) do { _Pragma("unroll") for (int m = 0; m < 4; ++m) _Pragma("unroll") for (int k = 0; k < 2; ++k) dst[m][k] = *(const PG8_LAS bf16x8*)(lds + PG8_SA(b, h) + aoff + m * 2048 + k * 1024); } while (0)
#define PG8_LDB(dst, b, h) do { _Pragma("unroll") for (int n = 0; n < 2; ++n) _Pragma("unroll") for (int k = 0; k < 2; ++k) dst[n][k] = *(const PG8_LAS bf16x8*)(lds + PG8_SB(b, h) + boff + n * 2048 + k * 1024); } while (0)
#define PG8_MMA(ai, bj, At, Bt) do { __builtin_amdgcn_s_setprio(1); _Pragma("unroll") for (int m = 0; m < 4; ++m) _Pragma("unroll") for (int n = 0; n < 2; ++n) _Pragma("unroll") for (int k = 0; k < 2; ++k) \
        acc[ai][bj][m][n] = __builtin_amdgcn_mfma_f32_16x16x32_bf16(Bt[n][k], At[m][k], acc[ai][bj][m][n], 0, 0, 0); __builtin_amdgcn_s_setprio(0); } while (0)
#define PG8_WAIT_V(n) asm volatile("s_waitcnt vmcnt(" #n ")" ::: "memory")
#define PG8_WAIT_L(n) asm volatile("s_waitcnt lgkmcnt(" #n ")" ::: "memory")
#define PG8_BAR __builtin_amdgcn_s_barrier()
#define PG8_SCHED __builtin_amdgcn_sched_barrier(0)
    Unit cur, nxt; int ui = 0;
    if (!S.next(0, cur)) return;
    f32x4 acc[2][2][4][2];
#pragma unroll
    for (int a = 0; a < 2; ++a)
#pragma unroll
        for (int b = 0; b < 2; ++b)
#pragma unroll
            for (int m = 0; m < 4; ++m)
#pragma unroll
                for (int n = 0; n < 2; ++n) acc[a][b][m][n] = (f32x4){0.f, 0.f, 0.f, 0.f};
    bf16x8 At[4][2], B0[2][2], B1[2][2];
    const char* cA = (const char*)g.A + (size_t)cur.pm * tstepA + (size_t)cur.pn * g.acol_pn * 2; const char* cB = (const char*)g.Bt + (size_t)cur.pn * tstepB;
    S.a_ready(cur);
    if constexpr (SP2) {
        PG8_STAGE(PG8_SB(0, 0), cB, voffB); PG8_STAGE(PG8_SB(0, 1), cB + hstepB, voffB); PG8_STAGE(PG8_SA(0, 0), cA, voffA); PG8_STAGE(PG8_SA(0, 1), cA + hstepA, voffA);
        if (wr == 1) PG8_BAR;
        PG8_WAIT_V(2); PG8_BAR;
        PG8_STAGE(PG8_SB(1, 0), cB + kstep, voffB); PG8_STAGE(PG8_SA(1, 0), cA + kstep, voffA); PG8_STAGE(PG8_SB(1, 1), cB + hstepB + kstep, voffB);
        PG8_WAIT_V(6); PG8_BAR;
    } else {
        PG8_STAGE(PG8_SB(0, 0), cB, voffB); PG8_STAGE(PG8_SA(0, 0), cA, voffA); PG8_STAGE(PG8_SB(0, 1), cB + hstepB, voffB); PG8_STAGE(PG8_SA(0, 1), cA + hstepA, voffA);
        if (wr == 1) PG8_BAR;
        PG8_WAIT_V(4); PG8_BAR;
        PG8_STAGE(PG8_SB(1, 0), cB + kstep, voffB); PG8_STAGE(PG8_SA(1, 0), cA + kstep, voffA); PG8_STAGE(PG8_SB(1, 1), cB + hstepB + kstep, voffB);
        PG8_WAIT_V(6); PG8_BAR;
    }
    for (;;) {
        const bool has_next = S.next(ui + 1, nxt);
        const char* nA = has_next ? (const char*)g.A + (size_t)nxt.pm * tstepA + (size_t)nxt.pn * g.acol_pn * 2 : cA; const char* nB = has_next ? (const char*)g.Bt + (size_t)nxt.pn * tstepB : cB;
        for (int t = 0; t < nt; t += 2) {
            const bool last = (t == nt - 2);
            const char* a1 = cA + (size_t)(t + 1) * kstep;
            const char* a2 = last ? nA : cA + (size_t)(t + 2) * kstep; const char* b2 = last ? nB : cB + (size_t)(t + 2) * kstep;
            const char* a3 = a2 + kstep; const char* b3 = b2 + kstep;
            if (last && has_next) S.a_ready(nxt);
            if constexpr (SP2) {
            PG8_LDB(B0, 0, 0); PG8_LDB(B1, 0, 1); PG8_SCHED; PG8_LDA(At, 0, 0); PG8_STAGE(PG8_SA(1, 1), a1 + hstepA, voffA);
            PG8_WAIT_V(8); PG8_WAIT_L(0); PG8_BAR; PG8_MMA(0, 0, At, B0); PG8_MMA(0, 1, At, B1); PG8_BAR; PG8_SCHED;
            PG8_LDA(At, 0, 1); PG8_STAGE(PG8_SB(0, 0), b2, voffB); PG8_STAGE(PG8_SB(0, 1), b2 + hstepB, voffB); PG8_STAGE(PG8_SA(0, 0), a2, voffA);
            PG8_WAIT_V(8); PG8_WAIT_L(0); PG8_BAR; PG8_MMA(1, 0, At, B0); PG8_MMA(1, 1, At, B1); PG8_BAR; PG8_SCHED;
            PG8_LDB(B0, 1, 0); PG8_LDB(B1, 1, 1); PG8_SCHED; PG8_LDA(At, 1, 0); PG8_STAGE(PG8_SA(0, 1), a2 + hstepA, voffA);
            PG8_WAIT_V(8); PG8_WAIT_L(0); PG8_BAR; PG8_MMA(0, 0, At, B0); PG8_MMA(0, 1, At, B1); PG8_BAR; PG8_SCHED;
            PG8_LDA(At, 1, 1); PG8_STAGE(PG8_SB(1, 0), b3, voffB); PG8_STAGE(PG8_SB(1, 1), b3 + hstepB, voffB); PG8_STAGE(PG8_SA(1, 0), a3, voffA);
            PG8_WAIT_V(8); PG8_WAIT_L(0); PG8_BAR; PG8_MMA(1, 0, At, B0); PG8_MMA(1, 1, At, B1); PG8_BAR; PG8_SCHED;
            } else {
            PG8_LDB(B0, 0, 0); PG8_SCHED; PG8_LDA(At, 0, 0); PG8_STAGE(PG8_SA(1, 1), a1 + hstepA, voffA);
            PG8_WAIT_L(8); PG8_BAR; PG8_WAIT_L(0); PG8_MMA(0, 0, At, B0); PG8_BAR; PG8_SCHED;
            PG8_LDB(B1, 0, 1); PG8_STAGE(PG8_SB(0, 0), b2, voffB);
            PG8_BAR; PG8_WAIT_L(0); PG8_MMA(0, 1, At, B1); PG8_BAR;
            PG8_LDA(At, 0, 1); PG8_STAGE(PG8_SA(0, 0), a2, voffA);
            PG8_BAR; PG8_WAIT_L(0); PG8_MMA(1, 0, At, B0); PG8_BAR; PG8_SCHED;
            PG8_STAGE(PG8_SB(0, 1), b2 + hstepB, voffB);
            PG8_WAIT_V(6); PG8_BAR; PG8_MMA(1, 1, At, B1); PG8_BAR;
            PG8_LDB(B0, 1, 0); PG8_SCHED; PG8_LDA(At, 1, 0); PG8_STAGE(PG8_SA(0, 1), a2 + hstepA, voffA);
            PG8_WAIT_L(8); PG8_BAR; PG8_WAIT_L(0); PG8_MMA(0, 0, At, B0); PG8_BAR; PG8_SCHED;
            PG8_LDB(B1, 1, 1); PG8_STAGE(PG8_SB(1, 0), b3, voffB);
            PG8_BAR; PG8_WAIT_L(0); PG8_MMA(0, 1, At, B1); PG8_BAR;
            PG8_LDA(At, 1, 1); PG8_STAGE(PG8_SA(1, 0), a3, voffA);
            PG8_BAR; PG8_WAIT_L(0); PG8_MMA(1, 0, At, B0); PG8_BAR; PG8_SCHED;
            PG8_STAGE(PG8_SB(1, 1), b3 + hstepB, voffB);
            PG8_WAIT_V(6); PG8_BAR; PG8_MMA(1, 1, At, B1); PG8_BAR;
            }
        }
        if constexpr (ALIGN_EPI) { if (wr == 0) PG8_BAR; }
        if constexpr (!Epi::AFTER_DRAIN) { E(acc, cur, wr, wc, fr, fq); S.done(cur); }
        if (!has_next) break;
#pragma unroll
        for (int a = 0; a < 2; ++a)
#pragma unroll
            for (int b = 0; b < 2; ++b)
#pragma unroll
                for (int m = 0; m < 4; ++m)
#pragma unroll
                    for (int n = 0; n < 2; ++n) acc[a][b][m][n] = (f32x4){0.f, 0.f, 0.f, 0.f};
        cur = nxt; cA = nA; cB = nB; ++ui;
        if constexpr (ALIGN_EPI) { if (wr == 1) PG8_BAR; }
    }
    PG8_WAIT_V(0);
    if constexpr (!ALIGN_EPI) { if (wr == 0) PG8_BAR; }
    PG8_BAR;
    if constexpr (Epi::AFTER_DRAIN) { E.fused(acc, cur, wr, wc, fr, fq, lds, wid, lane); S.done(cur); }
#undef PG8_SA
#undef PG8_SB
#undef PG8_STAGE
#undef PG8_LDA
#undef PG8_LDB
#undef PG8_MMA
#undef PG8_WAIT_V
#undef PG8_WAIT_L
#undef PG8_BAR
#undef PG8_SCHED
}
}

#include <hip/hip_bf16.h>
#include <cmath>
namespace attn_body {
using bf16=__hip_bfloat16;
using bf16x8=__attribute__((ext_vector_type(8)))short;
using s16x4=__attribute__((ext_vector_type(4)))short;
using f32x16=__attribute__((ext_vector_type(16)))float;
using u32x4=__attribute__((ext_vector_type(4)))unsigned;
using f32x4a=__attribute__((ext_vector_type(4)))float;
typedef __attribute__((address_space(3))) const float* lds_cfptr;
typedef __attribute__((address_space(3))) const f32x4a* lds_cf4ptr;
constexpr int BATCH=16,NHEAD=16,SEQ=4096,D=64,DM=NHEAD*D;
constexpr int NW=8,QBLK=32,QB=QBLK*NW,KVBLK=64,NQB=SEQ/QB;
constexpr int ATTN_PITCH=DM, ATTN_UNIT_ROWS=QB;
__device__ __forceinline__ int crow(int r,int hi){return (r&3)+8*(r>>2)+4*hi;}
#define SBAR() __builtin_amdgcn_sched_barrier(0)
__device__ __forceinline__ void cmask(f32x16&p0,f32x16&p1,int jb,int qrel,int hi){
  const float NEG=-INFINITY; int kb=64*jb+4*hi;
  #pragma unroll
  for(int r=0;r<16;++r){int kv=kb+(r&3)+8*(r>>2); if(kv>qrel)p0[r]=NEG; if(kv+32>qrel)p1[r]=NEG;}
}

constexpr int NSLOT=3, SLOTB=8192;
constexpr int LDS_K=0, LDS_V=NSLOT*SLOTB, LDS_WS=2*NSLOT*SLOTB, LDS_OST=LDS_WS+NW*64*4, LDS_BYTES=LDS_OST+NW*4096;
constexpr float C2=0.125f*1.4426950408889634f;
__device__ __forceinline__ void glds16(const void*gsrc,unsigned lds_dst){unsigned keep;
  asm volatile("s_mov_b32 %0, m0\n\ts_mov_b32 m0, %2\n\ts_nop 0\n\tglobal_load_lds_dwordx4 %1, off\n\ts_mov_b32 m0, %0":"=&s"(keep):"v"(gsrc),"s"(lds_dst):"memory");}
__device__ __forceinline__ float max3f(float a,float b,float c){float r;asm("v_max3_f32 %0, %1, %2, %3":"=v"(r):"v"(a),"v"(b),"v"(c));return r;}
__device__ __forceinline__ float max2f(float a,float b){float r;asm("v_max_f32_e32 %0, %1, %2":"=v"(r):"v"(a),"v"(b));return r;}
__device__ __forceinline__ float fadd_s(float a,float b){float r;asm("v_add_f32_e32 %0, %1, %2":"=v"(r):"v"(a),"v"(b));return r;}
__device__ __forceinline__ float fsub_s(float a,float b){float r;asm("v_sub_f32_e32 %0, %1, %2":"=v"(r):"v"(a),"v"(b));return r;}
typedef float f32x2_t __attribute__((ext_vector_type(2))); typedef __bf16 bf16x2_t __attribute__((ext_vector_type(2)));
__device__ __forceinline__ unsigned cvtpk_s(float lo,float hi){f32x2_t v={lo,hi};bf16x2_t b=__builtin_convertvector(v,bf16x2_t);return __builtin_bit_cast(unsigned,b);}
#define WAIT_BAR(N) asm volatile("s_waitcnt vmcnt(" #N ") lgkmcnt(0)\n\ts_barrier":::"memory")

__device__ __forceinline__ void qkt(f32x16&p0,f32x16&p1,const char*Kslot,const bf16x8*qr,int r32,int hi){
  const char*kb=Kslot+hi*1024+r32*16;
  #pragma unroll
  for(int d0=0;d0<4;++d0){
    const bf16x8 b0=*reinterpret_cast<const bf16x8*>(kb+d0*2048);
    const bf16x8 b1=*reinterpret_cast<const bf16x8*>(kb+d0*2048+512);
    {p0=__builtin_amdgcn_mfma_f32_32x32x16_bf16(b0,qr[d0],p0,0,0,0);p1=__builtin_amdgcn_mfma_f32_32x32x16_bf16(b1,qr[d0],p1,0,0,0);}}
}
typedef __attribute__((address_space(3))) const char* lds_cptr;
typedef short v4i16_t __attribute__((ext_vector_type(4)));
__device__ __forceinline__ void kload8(bf16x8*kf,lds_cptr kp){
  kf[0]=*(const __attribute__((address_space(3))) bf16x8*)(kp);      kf[1]=*(const __attribute__((address_space(3))) bf16x8*)(kp+512);
  kf[2]=*(const __attribute__((address_space(3))) bf16x8*)(kp+2048); kf[3]=*(const __attribute__((address_space(3))) bf16x8*)(kp+2560);
  kf[4]=*(const __attribute__((address_space(3))) bf16x8*)(kp+4096); kf[5]=*(const __attribute__((address_space(3))) bf16x8*)(kp+4608);
  kf[6]=*(const __attribute__((address_space(3))) bf16x8*)(kp+6144); kf[7]=*(const __attribute__((address_space(3))) bf16x8*)(kp+6656);
}
__device__ __forceinline__ void kload2(bf16x8*kf,lds_cptr kp,int j){ kf[2*j]=*(const __attribute__((address_space(3))) bf16x8*)(kp+j*2048); kf[2*j+1]=*(const __attribute__((address_space(3))) bf16x8*)(kp+j*2048+512); }
__device__ __forceinline__ s16x4 vtr(lds_cptr p){ return __builtin_bit_cast(s16x4,__builtin_amdgcn_ds_read_tr16_b64_v4i16((__attribute__((address_space(3))) v4i16_t*)p)); }
__device__ __forceinline__ float rowmax(const f32x16&p0,const f32x16&p1){
  float a=max3f(p0[0],p0[1],p1[0]),b=max3f(p0[2],p0[3],p1[1]);a=max3f(a,p1[2],p1[3]);
  #pragma unroll
  for(int r=4;r<16;r+=4){a=max3f(a,p0[r],p0[r+1]);b=max3f(b,p0[r+2],p0[r+3]);a=max3f(a,p1[r],p1[r+1]);b=max3f(b,p1[r+2],p1[r+3]);}
  const float m=max2f(a,b);
  auto rr=__builtin_amdgcn_permlane32_swap(__float_as_uint(m),__float_as_uint(m),false,false);
  return max2f(__uint_as_float(rr[0]),__uint_as_float(rr[1]));
}
__device__ __forceinline__ void pv(f32x16*o,int vb,bf16x8 pa0,bf16x8 pa1,bf16x8 pa2,bf16x8 pa3){
  #pragma unroll
  for(int d0=0;d0<2;++d0){s16x4 lo[4],hi[4];
    #pragma unroll
    for(int ks=0;ks<4;++ks){
      asm volatile("ds_read_b64_tr_b16 %0,%1 offset:%c2":"=&v"(lo[ks]):"v"(vb),"i"(d0*4096+ks*1024):"memory");
      asm volatile("ds_read_b64_tr_b16 %0,%1 offset:%c2":"=&v"(hi[ks]):"v"(vb),"i"(d0*4096+ks*1024+512):"memory");}
    asm volatile("s_waitcnt lgkmcnt(0)":::"memory");SBAR();
    #define PK(k) (bf16x8){lo[k][0],lo[k][1],lo[k][2],lo[k][3],hi[k][0],hi[k][1],hi[k][2],hi[k][3]}
    o[d0]=__builtin_amdgcn_mfma_f32_32x32x16_bf16(pa0,PK(0),o[d0],0,0,0);
    o[d0]=__builtin_amdgcn_mfma_f32_32x32x16_bf16(pa1,PK(1),o[d0],0,0,0);
    o[d0]=__builtin_amdgcn_mfma_f32_32x32x16_bf16(pa2,PK(2),o[d0],0,0,0);
    o[d0]=__builtin_amdgcn_mfma_f32_32x32x16_bf16(pa3,PK(3),o[d0],0,0,0);
    #undef PK
  }
}

#ifndef ATTN_STORE16
#define ATTN_STORE16(p,v) (*(u32x4*)(p)=(v))
#endif
template<int THRL> __device__ __forceinline__ void attn_unit(int b,int h,int qb,const bf16*Q,const bf16*__restrict__ K,const bf16*__restrict__ V,bf16*O,char*shm,lds_cfptr dkl,float lowc,int t0){
  int tid_o=threadIdx.x; asm volatile("":"+v"(tid_o)); const int tid=tid_o,lane=tid&63,r32=lane&31,hi=lane>>5; const int wid=__builtin_amdgcn_readfirstlane(tid>>6);
  const long rowbase=(long)b*SEQ; const int q0=qb*QB;
  const bf16*Qw=Q+(rowbase+q0+wid*QBLK)*DM+h*D;
  const bf16*Kh=K+(rowbase+(long)t0*KVBLK)*DM+h*D,*Vh=V+(rowbase+(long)t0*KVBLK)*DM+h*D;
  const unsigned lds0=(unsigned)(uintptr_t)shm;
  float*wsf=(float*)(shm+LDS_WS)+wid*64;
  const bf16*ksrc=Kh+(long)lane*DM+wid*8;
  const bf16*vsrc=Vh+(long)(16*(wid&3)+(lane>>2))*DM+(wid>>2)*32+(lane&3)*8;
  const unsigned kdst=lds0+LDS_K+wid*1024, vdst=lds0+LDS_V+wid*1024;
  #define DMA_K(t,slot) glds16(ksrc+(long)(t)*KVBLK*DM,(unsigned)__builtin_amdgcn_readfirstlane(kdst+(slot)))
  #define DMA_V(t,slot) glds16(vsrc+(long)(t)*KVBLK*DM,(unsigned)__builtin_amdgcn_readfirstlane(vdst+(slot)))
  const int vb0=(int)(lds0+LDS_V)+((lane>>4)&1)*32+(lane&3)*8+(4*hi+((lane&15)>>2))*64;
  const char*Kbase=shm+LDS_K; bf16x8 kf[8];
  const lds_cptr shm3=(lds_cptr)shm; const lds_cptr kp0=shm3+LDS_K+hi*1024+r32*16; const lds_cptr vp0=shm3+LDS_V+((lane>>4)&1)*32+(lane&3)*8+(4*hi+((lane&15)>>2))*64;
  const int NT=(q0+QB)/KVBLK-t0;
  DMA_K(0,0);DMA_V(0,0);DMA_K(1,SLOTB);
  bf16x8 qr[4];
  #pragma unroll
  for(int d0=0;d0<4;++d0)qr[d0]=*reinterpret_cast<const bf16x8*>(&Qw[(long)r32*DM+d0*16+hi*8]);
  const float dq2=dkl[q0+wid*QBLK+r32]; const lds_cf4ptr dk4=(lds_cf4ptr)dkl+16*t0;
  float mhat=-dq2,l_reg=0.f;f32x16 o[2];o[0]=f32x16{};o[1]=f32x16{};
  #define BINIT(P0,P1,t,NM) do{ const lds_cf4ptr d4_=dk4+16*(t)+hi; _Pragma("unroll") for(int j_=0;j_<4;++j_){ const f32x4a a_=d4_[2*j_], b_=d4_[8+2*j_]; _Pragma("unroll") for(int i_=0;i_<4;++i_){P0[4*j_+i_]=(NM)-a_[i_];P1[4*j_+i_]=(NM)-b_[i_];} } }while(0)
  #define BLOAD(P0,P1,t) do{ const lds_cf4ptr d4_=dk4+16*(t)+hi; _Pragma("unroll") for(int j_=0;j_<4;++j_){ const f32x4a a_=d4_[2*j_], b_=d4_[8+2*j_]; _Pragma("unroll") for(int i_=0;i_<4;++i_){P0[4*j_+i_]=a_[i_];P1[4*j_+i_]=b_[i_];} } }while(0)
  const int qrel=wid*QBLK+r32;
  #define CMASK(P0,P1,t) do{int jb_=(t)-(NT-4); if(jb_>=0)cmask(P0,P1,jb_,qrel,hi);}while(0)
  bool resc=false;
  #define START(P0,P1) do{ const float rm=rowmax(P0,P1); resc=false; \
    { const float dl=rm; mhat=fadd_s(mhat,dl); \
      _Pragma("unroll") for(int r=0;r<16;++r){P0[r]=fsub_s(P0[r],dl);P1[r]=fsub_s(P1[r],dl);} \
      } \
    _Pragma("unroll") for(int r=0;r<16;++r)P0[r]=__builtin_amdgcn_exp2f(P0[r]); }while(0)
  #define RESC() do{ if(resc){ asm volatile("s_waitcnt lgkmcnt(0)":::"memory"); \
      _Pragma("unroll") for(int d_=0;d_<2;++d_) _Pragma("unroll") for(int r=0;r<16;++r)o[d_][r]*=wsf[crow(r,hi)]; } }while(0)
  f32x16 pA0,pA1,pB0,pB1;
  int sl_prev=0,sl_cur=0,sl_next=SLOTB;
  #define ROT() do{sl_prev=sl_cur;sl_cur=sl_next;sl_next=(sl_next==(NSLOT-1)*SLOTB)?0:sl_next+SLOTB;}while(0)
  DMA_K(2,2*SLOTB);
  WAIT_BAR(3);
  BINIT(pA0,pA1,0,dq2);
  qkt(pA0,pA1,Kbase,qr,r32,hi);asm volatile("s_nop 15\n\ts_nop 7":"+v"(pA0),"+v"(pA1));CMASK(pA0,pA1,0);
  START(pA0,pA1);
  { const float nm0_=-mhat; BINIT(pB0,pB1,1,nm0_); }
  _Pragma("unroll") for(int r=0;r<16;++r)pA1[r]=__builtin_amdgcn_exp2f(pA1[r]);
  WAIT_BAR(0);
  DMA_K(3,0);DMA_V(1,SLOTB);
  ROT();
  kload8(kf,kp0+sl_cur);
  WAIT_BAR(2);
  s16x4 vlo[8],vhi[8]; u32x4 pw0,pw1,pw2,pw3;
  #define PKW(P,B) cvtpk_s(P[B],P[B+1])
  #define PAF(k) __builtin_bit_cast(bf16x8,pw##k)
  #define VFR(i) (bf16x8){vlo[i][0],vlo[i][1],vlo[i][2],vlo[i][3],vhi[i][0],vhi[i][1],vhi[i][2],vhi[i][3]}
  #define PIN(x) asm volatile("":"+v"(x))
  #define MX3(a,b,c) __builtin_fmaxf(__builtin_fmaxf((a),(b)),(c))
  #define GAPA(MF,A0,A1,A2,A3,W0,W1,PW) do{ MF; sacc+=A0; sacc+=A1; sacc+=A2; sacc+=A3; PIN(sacc); W0; W1; PIN(PW); SBAR(); }while(0)
  #define EX(v) __builtin_amdgcn_exp2f(v)
  #define GAPB(MF,X,B,G,PI) do{ MF; X[B]=EX(X[B]); X[B+1]=EX(X[B+1]); X[B+2]=EX(X[B+2]); X[B+3]=EX(X[B+3]); PIN(X); if(G){ PI[B]=nmh_-PI[B]; PI[B+1]=nmh_-PI[B+1]; PI[B+2]=nmh_-PI[B+2]; PI[B+3]=nmh_-PI[B+3]; PIN(PI); } SBAR(); }while(0)
  #define VRD(i) do{ vlo[i]=vtr(vp_+(((i)>>2)*4096+((i)&3)*1024)); vhi[i]=vtr(vp_+(((i)>>2)*4096+((i)&3)*1024+512)); }while(0)
  #define KRD(G,j) do{ if(G){ kload2(kf,kp0+sl_next,j); SBAR(); } }while(0)
  #define STEP(C0,C1,P0,P1,t,GK,GV,GL) do{ SBAR(); \
    const lds_cptr vp_=vp0+sl_prev; \
    VRD(0); SBAR(); float sacc=(P0[0]+P0[1]); \
    GAPA(C0=__builtin_amdgcn_mfma_f32_32x32x16_bf16(kf[0],qr[0],C0,0,0,0), P0[2],P0[3],P0[4],P0[5],     pw0[0]=PKW(P0,0), pw0[1]=PKW(P0,2), pw0); \
    VRD(4); SBAR(); GAPA(C1=__builtin_amdgcn_mfma_f32_32x32x16_bf16(kf[1],qr[0],C1,0,0,0), P0[6],P0[7],P0[8],P0[9],     pw0[2]=PKW(P0,4), pw0[3]=PKW(P0,6), pw0); \
    VRD(1); SBAR(); GAPA(C0=__builtin_amdgcn_mfma_f32_32x32x16_bf16(kf[2],qr[1],C0,0,0,0),   P0[10],P0[11],P0[12],P0[13], pw1[0]=PKW(P0,8), pw1[1]=PKW(P0,10), pw1); \
    VRD(5); SBAR(); GAPA(C1=__builtin_amdgcn_mfma_f32_32x32x16_bf16(kf[3],qr[1],C1,0,0,0),   P0[14],P0[15],P1[0],P1[1],   pw1[2]=PKW(P0,12),pw1[3]=PKW(P0,14), pw1); \
    VRD(2); SBAR(); GAPA(C0=__builtin_amdgcn_mfma_f32_32x32x16_bf16(kf[4],qr[2],C0,0,0,0),   P1[2],P1[3],P1[4],P1[5],     pw2[0]=PKW(P1,0), pw2[1]=PKW(P1,2), pw2); \
    VRD(6); SBAR(); GAPA(C1=__builtin_amdgcn_mfma_f32_32x32x16_bf16(kf[5],qr[2],C1,0,0,0),   P1[6],P1[7],P1[8],P1[9],     pw2[2]=PKW(P1,4), pw2[3]=PKW(P1,6), pw2); \
    VRD(3); SBAR(); GAPA(C0=__builtin_amdgcn_mfma_f32_32x32x16_bf16(kf[6],qr[3],C0,0,0,0),   P1[10],P1[11],P1[12],P1[13], pw3[0]=PKW(P1,8), pw3[1]=PKW(P1,10), pw3); \
    VRD(7); SBAR(); GAPA(C1=__builtin_amdgcn_mfma_f32_32x32x16_bf16(kf[7],qr[3],C1,0,0,0),   P1[14],P1[15],0.f,0.f,       pw3[2]=PKW(P1,12),pw3[3]=PKW(P1,14), pw3); \
    l_reg+=sacc; \
    if(GK){DMA_K((t)+3,sl_cur);} if(GV){DMA_V((t)+1,sl_next);} \
    CMASK(C0,C1,t); \
    { float a=MX3(C0[0],C0[1],C1[0]),b=MX3(C0[2],C0[3],C1[1]); a=MX3(a,C1[2],C1[3]); \
      _Pragma("unroll") for(int r=4;r<16;r+=4){a=MX3(a,C0[r],C0[r+1]);b=MX3(b,C0[r+2],C0[r+3]);a=MX3(a,C1[r],C1[r+1]);b=MX3(b,C1[r+2],C1[r+3]);} \
      float rm=__builtin_fmaxf(a,b); { auto rr=__builtin_amdgcn_permlane32_swap(__float_as_uint(rm),__float_as_uint(rm),false,false); rm=__builtin_fmaxf(__uint_as_float(rr[0]),__uint_as_float(rr[1])); } \
      resc=false; \
      if(__builtin_expect(__any(rm>(float)THRL),0)){ const float dl=__builtin_fmaxf(rm,0.f); mhat+=dl; \
        _Pragma("unroll") for(int r=0;r<16;++r){C0[r]-=dl;C1[r]-=dl;} \
        const float f=__builtin_amdgcn_exp2f(-dl); l_reg*=f; if(hi==0)wsf[r32]=f; resc=true; } } \
    const float nmh_=-mhat; if(GL){ BLOAD(P0,P1,(t)+1); } SBAR(); \
    GAPB(o[0]=__builtin_amdgcn_mfma_f32_32x32x16_bf16(PAF(0),VFR(0),o[0],0,0,0), C0,0,GL,P0); \
    GAPB(o[1]=__builtin_amdgcn_mfma_f32_32x32x16_bf16(PAF(0),VFR(4),o[1],0,0,0), C0,4,GL,P0); \
    KRD(GL,0); GAPB(o[0]=__builtin_amdgcn_mfma_f32_32x32x16_bf16(PAF(1),VFR(1),o[0],0,0,0), C0,8,GL,P0); \
    KRD(GL,1); GAPB(o[1]=__builtin_amdgcn_mfma_f32_32x32x16_bf16(PAF(1),VFR(5),o[1],0,0,0), C0,12,GL,P0); \
    KRD(GL,2); GAPB(o[0]=__builtin_amdgcn_mfma_f32_32x32x16_bf16(PAF(2),VFR(2),o[0],0,0,0), C1,0,GL,P1); \
    KRD(GL,3); GAPB(o[1]=__builtin_amdgcn_mfma_f32_32x32x16_bf16(PAF(2),VFR(6),o[1],0,0,0), C1,4,GL,P1); \
    GAPB(o[0]=__builtin_amdgcn_mfma_f32_32x32x16_bf16(PAF(3),VFR(3),o[0],0,0,0), C1,8,GL,P1); \
    GAPB(o[1]=__builtin_amdgcn_mfma_f32_32x32x16_bf16(PAF(3),VFR(7),o[1],0,0,0), C1,12,GL,P1); \
    }while(0)
  int t=1;
  #undef CMASK
  #define CMASK(P0,P1,t) do{}while(0)
  for(;t+5<NT;t+=2){
    STEP(pB0,pB1,pA0,pA1,t,true,true,true);     WAIT_BAR(2); RESC(); ROT();
    STEP(pA0,pA1,pB0,pB1,t+1,true,true,true);   WAIT_BAR(2); RESC(); ROT();
  }
  #undef CMASK
  #define CMASK(P0,P1,t) do{int jb_=(t)-(NT-4); if(jb_>=0)cmask(P0,P1,jb_,qrel,hi);}while(0)
  #define ENDW(tt) do{ if((tt)+3<NT){WAIT_BAR(2);} else if((tt)+2<NT){WAIT_BAR(1);} else {WAIT_BAR(0);} }while(0)
  for(;t+1<NT;t+=2){
    STEP(pB0,pB1,pA0,pA1,t,(t+3<NT),(t+1<NT),(t+1<NT));       ENDW(t);   RESC(); ROT();
    STEP(pA0,pA1,pB0,pB1,t+1,(t+4<NT),(t+2<NT),(t+2<NT));     ENDW(t+1); RESC(); ROT();
  }
  STEP(pB0,pB1,pA0,pA1,NT-1,false,false,false); RESC();
  { float sacc=pB0[0]+pB0[1]; _Pragma("unroll") for(int r=2;r<16;++r)sacc+=pB0[r]; _Pragma("unroll") for(int r=0;r<16;++r)sacc+=pB1[r]; l_reg+=sacc;
    pw0=(u32x4){PKW(pB0,0),PKW(pB0,2),PKW(pB0,4),PKW(pB0,6)};pw1=(u32x4){PKW(pB0,8),PKW(pB0,10),PKW(pB0,12),PKW(pB0,14)};pw2=(u32x4){PKW(pB1,0),PKW(pB1,2),PKW(pB1,4),PKW(pB1,6)};pw3=(u32x4){PKW(pB1,8),PKW(pB1,10),PKW(pB1,12),PKW(pB1,14)};
    SBAR(); pv(o,vb0+sl_cur,PAF(0),PAF(1),PAF(2),PAF(3)); }
  #undef PKW
  #undef PAF
  #undef VFR
  #undef PIN
  #undef MX3
  #undef GAPA
  #undef GAPB
  #undef EX
  #undef VRD
  #undef KRD
  #undef STEP
  #undef ENDW
  {auto rr=__builtin_amdgcn_permlane32_swap(__float_as_uint(l_reg),__float_as_uint(l_reg),false,false);l_reg=__uint_as_float(rr[0])+__uint_as_float(rr[1]);}
  if(hi==0)wsf[32+r32]=l_reg;asm volatile("s_waitcnt lgkmcnt(0)":::"memory");
  float rli[16];
  #pragma unroll
  for(int r=0;r<16;++r)rli[r]=__builtin_amdgcn_rcpf(wsf[32+crow(r,hi)]);
  bf16*Ow=O+(rowbase+q0+wid*QBLK)*DM+h*D;
  { bf16*stg=(bf16*)(shm+LDS_OST)+wid*2048;
    #pragma unroll
    for(int r=0;r<16;++r){const int orow=crow(r,hi);
      #pragma unroll
      for(int d0=0;d0<2;++d0)stg[orow*64+d0*32+r32]=__float2bfloat16(o[d0][r]*rli[r]);}
    asm volatile("s_waitcnt lgkmcnt(0)":::"memory");
    #pragma unroll
    for(int i=0;i<4;++i){const int row=i*8+(lane>>3),ch=lane&7; const u32x4 v=*(const u32x4*)(stg+row*64+ch*8); ATTN_STORE16(Ow+(long)row*DM+ch*8,v);} }
  asm volatile("s_waitcnt lgkmcnt(0)\n\ts_barrier":::"memory");
  #undef BINIT
  #undef BLOAD
  #undef DMA_K
  #undef DMA_V
  #undef CMASK
  #undef START
  #undef RESC
  #undef ROT
}
constexpr int ATTN_LDS_BYTES=LDS_BYTES;
#undef SBAR
#undef WAIT_BAR
}

#define LAS __attribute__((address_space(3)))
typedef unsigned short bf16;
typedef unsigned v4u __attribute__((ext_vector_type(4)));
typedef unsigned v2u __attribute__((ext_vector_type(2)));
typedef float f32x4 __attribute__((ext_vector_type(4)));
typedef float f32x16 __attribute__((ext_vector_type(16)));
typedef short bf16x8 __attribute__((ext_vector_type(8)));

constexpr int MP = 65536, MS = 1024, MT = MP + MS, DMODEL = 1024, FF = 2816, SEQL = 4096, PAST = 1024, SSQ_ = 64, KVS = PAST + SSQ_;
constexpr float LOG2E = 1.4426950408889634f;
constexpr size_t MiB = 1u << 20;
constexpr size_t WS_WPOOL = 0, WS_WGU0 = 1 * MiB, WS_WGU1 = 12 * MiB, WS_WDN0 = 23 * MiB, WS_WDN1 = 29 * MiB, WS_WKVQ = 35 * MiB, WS_WO = 42 * MiB,
                 WS_RSTD = 44 * MiB, WS_SSQ = 45 * MiB, WS_DK2 = 50 * MiB, WS_DKS = 54 * MiB, WS_XB = 64 * MiB, WS_PB = 194 * MiB, WS_R1 = 324 * MiB,
                 WS_KB = WS_R1, WS_VB = WS_R1 + 130 * MiB, WS_QB = WS_R1 + 260 * MiB, WS_GN = 56 * MiB, WS_CTL = 57 * MiB, WS_KVQS = 58 * MiB, WS_END = WS_R1 + 390 * MiB;
constexpr int LDS_BYTES = 147456;
constexpr int DK_OFF = 86016;
static_assert(attn_body::ATTN_LDS_BYTES <= DK_OFF && DK_OFF + 16384 <= LDS_BYTES && pg8::STAGE_BYTES <= LDS_BYTES, "LDS map");

__device__ __forceinline__ float wave_sum(float v) {
#pragma unroll
    for (int o = 1; o < 64; o <<= 1) v += __shfl_xor(v, o);
    return v;
}
__device__ __forceinline__ float wave_max(float v) {
#pragma unroll
    for (int o = 1; o < 64; o <<= 1) v = fmaxf(v, __shfl_xor(v, o));
    return v;
}
__device__ __forceinline__ unsigned pk2(float lo, float hi) { return pg8::cvt_pk_bf16(lo, hi); }
__device__ __forceinline__ float bf2f(unsigned short b) { return __uint_as_float((unsigned)b << 16); }
__device__ __forceinline__ int crow(int r, int hi) { return (r & 3) + 8 * (r >> 2) + 4 * hi; }

struct RmOff { int off; __device__ __forceinline__ int operator()(int n) const { return off + n; } };
struct RmGU  { int up;  __device__ __forceinline__ int operator()(int n) const { return 256 * (n >> 7) + (n & 127) + up * 128; } };
struct RmKVQ { int base; __device__ __forceinline__ int operator()(int n) const { const int l = n & 255; return base + (n & ~255) + 128 * ((l >> 5) & 1) + 32 * (l >> 6) + (l & 31); } };

template <class RowMap> __device__ __forceinline__ void transpose_item(const float* W, int K, int N, bf16* WT, const RowMap rm, const float* kgain, const float* nscale, LAS float* scr, int item, int lane) {
    const int nblk = N / 32, kb = item / nblk, nb = item % nblk, k0 = 64 * kb, n0 = 32 * nb;
    const int n4 = (lane & 7) * 4, kr = lane >> 3;
    const f32x4 ns4 = nscale ? *(const f32x4*)(nscale + n0 + n4) : (f32x4){1.f, 1.f, 1.f, 1.f};
    f32x4 v[8];
#pragma unroll
    for (int i = 0; i < 8; ++i) v[i] = *(const f32x4*)(W + (size_t)(k0 + kr + 8 * i) * N + n0 + n4);
#pragma unroll
    for (int i = 0; i < 8; ++i) { const int kk = kr + 8 * i; f32x4 x = v[i] * ns4; if (kgain) x = x * kgain[k0 + kk];
#pragma unroll
        for (int e = 0; e < 4; ++e) scr[kk * 33 + n4 + e] = x[e]; }
    asm volatile("s_waitcnt lgkmcnt(0)" ::: "memory");
    const int c = lane & 7;
#pragma unroll
    for (int j = 0; j < 4; ++j) { const int n = (lane >> 3) + 8 * j; const LAS float* s = scr + (8 * c) * 33 + n;
        v4u o; o.x = pg8::pkbf(s[0 * 33], s[1 * 33]); o.y = pg8::pkbf(s[2 * 33], s[3 * 33]); o.z = pg8::pkbf(s[4 * 33], s[5 * 33]); o.w = pg8::pkbf(s[6 * 33], s[7 * 33]);
        *(v4u*)(WT + (size_t)rm(n0 + n) * K + k0 + 8 * c) = o; }
    asm volatile("s_waitcnt lgkmcnt(0)" ::: "memory");
}

#define XB_TMO      128
#define XB_XCNT(j)  (256  + 64 * (j))
#define XB_XSUB(j)  (1280 + 64 * (j))
#define XB_XGEN(j)  (2304 + 64 * (j))
#define XB_TOP      3328
#define XB_TOPGEN   3392
#define XCD_BAR_WORDS 3456
#define XB_SPIN_CAP (1u << 18)

__device__ __forceinline__ unsigned xb_ld(unsigned* p)              { return __hip_atomic_load(p, __ATOMIC_RELAXED, __HIP_MEMORY_SCOPE_AGENT); }
__device__ __forceinline__ unsigned xb_add(unsigned* p, unsigned v) { return __hip_atomic_fetch_add(p, v, __ATOMIC_RELAXED, __HIP_MEMORY_SCOPE_AGENT); }
__device__ __forceinline__ unsigned xb_xcc_id() { return (unsigned)__builtin_amdgcn_s_getreg((3 << 11) | 20) & 0xFu; }
#define XB_SPIN(cond, bar) do { unsigned _sp = 0; while (cond) { __builtin_amdgcn_s_sleep(1); \
    if ((++_sp & 255u) == 0u) { if (xb_ld(&(bar)[XB_TMO])) break; if (_sp > XB_SPIN_CAP) { atomicAdd(&(bar)[XB_TMO], 1u); break; } } } } while (0)

struct XcdBarrier {
    unsigned* bar; unsigned x;
    volatile LAS unsigned* st;
};

__device__ __forceinline__ XcdBarrier xcd_barrier_post(unsigned* bar, volatile LAS unsigned* st) {
    XcdBarrier b; b.bar = bar; b.x = xb_xcc_id(); b.st = st;
    if (threadIdx.x == 0) (void)xb_add(&bar[XB_XCNT(b.x)], 1u);
    return b;
}
__device__ __forceinline__ void xcd_barrier_complete(unsigned* bar, unsigned x, unsigned& nloc, unsigned& nx) {
    const unsigned G = gridDim.x * gridDim.y * gridDim.z;
    unsigned sum, cnt, mine, sp = 0u;
    for (;;) {
        sum = 0u; cnt = 0u; mine = 0u;
#pragma unroll
        for (unsigned j = 0; j < 16; ++j) { const unsigned c = xb_ld(&bar[XB_XCNT(j)]); sum += c; cnt += (c > 0u) ? 1u : 0u; mine = (j == x) ? c : mine; }
        if (sum == G) break;
        __builtin_amdgcn_s_sleep(1);
        if ((++sp & 255u) == 0u) { if (xb_ld(&bar[XB_TMO])) break; if (sp > XB_SPIN_CAP) { atomicAdd(&bar[XB_TMO], 1u); break; } }
    }
    nloc = mine > 0u ? mine : 1u; nx = cnt > 0u ? cnt : 1u;
}

__device__ __forceinline__ void xcd_barrier(const XcdBarrier& b) {
    asm volatile("s_waitcnt vmcnt(0)" ::: "memory");
    __syncthreads();
    if (threadIdx.x == 0) {
        unsigned* bar = b.bar;
        __builtin_amdgcn_s_waitcnt(0);
        unsigned nloc = b.st[0], nx = b.st[1];
        if (nloc == 0u) { xcd_barrier_complete(bar, b.x, nloc, nx); b.st[0] = nloc; b.st[1] = nx; }
        const unsigned old = xb_add(&bar[XB_XSUB(b.x)], 1u);
        const unsigned gen = old / nloc;
        if (old + 1u == (gen + 1u) * nloc) {
            __builtin_amdgcn_fence(__ATOMIC_RELEASE, "agent");
            asm volatile("s_waitcnt vmcnt(0)" ::: "memory");
            const unsigned og = xb_add(&bar[XB_TOP], 1u);
            const unsigned tg = og / nx;
            if (og + 1u == (tg + 1u) * nx) xb_add(&bar[XB_TOPGEN], 1u);
            else XB_SPIN(xb_ld(&bar[XB_TOPGEN]) == tg, bar);
            __builtin_amdgcn_fence(__ATOMIC_ACQUIRE, "agent");
            xb_add(&bar[XB_XGEN(b.x)], 1u);
            asm volatile("s_waitcnt vmcnt(0)" ::: "memory");
        } else {
            XB_SPIN(xb_ld(&bar[XB_XGEN(b.x)]) == gen, bar);
            __builtin_amdgcn_fence(__ATOMIC_ACQUIRE, "agent");
            asm volatile("s_waitcnt vmcnt(0)" ::: "memory");
        }
    }
    __syncthreads();
}

struct Args { const float* in[22]; float* out; unsigned char* ws; };
enum { I_XP = 0, I_XS, I_SP, I_CK, I_CV, I_CL, I_GMIX, I_GFFN, I_PW, I_PS, I_GKV, I_WK, I_WV, I_WF, I_BF, I_GKN, I_WQ, I_GQN, I_WO, I_WG, I_WU, I_WD };

template <int W> __device__ __forceinline__ void pool_item(const float* xb_, const float* rstd, const float* sp_, int t0, bool smp, f32x4 gm, bf16* pb_, float* ps_, int pst) {
    f32x4 halo[W - 1], mn[16];
    if (t0 > 0) {
#pragma unroll
        for (int i = 0; i < W - 1; ++i) { const int t = t0 - (W - 1) + i; halo[i] = (*(const f32x4*)(xb_ + (size_t)t * 1024) * rstd[t]) * gm; }
    } else if (smp) {
#pragma unroll
        for (int i = 0; i < W - 1; ++i) halo[i] = *(const f32x4*)(sp_ + (size_t)(15 - (W - 1) + i) * 1024);
    } else {
#pragma unroll
        for (int i = 0; i < W - 1; ++i) halo[i] = (f32x4){0.f, 0.f, 0.f, 0.f};
    }
#pragma unroll
    for (int r = 0; r < 16; ++r) mn[r] = (*(const f32x4*)(xb_ + (size_t)(t0 + r) * 1024) * rstd[t0 + r]) * gm;
    f32x4 s = {0.f, 0.f, 0.f, 0.f};
#pragma unroll
    for (int i = 0; i < W - 1; ++i) s += halo[i];
#pragma unroll
    for (int r = 0; r < 16; ++r) {
        const int t = t0 + r; s += mn[r];
        const int cnt = (smp || t + 1 >= W) ? W : t + 1;
        const f32x4 p = s * (1.0f / (float)cnt) - mn[r];
        v2u pw; pw.x = pk2(p[0], p[1]); pw.y = pk2(p[2], p[3]);
        *(v2u*)(pb_ + (size_t)r * 1024) = pw;
        if (t >= pst) *(f32x4*)(ps_ + (size_t)(t - pst) * 1024) = mn[r];
        s -= (r - (W - 1) >= 0) ? mn[r - (W - 1) >= 0 ? r - (W - 1) : 0] : halo[r < W - 1 ? r : 0];
    }
}

template <int W> __device__ __forceinline__ void pool_step(const f32x4 (&prev)[16], const f32x4 (&mn)[16], int t0, bool smp, bf16* pb_, float* ps_, int pst) {
    f32x4 s = {0.f, 0.f, 0.f, 0.f};
#pragma unroll
    for (int i = 0; i < W - 1; ++i) s += prev[16 - (W - 1) + i];
#pragma unroll
    for (int r = 0; r < 16; ++r) {
        const int t = t0 + r; s += mn[r];
        const int cnt = (smp || t + 1 >= W) ? W : t + 1;
        const f32x4 p = s * (1.0f / (float)cnt) - mn[r];
        v2u pw; pw.x = pk2(p[0], p[1]); pw.y = pk2(p[2], p[3]);
        *(v2u*)(pb_ + (size_t)r * 1024) = pw;
        if (t >= pst) *(f32x4*)(ps_ + (size_t)(t - pst) * 1024) = mn[r];
        s -= (r - (W - 1) >= 0) ? mn[r - (W - 1) >= 0 ? r - (W - 1) : 0] : prev[(16 - (W - 1) + r) < 16 ? (16 - (W - 1) + r) : 0];
    }
}

__device__ __forceinline__ void sample_attn(int b, int h, const float* ck, const float* cv, const bf16* KB, const bf16* VB, const bf16* QB, const float* dks, bf16* OB,
                                            LAS unsigned char* lds, int tid, int lane, int wid) {
    constexpr int RS = 144;
    LAS unsigned char* Ks = lds; LAS unsigned char* Vs = lds + 128 * RS; LAS float* comb = (LAS float*)(lds + 2 * 128 * RS);
    const int r32 = lane & 31, hi = lane >> 5, qh = wid & 1, kg = wid >> 1;
    const int qrow = MP + b * 64 + qh * 32 + r32;
    bf16x8 qf[4];
#pragma unroll
    for (int d0 = 0; d0 < 4; ++d0) qf[d0] = *(const bf16x8*)(QB + (size_t)qrow * 1024 + h * 64 + d0 * 16 + hi * 8);
    const int qpos = PAST + qh * 32 + r32; const float dq2 = dks[qpos];
    float m = -1e30f, l = 0.f; f32x16 o0 = {}, o1 = {};
    const int kk = tid >> 2, dseg = (tid & 3) * 16;
    f32x4 kr[4], vr[4];
#define SA_LOAD(c) do { const int j_ = 128 * (c) + kk; \
        if (j_ < PAST) { const f32x4* pk_ = (const f32x4*)(ck + (((size_t)b * PAST + j_) * 16 + h) * 64 + dseg); const f32x4* pv_ = (const f32x4*)(cv + (((size_t)b * PAST + j_) * 16 + h) * 64 + dseg); \
            _Pragma("unroll") for (int i_ = 0; i_ < 4; ++i_) { kr[i_] = pk_[i_]; vr[i_] = pv_[i_]; } } \
        else if (j_ < KVS) { const v4u* pk_ = (const v4u*)(KB + (size_t)(MP + b * 64 + j_ - PAST) * 1024 + h * 64 + dseg); const v4u* pv_ = (const v4u*)(VB + (size_t)(MP + b * 64 + j_ - PAST) * 1024 + h * 64 + dseg); \
            _Pragma("unroll") for (int i_ = 0; i_ < 2; ++i_) { const v4u a_ = pk_[i_], c_ = pv_[i_]; \
                kr[2 * i_] = (f32x4){__uint_as_float(a_.x << 16), __uint_as_float(a_.x & 0xffff0000u), __uint_as_float(a_.y << 16), __uint_as_float(a_.y & 0xffff0000u)}; \
                kr[2 * i_ + 1] = (f32x4){__uint_as_float(a_.z << 16), __uint_as_float(a_.z & 0xffff0000u), __uint_as_float(a_.w << 16), __uint_as_float(a_.w & 0xffff0000u)}; \
                vr[2 * i_] = (f32x4){__uint_as_float(c_.x << 16), __uint_as_float(c_.x & 0xffff0000u), __uint_as_float(c_.y << 16), __uint_as_float(c_.y & 0xffff0000u)}; \
                vr[2 * i_ + 1] = (f32x4){__uint_as_float(c_.z << 16), __uint_as_float(c_.z & 0xffff0000u), __uint_as_float(c_.w << 16), __uint_as_float(c_.w & 0xffff0000u)}; } } \
        else { _Pragma("unroll") for (int i_ = 0; i_ < 4; ++i_) { kr[i_] = (f32x4){0.f, 0.f, 0.f, 0.f}; vr[i_] = (f32x4){0.f, 0.f, 0.f, 0.f}; } } } while (0)
    SA_LOAD(0);
    for (int c = 0; c < 9; ++c) {
        __syncthreads();
        {
            v4u a, bq;
            a.x = pk2(kr[0][0], kr[0][1]); a.y = pk2(kr[0][2], kr[0][3]); a.z = pk2(kr[1][0], kr[1][1]); a.w = pk2(kr[1][2], kr[1][3]);
            bq.x = pk2(kr[2][0], kr[2][1]); bq.y = pk2(kr[2][2], kr[2][3]); bq.z = pk2(kr[3][0], kr[3][1]); bq.w = pk2(kr[3][2], kr[3][3]);
            *(LAS v4u*)(Ks + kk * RS + dseg * 2) = a; *(LAS v4u*)(Ks + kk * RS + dseg * 2 + 16) = bq;
            a.x = pk2(vr[0][0], vr[0][1]); a.y = pk2(vr[0][2], vr[0][3]); a.z = pk2(vr[1][0], vr[1][1]); a.w = pk2(vr[1][2], vr[1][3]);
            bq.x = pk2(vr[2][0], vr[2][1]); bq.y = pk2(vr[2][2], vr[2][3]); bq.z = pk2(vr[3][0], vr[3][1]); bq.w = pk2(vr[3][2], vr[3][3]);
            *(LAS v4u*)(Vs + kk * RS + dseg * 2) = a; *(LAS v4u*)(Vs + kk * RS + dseg * 2 + 16) = bq;
        }
        __syncthreads();
        if (c + 1 < 9) SA_LOAD(c + 1);
        const int kvb = 128 * c + 32 * kg;
        if (kvb < KVS) {
            f32x16 s = {};
#pragma unroll
            for (int d0 = 0; d0 < 4; ++d0) { const bf16x8 kf = *(const LAS bf16x8*)(Ks + (32 * kg + r32) * RS + (d0 * 16 + hi * 8) * 2); s = __builtin_amdgcn_mfma_f32_32x32x16_bf16(kf, qf[d0], s, 0, 0, 0); }
            float mx = -1e30f;
#pragma unroll
            for (int jj = 0; jj < 4; ++jj) { const f32x4 dk = *(const f32x4*)(dks + kvb + 8 * jj + 4 * hi);
#pragma unroll
                for (int e = 0; e < 4; ++e) { const int kv = kvb + 8 * jj + 4 * hi + e; float x = s[4 * jj + e] + dq2 - dk[e]; x = (kv > qpos) ? -1e30f : x; s[4 * jj + e] = x; mx = fmaxf(mx, x); } }
            mx = fmaxf(mx, __shfl_xor(mx, 32));
            const float mn = fmaxf(m, mx), alpha = __builtin_amdgcn_exp2f(m - mn); m = mn;
            float ps = 0.f;
#pragma unroll
            for (int r = 0; r < 16; ++r) { s[r] = __builtin_amdgcn_exp2f(s[r] - mn); ps += s[r]; }
            l = l * alpha + ps; o0 = o0 * alpha; o1 = o1 * alpha;
#pragma unroll
            for (int ks = 0; ks < 2; ++ks) {
                v4u pw; pw.x = pk2(s[8 * ks], s[8 * ks + 1]); pw.y = pk2(s[8 * ks + 2], s[8 * ks + 3]); pw.z = pk2(s[8 * ks + 4], s[8 * ks + 5]); pw.w = pk2(s[8 * ks + 6], s[8 * ks + 7]);
                const bf16x8 pb = __builtin_bit_cast(bf16x8, pw);
#pragma unroll
                for (int dh = 0; dh < 2; ++dh) { bf16x8 va;
#pragma unroll
                    for (int i = 0; i < 8; ++i) va[i] = *(const LAS short*)(Vs + (32 * kg + crow(8 * ks + i, hi)) * RS + (dh * 32 + r32) * 2);
                    if (dh == 0) o0 = __builtin_amdgcn_mfma_f32_32x32x16_bf16(va, pb, o0, 0, 0, 0); else o1 = __builtin_amdgcn_mfma_f32_32x32x16_bf16(va, pb, o1, 0, 0, 0); }
            }
        }
    }
#undef SA_LOAD
    l += __shfl_xor(l, 32);
    LAS float* cw = comb + wid * (32 * 66) + r32 * 66;
#pragma unroll
    for (int r = 0; r < 16; ++r) { cw[crow(r, hi)] = o0[r]; cw[32 + crow(r, hi)] = o1[r]; }
    if (hi == 0) { cw[64] = m; cw[65] = l; }
    __syncthreads();
    {
        const int q64 = tid >> 3, d8 = (tid & 7) * 8, qh2 = q64 >> 5, ql = q64 & 31;
        float M = -1e30f;
#pragma unroll
        for (int g = 0; g < 4; ++g) M = fmaxf(M, comb[(g * 2 + qh2) * (32 * 66) + ql * 66 + 64]);
        float den = 0.f, a8[8];
#pragma unroll
        for (int e = 0; e < 8; ++e) a8[e] = 0.f;
#pragma unroll
        for (int g = 0; g < 4; ++g) { const LAS float* base = comb + (g * 2 + qh2) * (32 * 66) + ql * 66; const float w = __builtin_amdgcn_exp2f(base[64] - M); den += w * base[65];
#pragma unroll
            for (int e = 0; e < 8; ++e) a8[e] += w * base[d8 + e]; }
        const float inv = 1.0f / den;
        v4u w; w.x = pk2(a8[0] * inv, a8[1] * inv); w.y = pk2(a8[2] * inv, a8[3] * inv); w.z = pk2(a8[4] * inv, a8[5] * inv); w.w = pk2(a8[6] * inv, a8[7] * inv);
        *(v4u*)(OB + (size_t)(MP + b * 64 + q64) * 1024 + h * 64 + d8) = w;
    }
    __syncthreads();
}

#ifndef PG_ALIGN
#define PG_ALIGN true
#endif
#ifndef PH_MASK
#define PH_MASK 0xFFFF
#endif
#define RUN(p) (((PH_MASK) >> (p)) & 1)
#ifndef REP_MASK
#define REP_MASK 0
#endif
#define NREP(p) (1 + (((REP_MASK) >> (p)) & 1))

__global__ void __launch_bounds__(512, 2) mega(Args a) {
    extern __shared__ __attribute__((aligned(16))) unsigned char lds_raw[];
    cg::grid_group grid = cg::this_grid();
    LAS unsigned char* lds = (LAS unsigned char*)lds_raw;
    const int G = gridDim.x;
    int vcu;
    {
        LAS int* vs = (LAS int*)(lds_raw + LDS_BYTES - 16);
        if (threadIdx.x == 0) {
            unsigned* cen = (unsigned*)(a.ws + WS_CTL);
            const unsigned xcc = (unsigned)__builtin_amdgcn_s_getreg((3 << 11) | 20) & 7u;
            const unsigned rank = __hip_atomic_fetch_add(cen + 64 * xcc, 1u, __ATOMIC_RELAXED, __HIP_MEMORY_SCOPE_AGENT);
            vs[0] = (G == 256 && rank < 32u) ? (int)(xcc + 8u * rank) : -1;
        }
        __syncthreads();
        vcu = __builtin_amdgcn_readfirstlane(vs[0]);
        if (threadIdx.x == 0) { vs[1] = 0; vs[2] = 0; }
        __syncthreads();
    }
#define PHASE_ENTER() int tid_o = threadIdx.x; asm volatile("" : "+v"(tid_o)); const int tid = tid_o, lane = tid & 63, wave = __builtin_amdgcn_readfirstlane(tid >> 6); (void)lane; (void)wave; \
    int bx_o = blockIdx.x; asm volatile("" : "+s"(bx_o)); const int bx = bx_o; size_t zo_ = 0; asm volatile("" : "+s"(zo_)); unsigned char* ws = a.ws + zo_; float* out = a.out + zo_; \
    const float* xp = a.in[I_XP]; const float* xs = a.in[I_XS]; (void)xp; (void)xs; \
    bf16* WPOOL = (bf16*)(ws + WS_WPOOL); bf16* WKVQ = (bf16*)(ws + WS_WKVQ); bf16* WOT = (bf16*)(ws + WS_WO); \
    float* RSTD = (float*)(ws + WS_RSTD); float* SSQ = (float*)(ws + WS_SSQ); float* DK2 = (float*)(ws + WS_DK2); float* DKS = (float*)(ws + WS_DKS); \
    bf16* XB = (bf16*)(ws + WS_XB); bf16* PB = (bf16*)(ws + WS_PB); bf16* OB = PB; bf16* ACT = (bf16*)(ws + WS_R1); \
    bf16* QB = (bf16*)(ws + WS_QB); bf16* KB = (bf16*)(ws + WS_KB); bf16* VB = (bf16*)(ws + WS_VB); \
    (void)WPOOL; (void)WKVQ; (void)WOT; (void)RSTD; (void)SSQ; (void)DK2; (void)DKS; (void)XB; (void)PB; (void)OB; (void)ACT; (void)QB; (void)KB; (void)VB;
    (void)xcd_barrier_post((unsigned*)(a.ws + WS_CTL + 4096), (volatile LAS unsigned*)(lds_raw + LDS_BYTES - 12));
#define GSYNC() do { size_t zb_ = 0; asm volatile("" : "+s"(zb_)); XcdBarrier xb_; xb_.bar = (unsigned*)(a.ws + WS_CTL + 4096) + zb_; xb_.x = xb_xcc_id(); xb_.st = (volatile LAS unsigned*)(lds_raw + LDS_BYTES - 12); xcd_barrier(xb_); } while (0)
#define GSYNC0() do { asm volatile("s_waitcnt vmcnt(0)" ::: "memory"); grid.sync(); __builtin_amdgcn_fence(__ATOMIC_ACQUIRE, "agent"); asm volatile("s_waitcnt vmcnt(0)" ::: "memory"); } while (0)

    grid.sync();
    for (int rep_ = 0; rep_ < NREP(0); ++rep_) { if (rep_) GSYNC(); PHASE_ENTER();
        LAS float* scr = (LAS float*)(lds + wave * 16384);
        const int gw = bx * 8 + wave, NGW = G * 8;
        constexpr int I_POOL = 4 * 32, I_GU = 16 * 88, I_DN = 44 * 32, I_SQ = 16 * 32;
        constexpr int NITEMS = I_POOL + 4 * I_GU + 2 * I_DN + 4 * I_SQ;
        for (int it = gw; it < NITEMS; it += NGW) {
            int r = it;
            if (r < I_POOL) { const int mtx = r >> 5; transpose_item(a.in[I_PW] + (size_t)mtx * 65536, 256, 256, WPOOL, RmOff{mtx * 256}, nullptr, a.in[I_PS] + mtx * 256, scr, r & 31, lane); continue; } r -= I_POOL;
            if (r < 4 * I_GU) { const int mtx = r / I_GU, l = mtx >> 1, up = mtx & 1; transpose_item((up ? a.in[I_WU] : a.in[I_WG]) + (size_t)l * 1024 * 2816, 1024, 2816, (bf16*)(ws + (l ? WS_WGU1 : WS_WGU0)), RmGU{up}, a.in[I_GFFN] + l * 1024, nullptr, scr, r % I_GU, lane); continue; } r -= 4 * I_GU;
            if (r < 2 * I_DN) { const int l = r / I_DN; transpose_item(a.in[I_WD] + (size_t)l * 2816 * 1024, 2816, 1024, (bf16*)(ws + (l ? WS_WDN1 : WS_WDN0)), RmOff{0}, nullptr, nullptr, scr, r % I_DN, lane); continue; } r -= 2 * I_DN;
            if (r < I_SQ) { transpose_item(a.in[I_WK], 1024, 1024, WKVQ, RmKVQ{0}, a.in[I_GKV], nullptr, scr, r, lane); continue; } r -= I_SQ;
            if (r < I_SQ) { transpose_item(a.in[I_WV], 1024, 1024, WKVQ, RmKVQ{1024}, a.in[I_GKV], nullptr, scr, r, lane); continue; } r -= I_SQ;
            if (r < I_SQ) { transpose_item(a.in[I_WQ], 1024, 1024, WKVQ, RmKVQ{2048}, a.in[I_GMIX] + 1024, nullptr, scr, r, lane); continue; } r -= I_SQ;
            transpose_item(a.in[I_WO], 1024, 1024, WOT, RmOff{0}, nullptr, nullptr, scr, r, lane);
        }
        const int gt = bx * 512 + tid, NT = G * 512;
        for (int i = gt; i < 16 * 1024; i += NT) { const int n = i >> 10, k = i & 1023; WKVQ[(size_t)(3072 + n) * 1024 + k] = (bf16)(pk2(a.in[I_WF][k * 16 + n] * a.in[I_GKV][k], 0.f) & 0xffffu); }
        if (gt < 192) ((float*)(ws + WS_GN))[gt] = gt < 64 ? a.in[I_GKN][gt] : gt < 128 ? 1.0f : a.in[I_GQN][gt - 128] * (0.125f * LOG2E);
        for (int i = gt; i < 240 * 1024 / 8; i += NT) ((v4u*)(WKVQ + (size_t)3088 * 1024))[i] = (v4u){0u, 0u, 0u, 0u};
    }
    __syncthreads();

    for (int rep_ = 0; rep_ < NREP(1); ++rep_) { if (rep_) GSYNC(); PHASE_ENTER();
        const int half = tid >> 8, c4 = (tid & 255) * 4, grp = __builtin_amdgcn_readfirstlane(c4 >> 8), wq = (tid >> 6) & 3;
        const f32x4 gm = *(const f32x4*)(a.in[I_GMIX] + c4);
        LAS float* redb = (LAS float*)lds + half * 64; int par = 0;
        f32x4 prev[16], raw[16]; float rs[16];
#define P1_LOAD(src, t_first) do { _Pragma("unroll") for (int r_ = 0; r_ < 16; ++r_) raw[r_] = *(const f32x4*)((src) + (size_t)((t_first) + r_) * 1024); } while (0)
#define P1_RSTD(valid) do { float ss_[16]; \
            _Pragma("unroll") for (int r_ = 0; r_ < 16; ++r_) { const f32x4 v_ = raw[r_]; ss_[r_] = (valid) ? wave_sum((v_[0] * v_[0] + v_[1] * v_[1]) + (v_[2] * v_[2] + v_[3] * v_[3])) : 0.f; } \
            LAS float* red_ = redb + par * 128; par ^= 1; \
            if (lane == 0) { _Pragma("unroll") for (int r_ = 0; r_ < 16; r_ += 4) *(LAS f32x4*)(red_ + wq * 16 + r_) = (f32x4){ss_[r_], ss_[r_ + 1], ss_[r_ + 2], ss_[r_ + 3]}; } \
            __syncthreads(); \
            _Pragma("unroll") for (int r_ = 0; r_ < 16; ++r_) rs[r_] = __builtin_amdgcn_rsqf(((red_[r_] + red_[16 + r_]) + (red_[32 + r_] + red_[48 + r_])) * (1.0f / 1024.0f) + 1e-6f); } while (0)
#define P1_STEP(t0_, smp_, pb_, ps_, pst_) do { if (grp == 0) pool_step<2>(prev, raw, t0_, smp_, pb_, ps_, pst_); else if (grp == 1) pool_step<4>(prev, raw, t0_, smp_, pb_, ps_, pst_); \
            else if (grp == 2) pool_step<8>(prev, raw, t0_, smp_, pb_, ps_, pst_); else pool_step<16>(prev, raw, t0_, smp_, pb_, ps_, pst_); } while (0)
        for (int run = bx * 2 + half; run < 512; run += G * 2) {
            const int row0 = run * 128, b = row0 >> 12, tr = row0 & 4095;
            const float* xb_ = xp + (size_t)(row0 - tr) * 1024 + c4;
            float* ps_ = out + pg8::O_PSP + (size_t)b * 15 * 1024 + c4;
            if (tr > 0) P1_LOAD(xb_, tr - 16);
            P1_RSTD(tr > 0);
#pragma unroll
            for (int r = 0; r < 16; ++r) prev[r] = (tr > 0) ? (raw[r] * rs[r]) * gm : (f32x4){0.f, 0.f, 0.f, 0.f};
            for (int st = 0; st < 8; ++st) {
                const int t0 = tr + 16 * st;
                P1_LOAD(xb_, t0);
                P1_RSTD(true);
#pragma unroll
                for (int r = 0; r < 16; ++r) raw[r] = (raw[r] * rs[r]) * gm;
                P1_STEP(t0, false, PB + (size_t)(row0 + 16 * st) * 1024 + c4, ps_, 4081);
#pragma unroll
                for (int r = 0; r < 16; ++r) prev[r] = raw[r];
            }
        }
        for (int si = bx * 2 + half; si < 64; si += G * 2) {
            const int b = si >> 2, t0 = 16 * (si & 3);
            const float* xb_ = xs + (size_t)b * 64 * 1024 + c4;
            const float* sp_ = a.in[I_SP] + (size_t)b * 15 * 1024 + c4;
            if (t0 > 0) P1_LOAD(xb_, t0 - 16);
            P1_RSTD(t0 > 0);
            if (t0 > 0) {
#pragma unroll
                for (int r = 0; r < 16; ++r) prev[r] = (raw[r] * rs[r]) * gm;
            } else {
                prev[0] = (f32x4){0.f, 0.f, 0.f, 0.f};
#pragma unroll
                for (int r = 1; r < 16; ++r) prev[r] = *(const f32x4*)(sp_ + (size_t)(r - 1) * 1024);
            }
            P1_LOAD(xb_, t0);
            P1_RSTD(true);
#pragma unroll
            for (int r = 0; r < 16; ++r) raw[r] = (raw[r] * rs[r]) * gm;
            P1_STEP(t0, true, PB + (size_t)(MP + 16 * si) * 1024 + c4, out + pg8::O_PSS + (size_t)b * 15 * 1024 + c4, 49);
        }
#undef P1_LOAD
#undef P1_RSTD
#undef P1_STEP
    }
    GSYNC();
    {
        const unsigned* cen = (const unsigned*)(a.ws + WS_CTL); bool okc = (G == 256);
#pragma unroll
        for (int x = 0; x < 8; ++x) okc = okc && (__hip_atomic_load(cen + 64 * x, __ATOMIC_RELAXED, __HIP_MEMORY_SCOPE_AGENT) == 32u);
        if (!okc) vcu = blockIdx.x;
    }

    for (int rep_ = 0; rep_ < NREP(2); ++rep_) { if (rep_) GSYNC(); PHASE_ENTER();
        pg8::Gemm g{PB, WPOOL, MT, 1024, 256, 1024, 256}; pg8::StaticOrder S; S.init(MP, 1024, G, vcu);
        pg8::EpiRes<true, false, false> E{xp, xs, out, XB, SSQ, nullptr};
        pg8::gemm_phase<pg8::EpiRes<true, false, false>, pg8::StaticOrder, PG_ALIGN, true>(lds, g, S, E);
    }
    GSYNC();

    for (int l = 0; l < 2; ++l) {
        if (l == 1) {
            for (int rep_ = 0; rep_ < NREP(5); ++rep_) { if (rep_) GSYNC(); PHASE_ENTER();
                pg8::Gemm g{XB, WKVQ, MT, 3328, 1024, 1024, 0}; pg8::StaticOrder S; S.init(MP, 3328, G, vcu);
                pg8::EpiKVQ E{SSQ, (const float*)(ws + WS_GN), a.in[I_BF], out, KB, (size_t)(130 * MiB / 2)};
                pg8::gemm_phase<pg8::EpiKVQ, pg8::StaticOrder, PG_ALIGN, true>(lds, g, S, E);
            }
            GSYNC();
            for (int rep_ = 0; rep_ < NREP(7); ++rep_) { if (rep_) GSYNC(); PHASE_ENTER();
                const float mq = wave_max(fabsf(a.in[I_GQN][lane])), mk = wave_max(fabsf(a.in[I_GKN][lane]));
                const float lowc = -(0.125f * LOG2E * 64.f) * mq * mk;
                for (int u = bx; u < 256; u += G) {
                    const int b = u >> 4, h = u & 15;
                    {
                        const float* lp = out + pg8::O_LP + ((size_t)b * 4096 + 8 * tid) * 16 + h; float v[8];
#pragma unroll
                        for (int k = 0; k < 8; ++k) v[k] = lp[(size_t)k * 16];
#pragma unroll
                        for (int k = 1; k < 8; ++k) v[k] += v[k - 1];
                        float inc = v[7];
#pragma unroll
                        for (int o = 1; o < 64; o <<= 1) { const float t = __shfl_up(inc, o); if (lane >= o) inc += t; }
                        LAS float* wt = (LAS float*)(lds + DK_OFF + 16384);
                        if (lane == 63) wt[wave] = inc;
                        __syncthreads();
                        float pre = 0.f;
#pragma unroll
                        for (int w = 0; w < 8; ++w) pre += (w < wave) ? wt[w] : 0.f;
                        const float ex = pre + inc - v[7];
                        LAS f32x4* dstl = (LAS f32x4*)(lds + DK_OFF) + 2 * tid;
                        dstl[0] = (f32x4){(v[0] + ex) * LOG2E, (v[1] + ex) * LOG2E, (v[2] + ex) * LOG2E, (v[3] + ex) * LOG2E};
                        dstl[1] = (f32x4){(v[4] + ex) * LOG2E, (v[5] + ex) * LOG2E, (v[6] + ex) * LOG2E, (v[7] + ex) * LOG2E};
                    }
                    __syncthreads();
                    for (int qb = 15; qb >= 0; --qb) {
                        const LAS float* dl = (const LAS float*)(lds + DK_OFF);
                        const float thr = dl[256 * qb] - 2.f * lowc + 45.f;
                        const int jmax = 4 * qb;
                        const bool sk = (lane < jmax) && (dl[64 * lane + 63] > thr);
                        const int t0 = (int)__builtin_popcountll(__ballot(sk)) & ~1;
                        attn_body::attn_unit<8>(b, h, qb, (const attn_body::bf16*)QB, (const attn_body::bf16*)KB, (const attn_body::bf16*)VB, (attn_body::bf16*)OB, (char*)lds_raw,
                                                (const LAS float*)(lds + DK_OFF), lowc, t0);
                    }
                    __syncthreads();
                }
            }
            for (int rep_ = 0; rep_ < NREP(7); ++rep_) { if (rep_) GSYNC(); PHASE_ENTER();
                for (int u = bx; u < 256; u += G) {
                    {
                        const int b = u >> 4, h = u & 15; const float* ls = out + pg8::O_LS + (size_t)b * 64 * 16 + h; const float* cl = a.in[I_CL] + (size_t)b * 1024 * 16 + h; float v[4];
#pragma unroll
                        for (int k = 0; k < 4; ++k) { const int j = 4 * tid + k; v[k] = j < PAST ? cl[(size_t)j * 16] : (j < KVS ? ls[(size_t)(j - PAST) * 16] : 0.f); }
#pragma unroll
                        for (int k = 1; k < 4; ++k) v[k] += v[k - 1];
                        float inc = v[3];
#pragma unroll
                        for (int o = 1; o < 64; o <<= 1) { const float t = __shfl_up(inc, o); if (lane >= o) inc += t; }
                        LAS float* wt = (LAS float*)(lds + DK_OFF + 16384);
                        if (lane == 63) wt[wave] = inc;
                        __syncthreads();
                        float pre = 0.f;
#pragma unroll
                        for (int w = 0; w < 8; ++w) pre += (w < wave) ? wt[w] : 0.f;
                        const float ex = pre + inc - v[3];
                        if (4 * tid < KVS) *(f32x4*)(DKS + (size_t)u * KVS + 4 * tid) = (f32x4){(v[0] + ex) * LOG2E, (v[1] + ex) * LOG2E, (v[2] + ex) * LOG2E, (v[3] + ex) * LOG2E};
                        asm volatile("s_waitcnt vmcnt(0)" ::: "memory"); __syncthreads();
                    }
                    sample_attn(u >> 4, u & 15, a.in[I_CK], a.in[I_CV], (bf16*)(ws + WS_KVQS) - (size_t)MP * 1024, (bf16*)(ws + WS_KVQS + 2 * MiB) - (size_t)MP * 1024, (bf16*)(ws + WS_KVQS + 4 * MiB) - (size_t)MP * 1024, DKS + (size_t)u * KVS, OB, lds, tid, lane, wave);
                }
            }
            GSYNC();
            for (int rep_ = 0; rep_ < NREP(8); ++rep_) { if (rep_) GSYNC(); PHASE_ENTER();
                pg8::Gemm g{OB, WOT, MT, 1024, 1024, 1024, 0}; pg8::StaticOrder S; S.init(MP, 1024, G, vcu);
                pg8::EpiRes<true, true, false> E{out, out + (size_t)MP * 1024, out, XB, SSQ, nullptr};
                pg8::gemm_phase<pg8::EpiRes<true, true, false>, pg8::StaticOrder, PG_ALIGN, true>(lds, g, S, E);
            }
            GSYNC();
        }
#define SROLE_NB(v) ((v) < 16 ? 0 : (v) < 104 ? 2 : (v) < 120 ? 5 : ((v) < 172 && l == 0) ? 9 : 0)
        {
            PHASE_ENTER();
            pg8::Gemm g{XB, (bf16*)(ws + (l ? WS_WGU1 : WS_WGU0)), MT, 5632, 1024, 1024, 0}; pg8::StaticOrder base; base.init(MP, 5632, G, vcu);
            pg8::EpiGU E{SSQ, ACT};
            pg8::RangeOrder S{base, 0, SROLE_NB(vcu), -1, 0};
            pg8::gemm_phase<pg8::EpiGU, pg8::RangeOrder, PG_ALIGN, true>(lds, g, S, E);
        }
        if (vcu < 120 || (vcu < 172 && l == 0)) {
            PHASE_ENTER();
            int role, sidx;
            if (vcu < 16) { role = 1; sidx = vcu; } else if (vcu < 104) { role = 2; sidx = vcu - 16; } else if (vcu < 120) { role = 3; sidx = vcu - 104; } else { role = 4; sidx = vcu - 120; }
            unsigned* cnt = (unsigned*)(ws + WS_CTL + 32768) + l * 256;
            if (role > 1) {
                if (tid == 0) { const unsigned need = role == 3 ? 88u : 16u; unsigned sp = 0;
                    while (__hip_atomic_load(cnt + 64 * (role - 2), __ATOMIC_RELAXED, __HIP_MEMORY_SCOPE_AGENT) < need && ++sp < (1u << 22)) __builtin_amdgcn_s_sleep(2);
                    __builtin_amdgcn_fence(__ATOMIC_ACQUIRE, "agent"); asm volatile("s_waitcnt vmcnt(0)" ::: "memory"); }
                __syncthreads();
            }
            if (role == 1) {
                pg8::OneUnit S1{256 + (sidx >> 2), sidx & 3};
                if (l) { pg8::Gemm g2{OB, WOT, MT, 1024, 1024, 1024, 0}; pg8::EpiRes<true, true, false> E3{xp, xs, out, XB, SSQ, nullptr}; pg8::gemm_phase<pg8::EpiRes<true, true, false>, pg8::OneUnit, PG_ALIGN, true>(lds, g2, S1, E3); }
                else { pg8::Gemm g2{PB, WPOOL, MT, 1024, 256, 1024, 256}; pg8::EpiRes<true, false, false> E2{xp, xs, out, XB, SSQ, nullptr}; pg8::gemm_phase<pg8::EpiRes<true, false, false>, pg8::OneUnit, PG_ALIGN, true>(lds, g2, S1, E2); }
            } else if (role == 2) {
                pg8::Gemm g2{XB, (bf16*)(ws + (l ? WS_WGU1 : WS_WGU0)), MT, 5632, 1024, 1024, 0}; pg8::EpiGU E2{SSQ, ACT};
                pg8::OneUnit S1{256 + sidx / 22, sidx % 22};
                pg8::gemm_phase<pg8::EpiGU, pg8::OneUnit, PG_ALIGN, true>(lds, g2, S1, E2);
            } else if (role == 3) {
                pg8::Gemm g2{ACT, (bf16*)(ws + (l ? WS_WDN1 : WS_WDN0)), MT, 1024, 2816, 2816, 0}; pg8::OneUnit S1{256 + (sidx >> 2), sidx & 3};
                pg8::EpiRes<true, true, true> E2{out, out + (size_t)MP * 1024, out, XB, SSQ, nullptr};
                pg8::gemm_phase<pg8::EpiRes<true, true, true>, pg8::OneUnit, PG_ALIGN, true>(lds, g2, S1, E2);
            } else {
                pg8::Gemm g2{XB, WKVQ, MT, 3328, 1024, 1024, 0}; pg8::OneUnit S1{256 + sidx / 13, sidx % 13};
                pg8::EpiKVQ E2{SSQ, (const float*)(ws + WS_GN), a.in[I_BF], out, (bf16*)(ws + WS_KVQS) - (size_t)MP * 1024, (size_t)(2 * MiB / 2)};
                pg8::gemm_phase<pg8::EpiKVQ, pg8::OneUnit, PG_ALIGN, true>(lds, g2, S1, E2);
            }
            asm volatile("s_waitcnt vmcnt(0)" ::: "memory"); __syncthreads();
            if (tid == 0) { __builtin_amdgcn_fence(__ATOMIC_RELEASE, "agent"); asm volatile("s_waitcnt vmcnt(0)" ::: "memory");
                __hip_atomic_fetch_add(cnt + 64 * (role - 1), 1u, __ATOMIC_RELAXED, __HIP_MEMORY_SCOPE_AGENT); }
        }
        {
            PHASE_ENTER();
            pg8::Gemm g{XB, (bf16*)(ws + (l ? WS_WGU1 : WS_WGU0)), MT, 5632, 1024, 1024, 0}; pg8::StaticOrder base; base.init(MP, 5632, G, vcu);
            pg8::EpiGU E{SSQ, ACT};
            const bool dns = vcu >= 104 && vcu < 120, tk = vcu >= 172 && vcu < 188;
            pg8::RangeOrder S{base, SROLE_NB(vcu), dns ? 21 : 22, tk ? vcu - 172 + 104 : -1, 21};
            pg8::gemm_phase<pg8::EpiGU, pg8::RangeOrder, PG_ALIGN, true>(lds, g, S, E);
        }
#undef SROLE_NB
        GSYNC();
        for (int rep_ = 0; rep_ < NREP(4); ++rep_) { if (rep_) GSYNC(); PHASE_ENTER();
            pg8::Gemm g{ACT, (bf16*)(ws + (l ? WS_WDN1 : WS_WDN0)), MT, 1024, 2816, 2816, 0}; pg8::StaticOrder S; S.init(MP, 1024, G, vcu);
            if (l == 0) { pg8::EpiRes<true, true, false> E{out, out + (size_t)MP * 1024, out, XB, SSQ, nullptr}; pg8::gemm_phase<pg8::EpiRes<true, true, false>, pg8::StaticOrder, PG_ALIGN, true>(lds, g, S, E); }
            else { pg8::EpiRes<false, true, true> E{out, out + (size_t)MP * 1024, out, XB, nullptr, nullptr}; pg8::gemm_phase<pg8::EpiRes<false, true, true>, pg8::StaticOrder, PG_ALIGN, true>(lds, g, S, E); }
        }
        if (l == 0) GSYNC();
    }
}

extern "C" void kernel_launch(void* const* d_in, const int* in_sizes, int n_in, void* d_out, int out_size, void* d_ws, size_t ws_size, hipStream_t stream) {
    static int grid = 0;
    if (grid == 0) {
        if (n_in != 22 || (size_t)out_size != pg8::O_END || ws_size < WS_END) { fprintf(stderr, "kernel_launch: unexpected shapes: n_in %d out %d ws %zu (need %zu)\n", n_in, out_size, ws_size, (size_t)WS_END); grid = -1; return; }
        int dev = 0, cus = 0, per_cu = 0;
        (void)hipGetDevice(&dev); (void)hipDeviceGetAttribute(&cus, hipDeviceAttributeMultiprocessorCount, dev);
        if (hipFuncSetAttribute((const void*)mega, hipFuncAttributeMaxDynamicSharedMemorySize, LDS_BYTES) != hipSuccess) fprintf(stderr, "kernel_launch: hipFuncSetAttribute failed\n");
        if (hipOccupancyMaxActiveBlocksPerMultiprocessor(&per_cu, (const void*)mega, 512, LDS_BYTES) != hipSuccess || per_cu < 1) { fprintf(stderr, "kernel_launch: occupancy query says %d\n", per_cu); per_cu = 1; }
        (void)hipGetLastError();
        if (cus <= 0) cus = 256;
        grid = cus;
    }
    if (grid < 0) return;
    if (hipMemsetAsync((char*)d_ws + WS_CTL, 0, 65536, stream) != hipSuccess) { fprintf(stderr, "kernel_launch: memset failed\n"); return; }
    Args a{};
    for (int i = 0; i < 22; ++i) a.in[i] = (const float*)d_in[i];
    a.out = (float*)d_out; a.ws = (unsigned char*)d_ws;
    void* args[] = {&a};
    const hipError_t e = hipLaunchCooperativeKernel((const void*)mega, dim3(grid), dim3(512), args, LDS_BYTES, stream);
    if (e != hipSuccess) fprintf(stderr, "kernel_launch: cooperative launch failed: %s (grid %d)\n", hipGetErrorString(e), grid);
}
```

```cpp
#include <hip/hip_runtime.h>
#include <hip/hip_cooperative_groups.h>
#include <cstdio>
#include <cstdint>
namespace cg = cooperative_groups;
namespace pg8 {
#define PG8_LAS __attribute__((address_space(3)))
typedef unsigned short bf16_t;
typedef short bf16x8 __attribute__((ext_vector_type(8)));
typedef float f32x4 __attribute__((ext_vector_type(4)));
typedef unsigned u32x4 __attribute__((ext_vector_type(4)));
constexpr int BM = 256, BK = 64, HALF = 128, HTB = HALF * BK * 2  , STAGE_BYTES = 8 * HTB, NXCD = 8, WGM = 8;

__host__ __device__ __forceinline__ int lds_byte(int r, int c) { const int st = (r >> 4) * 2 + (c >> 5), rr = r & 15, cc = c & 31, ob = rr * 64 + cc * 2; return st * 1024 + (ob ^ (((ob >> 9) & 1) << 5)); }
__host__ __device__ __forceinline__ void stage_rc(int b, int& R, int& C) { const int st = b / 1024, sb = b % 1024, swz = sb ^ (((sb >> 9) & 1) << 5); R = (st >> 1) * 16 + swz / 64; C = (st & 1) * 32 + (swz % 64) / 2; }
__host__ __device__ __forceinline__ int perm32(int rho) { const int n = rho >> 4, i = rho & 15; return 8 * (i >> 2) + 4 * n + (i & 3); }

struct Unit { int pm, pn; };
struct Gemm { const bf16_t* A; const bf16_t* Bt; int M, N, K; int lda; int acol_pn; };

struct StaticOrder {
    int nM, nN, nwg, G, c;
    __host__ __device__ void init(int M, int N, int G_, int c_) { nM = M / BM; nN = N / BM; nwg = nM * nN; G = G_; c = c_; }
    __host__ __device__ bool next(int i, Unit& u) const {
        const long L = (long)i * G + c; if (L >= nwg) return false;
        int wgid = (int)L; { const int q = nwg / NXCD, r = nwg % NXCD, xcd = wgid % NXCD, off = wgid / NXCD; wgid = (xcd < r ? xcd * (q + 1) : r * (q + 1) + (xcd - r) * q) + off; }
        const int nig = WGM * nN, gid = wgid / nig, fm = gid * WGM, gsz = (nM - fm) < WGM ? (nM - fm) : WGM;
        u.pm = fm + ((wgid % nig) % gsz); u.pn = (wgid % nig) / gsz; return true;
    }
    __device__ __forceinline__ void a_ready(const Unit&) const {}
    __device__ __forceinline__ void done(const Unit&) const {}
};
__device__ __forceinline__ unsigned cvt_pk_bf16(float lo, float hi) { unsigned r; asm volatile("v_cvt_pk_bf16_f32 %0, %1, %2" : "=v"(r) : "v"(lo), "v"(hi)); return r; }
typedef float f32x2 __attribute__((ext_vector_type(2)));
typedef unsigned u32x2 __attribute__((ext_vector_type(2)));
typedef float f32x2e __attribute__((ext_vector_type(2))); typedef __bf16 bf16x2e __attribute__((ext_vector_type(2)));
__device__ __forceinline__ unsigned pkbf(float lo, float hi) { f32x2e v = {lo, hi}; bf16x2e b = __builtin_convertvector(v, bf16x2e); return __builtin_bit_cast(unsigned, b); }
__device__ __forceinline__ float xsum16(float s) { const unsigned b = __float_as_uint(s); auto r = __builtin_amdgcn_permlane16_swap(b, b, false, false); return __uint_as_float(r[0]) + __uint_as_float(r[1]); }
__device__ __forceinline__ float xsum32(float s) { const unsigned b = __float_as_uint(s); auto r = __builtin_amdgcn_permlane32_swap(b, b, false, false); return __uint_as_float(r[0]) + __uint_as_float(r[1]); }
__device__ __forceinline__ void rstd8(const float* ssq, int row00, int fq, float (&rr)[2][4]) {
    f32x4 sv[2][4];
#pragma unroll
    for (int ai = 0; ai < 2; ++ai)
#pragma unroll
        for (int m = 0; m < 4; ++m) sv[ai][m] = *(const f32x4*)(ssq + (size_t)(row00 + ai * HALF + m * 16) * 16 + fq * 4);
    float s[2][4];
#pragma unroll
    for (int ai = 0; ai < 2; ++ai)
#pragma unroll
        for (int m = 0; m < 4; ++m) s[ai][m] = (sv[ai][m][0] + sv[ai][m][1]) + (sv[ai][m][2] + sv[ai][m][3]);
#pragma unroll
    for (int ai = 0; ai < 2; ++ai)
#pragma unroll
        for (int m = 0; m < 4; ++m) s[ai][m] = xsum16(s[ai][m]);
#pragma unroll
    for (int ai = 0; ai < 2; ++ai)
#pragma unroll
        for (int m = 0; m < 4; ++m) s[ai][m] = xsum32(s[ai][m]);
#pragma unroll
    for (int ai = 0; ai < 2; ++ai)
#pragma unroll
        for (int m = 0; m < 4; ++m) rr[ai][m] = __builtin_amdgcn_rsqf(s[ai][m] * (1.0f / 1024.0f) + 1e-6f);
}
constexpr int EMP = 65536;
constexpr size_t O_YP = 0, O_YS = 67108864, O_PSP = O_YS + 1048576, O_PSS = O_PSP + 245760, O_KP = O_PSS + 245760, O_VP = O_KP + 67108864,
                 O_LP = O_VP + 67108864, O_KS = O_LP + 1048576, O_VS = O_KS + 1048576, O_LS = O_VS + 1048576, O_END = O_LS + 16384;
__device__ __forceinline__ float rstd_from_ssq(const float* ssq, int row, int fq) {
    const f32x4 v = *(const f32x4*)(ssq + (size_t)row * 16 + fq * 4);
    float s = (v[0] + v[1]) + (v[2] + v[3]);
    s += __shfl_xor(s, 16); s += __shfl_xor(s, 32);
    return __builtin_amdgcn_rsqf(s * (1.0f / 1024.0f) + 1e-6f);
}
template <bool HAS_XB, bool SRC_BF16, bool WR_F32> struct EpiRes {
    static constexpr bool PERM = false, AFTER_DRAIN = false;
    const float* srcP; const float* srcS; float* dst; bf16_t* xb; float* ssq; const float* cscale;
    __device__ __forceinline__ void operator()(const f32x4 (&acc)[2][2][4][2], const Unit& u, int wr, int wc, int fr_in, int fq_in) const {
        int ln_ = threadIdx.x & 63; asm volatile("" : "+v"(ln_)); const int fr = ln_ & 15, fq = ln_ >> 4; (void)fr_in; (void)fq_in;
        const int col0 = u.pn * BM + wc * 32 + 4 * fq;
#pragma unroll
        for (int ai = 0; ai < 2; ++ai) {
            f32x4 res[4][2][2];
#pragma unroll
            for (int m = 0; m < 4; ++m) {
                const int row = u.pm * BM + ai * HALF + wr * 64 + m * 16 + fr;
#pragma unroll
                for (int bj = 0; bj < 2; ++bj)
#pragma unroll
                    for (int n = 0; n < 2; ++n) {
                        if (SRC_BF16) { const u32x2 rb = *(const u32x2*)(xb + (size_t)row * 1024 + col0 + bj * HALF + n * 16);
                            res[m][bj][n] = (f32x4){__uint_as_float(rb.x << 16), __uint_as_float(rb.x & 0xffff0000u), __uint_as_float(rb.y << 16), __uint_as_float(rb.y & 0xffff0000u)}; }
                        else { const float* src = (row < EMP ? srcP + (size_t)row * 1024 : srcS + (size_t)(row - EMP) * 1024) + col0; res[m][bj][n] = *(const f32x4*)(src + bj * HALF + n * 16); }
                    }
            }
            float ssv[4];
#pragma unroll
            for (int m = 0; m < 4; ++m) {
                const int row = u.pm * BM + ai * HALF + wr * 64 + m * 16 + fr;
                float* d = dst + (size_t)row * 1024 + col0;
                float ss = 0.f;
#pragma unroll
                for (int bj = 0; bj < 2; ++bj)
#pragma unroll
                    for (int n = 0; n < 2; ++n) {
                        const f32x4 x = res[m][bj][n] + acc[ai][bj][m][n];
                        if (WR_F32) *(f32x4*)(d + bj * HALF + n * 16) = x;
                        if (HAS_XB) { u32x2 w; w.x = pkbf(x[0], x[1]); w.y = pkbf(x[2], x[3]); *(u32x2*)(xb + (size_t)row * 1024 + col0 + bj * HALF + n * 16) = w;
                            ss += (x[0] * x[0] + x[1] * x[1]) + (x[2] * x[2] + x[3] * x[3]); }
                    }
                ssv[m] = ss;
            }
            if (HAS_XB) {
#pragma unroll
                for (int m = 0; m < 4; ++m) ssv[m] = xsum16(ssv[m]);
#pragma unroll
                for (int m = 0; m < 4; ++m) ssv[m] = xsum32(ssv[m]);
#pragma unroll
                for (int m = 0; m < 4; ++m) if (fq == 0) ssq[(size_t)(u.pm * BM + ai * HALF + wr * 64 + m * 16 + fr) * 16 + u.pn * 4 + wc] = ssv[m];
            }
        }
    }
};
struct EpiGU {
    static constexpr bool PERM = true, AFTER_DRAIN = false;
    const float* ssq; bf16_t* act;
    __device__ __forceinline__ void operator()(const f32x4 (&acc)[2][2][4][2], const Unit& u, int wr, int wc, int fr_in, int fq_in) const {
        int ln_ = threadIdx.x & 63; asm volatile("" : "+v"(ln_)); const int fr = ln_ & 15, fq = ln_ >> 4; (void)fr_in; (void)fq_in;
        const int col = u.pn * 128 + wc * 32 + 8 * fq;
        float rr[2][4]; rstd8(ssq, u.pm * BM + wr * 64 + fr, fq, rr);
#pragma unroll
        for (int ai = 0; ai < 2; ++ai)
#pragma unroll
            for (int m = 0; m < 4; ++m) {
                const int row = u.pm * BM + ai * HALF + wr * 64 + m * 16 + fr;
                const float r = rr[ai][m];
                u32x4 w;
#pragma unroll
                for (int n = 0; n < 2; ++n) {
                    const f32x4 g = acc[ai][0][m][n] * r, up = acc[ai][1][m][n] * r; float hh[4];
#pragma unroll
                    for (int e = 0; e < 4; ++e) hh[e] = g[e] * __builtin_amdgcn_rcpf(1.0f + __builtin_amdgcn_exp2f(-1.4426950408889634f * g[e])) * up[e];
                    w[2 * n] = pkbf(hh[0], hh[1]); w[2 * n + 1] = pkbf(hh[2], hh[3]);
                }
                *(u32x4*)(act + (size_t)row * 2816 + col) = w;
            }
    }
};
struct EpiKVQ {
    static constexpr bool PERM = true, AFTER_DRAIN = false;
    const float* ssq; const float* gn; const float* bfp; float* out; bf16_t* kvq; size_t kvq_stride;
    __device__ __forceinline__ void operator()(const f32x4 (&acc)[2][2][4][2], const Unit& u, int wr, int wc, int fr_in, int fq_in) const {
        int ln_ = threadIdx.x & 63; asm volatile("" : "+v"(ln_)); const int fr = ln_ & 15, fq = ln_ >> 4; (void)fr_in; (void)fq_in;
        const int t = u.pn >> 2, j = u.pn & 3;
        if (t == 3) {
            if (wc != 0) return;
            const int h0 = 8 * (fq & 1);
            const f32x4 b0 = *(const f32x4*)(bfp + h0), b1 = *(const f32x4*)(bfp + h0 + 4);
            float rrf[2][4]; rstd8(ssq, u.pm * BM + wr * 64 + fr, fq, rrf);
#pragma unroll
            for (int ai = 0; ai < 2; ++ai)
#pragma unroll
                for (int m = 0; m < 4; ++m) {
                    const int row = u.pm * BM + ai * HALF + wr * 64 + m * 16 + fr;
                    const float r = rrf[ai][m];
                    if (fq < 2) {
                        float* o = (row < EMP ? out + O_LP + (size_t)row * 16 : out + O_LS + (size_t)(row - EMP) * 16) + h0;
#pragma unroll
                        for (int n = 0; n < 2; ++n) { const f32x4 z = acc[ai][0][m][n] * r + (n == 0 ? b0 : b1); f32x4 lf;
#pragma unroll
                            for (int e = 0; e < 4; ++e) lf[e] = fminf(z[e], 0.f) - 0.6931471805599453f * __builtin_amdgcn_logf(1.0f + __builtin_amdgcn_exp2f(-1.4426950408889634f * fabsf(z[e])));
                            *(f32x4*)(o + 4 * n) = lf; }
                    }
                }
            return;
        }
        f32x4 gain[2][2];
#pragma unroll
        for (int bj = 0; bj < 2; ++bj)
#pragma unroll
            for (int n = 0; n < 2; ++n) gain[bj][n] = *(const f32x4*)(gn + 64 * t + 32 * bj + 8 * fq + 4 * n);
        const int cl = 256 * j + 64 * wc + 8 * fq;
        bf16_t* const ob0 = kvq + (size_t)t * kvq_stride;
        float rr[2][4]; rstd8(ssq, u.pm * BM + wr * 64 + fr, fq, rr);
        float rn8[2][4];
        if (t != 1) {
#pragma unroll
            for (int ai = 0; ai < 2; ++ai)
#pragma unroll
                for (int m = 0; m < 4; ++m) { float ss = 0.f;
#pragma unroll
                    for (int bj = 0; bj < 2; ++bj)
#pragma unroll
                        for (int n = 0; n < 2; ++n) { const f32x4 x = acc[ai][bj][m][n]; ss += (x[0] * x[0] + x[1] * x[1]) + (x[2] * x[2] + x[3] * x[3]); }
                    rn8[ai][m] = ss * rr[ai][m] * rr[ai][m]; }
#pragma unroll
            for (int ai = 0; ai < 2; ++ai)
#pragma unroll
                for (int m = 0; m < 4; ++m) rn8[ai][m] = xsum16(rn8[ai][m]);
#pragma unroll
            for (int ai = 0; ai < 2; ++ai)
#pragma unroll
                for (int m = 0; m < 4; ++m) rn8[ai][m] = __builtin_amdgcn_rsqf(xsum32(rn8[ai][m]) * (1.0f / 64.0f) + 1e-6f);
        }
#pragma unroll
        for (int ai = 0; ai < 2; ++ai)
#pragma unroll
            for (int m = 0; m < 4; ++m) {
                const int row = u.pm * BM + ai * HALF + wr * 64 + m * 16 + fr;
                const float r = rr[ai][m];
                f32x4 v[2][2];
#pragma unroll
                for (int bj = 0; bj < 2; ++bj)
#pragma unroll
                    for (int n = 0; n < 2; ++n) v[bj][n] = acc[ai][bj][m][n] * r;
                if (t != 1) { const float rn = rn8[ai][m];
#pragma unroll
                    for (int bj = 0; bj < 2; ++bj)
#pragma unroll
                        for (int n = 0; n < 2; ++n) v[bj][n] = v[bj][n] * rn * gain[bj][n]; }
                if (t < 2) { float* o = (row < EMP ? out + (t == 0 ? O_KP : O_VP) + (size_t)row * 1024 : out + (t == 0 ? O_KS : O_VS) + (size_t)(row - EMP) * 1024) + cl;
#pragma unroll
                    for (int bj = 0; bj < 2; ++bj) { *(f32x4*)(o + 32 * bj) = v[bj][0]; *(f32x4*)(o + 32 * bj + 4) = v[bj][1]; } }
                bf16_t* ob = ob0 + (size_t)row * 1024 + cl;
#pragma unroll
                for (int bj = 0; bj < 2; ++bj) { u32x4 w; w.x = pkbf(v[bj][0][0], v[bj][0][1]); w.y = pkbf(v[bj][0][2], v[bj][0][3]); w.z = pkbf(v[bj][1][0], v[bj][1][1]); w.w = pkbf(v[bj][1][2], v[bj][1][3]);
                    *(u32x4*)(ob + 32 * bj) = w; }
            }
    }
};

struct RangeOrder {
    StaticOrder b; int i0, i1; int xc, xi;
    __device__ __forceinline__ bool next(int i, Unit& u) const {
        if (i0 + i < i1) return b.next(i0 + i, u);
        if (xc >= 0 && i0 + i == i1) { StaticOrder b2 = b; b2.c = xc; return b2.next(xi, u); }
        return false; }
    __device__ __forceinline__ void a_ready(const Unit&) const {}
    __device__ __forceinline__ void done(const Unit&) const {}
};
struct OneUnit {
    int pm, pn;
    __device__ __forceinline__ bool next(int i, Unit& u) const { if (i != 0) return false; u.pm = pm; u.pn = pn; return true; }
    __device__ __forceinline__ void a_ready(const Unit&) const {}
    __device__ __forceinline__ void done(const Unit&) const {}
};
template <class Epi, class Sched, bool ALIGN_EPI = false, bool SP2 = false>
__device__ __forceinline__ void gemm_phase(PG8_LAS unsigned char* lds, const Gemm g, const Sched& S, const Epi& E) {
    int tid_o = threadIdx.x; asm volatile("" : "+v"(tid_o)); const int tid = tid_o, wid = __builtin_amdgcn_readfirstlane(tid >> 6), lane = tid & 63, wr = wid >> 2, wc = wid & 3, fr = lane & 15, fq = lane >> 4;
    const int K = g.K, nt = K / BK;
    unsigned voffA[2], voffB[2];
#pragma unroll
    for (int i = 0; i < 2; ++i) { int R, C; stage_rc(tid * 16 + i * 8192, R, C); const int Rb = Epi::PERM ? ((R & ~31) + perm32(R & 31)) : R;
        voffA[i] = (unsigned)(R * g.lda + C) * 2u; voffB[i] = (unsigned)(Rb * K + C) * 2u; }
    const size_t kstep = (size_t)(BK * 2);
    const size_t hstepB = (size_t)HALF * K * 2, hstepA = (size_t)HALF * g.lda * 2;
    const size_t tstepB = 2 * hstepB, tstepA = 2 * hstepA;
    const unsigned ldsw = (unsigned)wid * 1024u;
    const int aoff = lds_byte(wr * 64 + fr, fq * 8), boff = lds_byte(wc * 32 + fr, fq * 8);
#define PG8_SA(b, h) (((b) * 2 + (h)) * HTB)
#define PG8_SB(b, h) ((4 + (b) * 2 + (h)) * HTB)
#define PG8_STAGE(bufoff, gbase, voff) do { _Pragma("unroll") for (int _i = 0; _i < 2; ++_i) \
        __builtin_amdgcn_global_load_lds((const unsigned*)((const char*)(gbase) + (voff)[_i]), (PG8_LAS unsigned*)(lds + (bufoff) + ldsw + _i * 8192), 16, 0, 0); } while (0)
#define PG8_LDA(dst, b, h) do { _Pragma("unroll") for (int m = 0; m < 4; ++m) _Pragma("unroll") for (int k = 0; k < 2; ++k) dst[m][k] = *(const PG8_LAS bf16x8*)(lds + PG8_SA(b, h) + aoff + m * 2048 + k * 1024); } while (0)
#define PG8_LDB(dst, b, h) do { _Pragma("unroll") for (int n = 0; n < 2; ++n) _Pragma("unroll") for (int k = 0; k < 2; ++k) dst[n][k] = *(const PG8_LAS bf16x8*)(lds + PG8_SB(b, h) + boff + n * 2048 + k * 1024); } while (0)
#define PG8_MMA(ai, bj, At, Bt) do { __builtin_amdgcn_s_setprio(1); _Pragma("unroll") for (int m = 0; m < 4; ++m) _Pragma("unroll") for (int n = 0; n < 2; ++n) _Pragma("unroll") for (int k = 0; k < 2; ++k) \
        acc[ai][bj][m][n] = __builtin_amdgcn_mfma_f32_16x16x32_bf16(Bt[n][k], At[m][k], acc[ai][bj][m][n], 0, 0, 0); __builtin_amdgcn_s_setprio(0); } while (0)
#define PG8_WAIT_V(n) asm volatile("s_waitcnt vmcnt(" #n ")" ::: "memory")
#define PG8_WAIT_L(n) asm volatile("s_waitcnt lgkmcnt(" #n ")" ::: "memory")
#define PG8_BAR __builtin_amdgcn_s_barrier()
#define PG8_SCHED __builtin_amdgcn_sched_barrier(0)
    Unit cur, nxt; int ui = 0;
    if (!S.next(0, cur)) return;
    f32x4 acc[2][2][4][2];
#pragma unroll
    for (int a = 0; a < 2; ++a)
#pragma unroll
        for (int b = 0; b < 2; ++b)
#pragma unroll
            for (int m = 0; m < 4; ++m)
#pragma unroll
                for (int n = 0; n < 2; ++n) acc[a][b][m][n] = (f32x4){0.f, 0.f, 0.f, 0.f};
    bf16x8 At[4][2], B0[2][2], B1[2][2];
    const char* cA = (const char*)g.A + (size_t)cur.pm * tstepA + (size_t)cur.pn * g.acol_pn * 2; const char* cB = (const char*)g.Bt + (size_t)cur.pn * tstepB;
    S.a_ready(cur);
    if constexpr (SP2) {
        PG8_STAGE(PG8_SB(0, 0), cB, voffB); PG8_STAGE(PG8_SB(0, 1), cB + hstepB, voffB); PG8_STAGE(PG8_SA(0, 0), cA, voffA); PG8_STAGE(PG8_SA(0, 1), cA + hstepA, voffA);
        if (wr == 1) PG8_BAR;
        PG8_WAIT_V(2); PG8_BAR;
        PG8_STAGE(PG8_SB(1, 0), cB + kstep, voffB); PG8_STAGE(PG8_SA(1, 0), cA + kstep, voffA); PG8_STAGE(PG8_SB(1, 1), cB + hstepB + kstep, voffB);
        PG8_WAIT_V(6); PG8_BAR;
    } else {
        PG8_STAGE(PG8_SB(0, 0), cB, voffB); PG8_STAGE(PG8_SA(0, 0), cA, voffA); PG8_STAGE(PG8_SB(0, 1), cB + hstepB, voffB); PG8_STAGE(PG8_SA(0, 1), cA + hstepA, voffA);
        if (wr == 1) PG8_BAR;
        PG8_WAIT_V(4); PG8_BAR;
        PG8_STAGE(PG8_SB(1, 0), cB + kstep, voffB); PG8_STAGE(PG8_SA(1, 0), cA + kstep, voffA); PG8_STAGE(PG8_SB(1, 1), cB + hstepB + kstep, voffB);
        PG8_WAIT_V(6); PG8_BAR;
    }
    for (;;) {
        const bool has_next = S.next(ui + 1, nxt);
        const char* nA = has_next ? (const char*)g.A + (size_t)nxt.pm * tstepA + (size_t)nxt.pn * g.acol_pn * 2 : cA; const char* nB = has_next ? (const char*)g.Bt + (size_t)nxt.pn * tstepB : cB;
        for (int t = 0; t < nt; t += 2) {
            const bool last = (t == nt - 2);
            const char* a1 = cA + (size_t)(t + 1) * kstep;
            const char* a2 = last ? nA : cA + (size_t)(t + 2) * kstep; const char* b2 = last ? nB : cB + (size_t)(t + 2) * kstep;
            const char* a3 = a2 + kstep; const char* b3 = b2 + kstep;
            if (last && has_next) S.a_ready(nxt);
            if constexpr (SP2) {
            PG8_LDB(B0, 0, 0); PG8_LDB(B1, 0, 1); PG8_SCHED; PG8_LDA(At, 0, 0); PG8_STAGE(PG8_SA(1, 1), a1 + hstepA, voffA);
            PG8_WAIT_V(8); PG8_WAIT_L(0); PG8_BAR; PG8_MMA(0, 0, At, B0); PG8_MMA(0, 1, At, B1); PG8_BAR; PG8_SCHED;
            PG8_LDA(At, 0, 1); PG8_STAGE(PG8_SB(0, 0), b2, voffB); PG8_STAGE(PG8_SB(0, 1), b2 + hstepB, voffB); PG8_STAGE(PG8_SA(0, 0), a2, voffA);
            PG8_WAIT_V(8); PG8_WAIT_L(0); PG8_BAR; PG8_MMA(1, 0, At, B0); PG8_MMA(1, 1, At, B1); PG8_BAR; PG8_SCHED;
            PG8_LDB(B0, 1, 0); PG8_LDB(B1, 1, 1); PG8_SCHED; PG8_LDA(At, 1, 0); PG8_STAGE(PG8_SA(0, 1), a2 + hstepA, voffA);
            PG8_WAIT_V(8); PG8_WAIT_L(0); PG8_BAR; PG8_MMA(0, 0, At, B0); PG8_MMA(0, 1, At, B1); PG8_BAR; PG8_SCHED;
            PG8_LDA(At, 1, 1); PG8_STAGE(PG8_SB(1, 0), b3, voffB); PG8_STAGE(PG8_SB(1, 1), b3 + hstepB, voffB); PG8_STAGE(PG8_SA(1, 0), a3, voffA);
            PG8_WAIT_V(8); PG8_WAIT_L(0); PG8_BAR; PG8_MMA(1, 0, At, B0); PG8_MMA(1, 1, At, B1); PG8_BAR; PG8_SCHED;
            } else {
            PG8_LDB(B0, 0, 0); PG8_SCHED; PG8_LDA(At, 0, 0); PG8_STAGE(PG8_SA(1, 1), a1 + hstepA, voffA);
            PG8_WAIT_L(8); PG8_BAR; PG8_WAIT_L(0); PG8_MMA(0, 0, At, B0); PG8_BAR; PG8_SCHED;
            PG8_LDB(B1, 0, 1); PG8_STAGE(PG8_SB(0, 0), b2, voffB);
            PG8_BAR; PG8_WAIT_L(0); PG8_MMA(0, 1, At, B1); PG8_BAR;
            PG8_LDA(At, 0, 1); PG8_STAGE(PG8_SA(0, 0), a2, voffA);
            PG8_BAR; PG8_WAIT_L(0); PG8_MMA(1, 0, At, B0); PG8_BAR; PG8_SCHED;
            PG8_STAGE(PG8_SB(0, 1), b2 + hstepB, voffB);
            PG8_WAIT_V(6); PG8_BAR; PG8_MMA(1, 1, At, B1); PG8_BAR;
            PG8_LDB(B0, 1, 0); PG8_SCHED; PG8_LDA(At, 1, 0); PG8_STAGE(PG8_SA(0, 1), a2 + hstepA, voffA);
            PG8_WAIT_L(8); PG8_BAR; PG8_WAIT_L(0); PG8_MMA(0, 0, At, B0); PG8_BAR; PG8_SCHED;
            PG8_LDB(B1, 1, 1); PG8_STAGE(PG8_SB(1, 0), b3, voffB);
            PG8_BAR; PG8_WAIT_L(0); PG8_MMA(0, 1, At, B1); PG8_BAR;
            PG8_LDA(At, 1, 1); PG8_STAGE(PG8_SA(1, 0), a3, voffA);
            PG8_BAR; PG8_WAIT_L(0); PG8_MMA(1, 0, At, B0); PG8_BAR; PG8_SCHED;
            PG8_STAGE(PG8_SB(1, 1), b3 + hstepB, voffB);
            PG8_WAIT_V(6); PG8_BAR; PG8_MMA(1, 1, At, B1); PG8_BAR;
            }
        }
        if constexpr (ALIGN_EPI) { if (wr == 0) PG8_BAR; }
        if constexpr (!Epi::AFTER_DRAIN) { E(acc, cur, wr, wc, fr, fq); S.done(cur); }
        if (!has_next) break;
#pragma unroll
        for (int a = 0; a < 2; ++a)
#pragma unroll
            for (int b = 0; b < 2; ++b)
#pragma unroll
                for (int m = 0; m < 4; ++m)
#pragma unroll
                    for (int n = 0; n < 2; ++n) acc[a][b][m][n] = (f32x4){0.f, 0.f, 0.f, 0.f};
        cur = nxt; cA = nA; cB = nB; ++ui;
        if constexpr (ALIGN_EPI) { if (wr == 1) PG8_BAR; }
    }
    PG8_WAIT_V(0);
    if constexpr (!ALIGN_EPI) { if (wr == 0) PG8_BAR; }
    PG8_BAR;
    if constexpr (Epi::AFTER_DRAIN) { E.fused(acc, cur, wr, wc, fr, fq, lds, wid, lane); S.done(cur); }
#undef PG8_SA
#undef PG8_SB
#undef PG8_STAGE
#undef PG8_LDA
#undef PG8_LDB
#undef PG8_MMA
#undef PG8_WAIT_V
#undef PG8_WAIT_L
#undef PG8_BAR
#undef PG8_SCHED
}
}

#include <hip/hip_bf16.h>
#include <cmath>
namespace attn_body {
using bf16=__hip_bfloat16;
using bf16x8=__attribute__((ext_vector_type(8)))short;
using s16x4=__attribute__((ext_vector_type(4)))short;
using f32x16=__attribute__((ext_vector_type(16)))float;
using u32x4=__attribute__((ext_vector_type(4)))unsigned;
using f32x4a=__attribute__((ext_vector_type(4)))float;
typedef __attribute__((address_space(3))) const float* lds_cfptr;
typedef __attribute__((address_space(3))) const f32x4a* lds_cf4ptr;
constexpr int BATCH=16,NHEAD=16,SEQ=4096,D=64,DM=NHEAD*D;
constexpr int NW=8,QBLK=32,QB=QBLK*NW,KVBLK=64,NQB=SEQ/QB;
constexpr int ATTN_PITCH=DM, ATTN_UNIT_ROWS=QB;
__device__ __forceinline__ int crow(int r,int hi){return (r&3)+8*(r>>2)+4*hi;}
#define SBAR() __builtin_amdgcn_sched_barrier(0)
__device__ __forceinline__ void cmask(f32x16&p0,f32x16&p1,int jb,int qrel,int hi){
  const float NEG=-INFINITY; int kb=64*jb+4*hi;
  #pragma unroll
  for(int r=0;r<16;++r){int kv=kb+(r&3)+8*(r>>2); if(kv>qrel)p0[r]=NEG; if(kv+32>qrel)p1[r]=NEG;}
}

constexpr int NSLOT=3, SLOTB=8192;
constexpr int LDS_K=0, LDS_V=NSLOT*SLOTB, LDS_WS=2*NSLOT*SLOTB, LDS_OST=LDS_WS+NW*64*4, LDS_BYTES=LDS_OST+NW*4096;
constexpr float C2=0.125f*1.4426950408889634f;
__device__ __forceinline__ void glds16(const void*gsrc,unsigned lds_dst){unsigned keep;
  asm volatile("s_mov_b32 %0, m0\n\ts_mov_b32 m0, %2\n\ts_nop 0\n\tglobal_load_lds_dwordx4 %1, off\n\ts_mov_b32 m0, %0":"=&s"(keep):"v"(gsrc),"s"(lds_dst):"memory");}
__device__ __forceinline__ float max3f(float a,float b,float c){float r;asm("v_max3_f32 %0, %1, %2, %3":"=v"(r):"v"(a),"v"(b),"v"(c));return r;}
__device__ __forceinline__ float max2f(float a,float b){float r;asm("v_max_f32_e32 %0, %1, %2":"=v"(r):"v"(a),"v"(b));return r;}
__device__ __forceinline__ float fadd_s(float a,float b){float r;asm("v_add_f32_e32 %0, %1, %2":"=v"(r):"v"(a),"v"(b));return r;}
__device__ __forceinline__ float fsub_s(float a,float b){float r;asm("v_sub_f32_e32 %0, %1, %2":"=v"(r):"v"(a),"v"(b));return r;}
typedef float f32x2_t __attribute__((ext_vector_type(2))); typedef __bf16 bf16x2_t __attribute__((ext_vector_type(2)));
__device__ __forceinline__ unsigned cvtpk_s(float lo,float hi){f32x2_t v={lo,hi};bf16x2_t b=__builtin_convertvector(v,bf16x2_t);return __builtin_bit_cast(unsigned,b);}
#define WAIT_BAR(N) asm volatile("s_waitcnt vmcnt(" #N ") lgkmcnt(0)\n\ts_barrier":::"memory")

__device__ __forceinline__ void qkt(f32x16&p0,f32x16&p1,const char*Kslot,const bf16x8*qr,int r32,int hi){
  const char*kb=Kslot+hi*1024+r32*16;
  #pragma unroll
  for(int d0=0;d0<4;++d0){
    const bf16x8 b0=*reinterpret_cast<const bf16x8*>(kb+d0*2048);
    const bf16x8 b1=*reinterpret_cast<const bf16x8*>(kb+d0*2048+512);
    {p0=__builtin_amdgcn_mfma_f32_32x32x16_bf16(b0,qr[d0],p0,0,0,0);p1=__builtin_amdgcn_mfma_f32_32x32x16_bf16(b1,qr[d0],p1,0,0,0);}}
}
typedef __attribute__((address_space(3))) const char* lds_cptr;
typedef short v4i16_t __attribute__((ext_vector_type(4)));
__device__ __forceinline__ void kload8(bf16x8*kf,lds_cptr kp){
  kf[0]=*(const __attribute__((address_space(3))) bf16x8*)(kp);      kf[1]=*(const __attribute__((address_space(3))) bf16x8*)(kp+512);
  kf[2]=*(const __attribute__((address_space(3))) bf16x8*)(kp+2048); kf[3]=*(const __attribute__((address_space(3))) bf16x8*)(kp+2560);
  kf[4]=*(const __attribute__((address_space(3))) bf16x8*)(kp+4096); kf[5]=*(const __attribute__((address_space(3))) bf16x8*)(kp+4608);
  kf[6]=*(const __attribute__((address_space(3))) bf16x8*)(kp+6144); kf[7]=*(const __attribute__((address_space(3))) bf16x8*)(kp+6656);
}
__device__ __forceinline__ void kload2(bf16x8*kf,lds_cptr kp,int j){ kf[2*j]=*(const __attribute__((address_space(3))) bf16x8*)(kp+j*2048); kf[2*j+1]=*(const __attribute__((address_space(3))) bf16x8*)(kp+j*2048+512); }
__device__ __forceinline__ s16x4 vtr(lds_cptr p){ return __builtin_bit_cast(s16x4,__builtin_amdgcn_ds_read_tr16_b64_v4i16((__attribute__((address_space(3))) v4i16_t*)p)); }
__device__ __forceinline__ float rowmax(const f32x16&p0,const f32x16&p1){
  float a=max3f(p0[0],p0[1],p1[0]),b=max3f(p0[2],p0[3],p1[1]);a=max3f(a,p1[2],p1[3]);
  #pragma unroll
  for(int r=4;r<16;r+=4){a=max3f(a,p0[r],p0[r+1]);b=max3f(b,p0[r+2],p0[r+3]);a=max3f(a,p1[r],p1[r+1]);b=max3f(b,p1[r+2],p1[r+3]);}
  const float m=max2f(a,b);
  auto rr=__builtin_amdgcn_permlane32_swap(__float_as_uint(m),__float_as_uint(m),false,false);
  return max2f(__uint_as_float(rr[0]),__uint_as_float(rr[1]));
}
__device__ __forceinline__ void pv(f32x16*o,int vb,bf16x8 pa0,bf16x8 pa1,bf16x8 pa2,bf16x8 pa3){
  #pragma unroll
  for(int d0=0;d0<2;++d0){s16x4 lo[4],hi[4];
    #pragma unroll
    for(int ks=0;ks<4;++ks){
      asm volatile("ds_read_b64_tr_b16 %0,%1 offset:%c2":"=&v"(lo[ks]):"v"(vb),"i"(d0*4096+ks*1024):"memory");
      asm volatile("ds_read_b64_tr_b16 %0,%1 offset:%c2":"=&v"(hi[ks]):"v"(vb),"i"(d0*4096+ks*1024+512):"memory");}
    asm volatile("s_waitcnt lgkmcnt(0)":::"memory");SBAR();
    #define PK(k) (bf16x8){lo[k][0],lo[k][1],lo[k][2],lo[k][3],hi[k][0],hi[k][1],hi[k][2],hi[k][3]}
    o[d0]=__builtin_amdgcn_mfma_f32_32x32x16_bf16(pa0,PK(0),o[d0],0,0,0);
    o[d0]=__builtin_amdgcn_mfma_f32_32x32x16_bf16(pa1,PK(1),o[d0],0,0,0);
    o[d0]=__builtin_amdgcn_mfma_f32_32x32x16_bf16(pa2,PK(2),o[d0],0,0,0);
    o[d0]=__builtin_amdgcn_mfma_f32_32x32x16_bf16(pa3,PK(3),o[d0],0,0,0);
    #undef PK
  }
}

#ifndef ATTN_STORE16
#define ATTN_STORE16(p,v) (*(u32x4*)(p)=(v))
#endif
template<int THRL> __device__ __forceinline__ void attn_unit(int b,int h,int qb,const bf16*Q,const bf16*__restrict__ K,const bf16*__restrict__ V,bf16*O,char*shm,lds_cfptr dkl,float lowc,int t0,int t0n,bool pref,bf16x8(&qr)[4]){
  int tid_o=threadIdx.x; asm volatile("":"+v"(tid_o)); const int tid=tid_o,lane=tid&63,r32=lane&31,hi=lane>>5; const int wid=__builtin_amdgcn_readfirstlane(tid>>6);
  const long rowbase=(long)b*SEQ; const int q0=qb*QB;
  const bf16*Qw=Q+(rowbase+q0+wid*QBLK)*DM+h*D;
  const bf16*Kh=K+(rowbase+(long)t0*KVBLK)*DM+h*D,*Vh=V+(rowbase+(long)t0*KVBLK)*DM+h*D;
  const unsigned lds0=(unsigned)(uintptr_t)shm;
  float*wsf=(float*)(shm+LDS_WS)+wid*64;
  const bf16*ksrc=Kh+(long)lane*DM+wid*8;
  const bf16*vsrc=Vh+(long)(16*(wid&3)+(lane>>2))*DM+(wid>>2)*32+(lane&3)*8;
  const unsigned kdst=lds0+LDS_K+wid*1024, vdst=lds0+LDS_V+wid*1024;
  #define DMA_K(t,slot) glds16(ksrc+(long)(t)*KVBLK*DM,(unsigned)__builtin_amdgcn_readfirstlane(kdst+(slot)))
  #define DMA_V(t,slot) glds16(vsrc+(long)(t)*KVBLK*DM,(unsigned)__builtin_amdgcn_readfirstlane(vdst+(slot)))
  const int vb0=(int)(lds0+LDS_V)+((lane>>4)&1)*32+(lane&3)*8+(4*hi+((lane&15)>>2))*64;
  const char*Kbase=shm+LDS_K; bf16x8 kf[8];
  const lds_cptr shm3=(lds_cptr)shm; const lds_cptr kp0=shm3+LDS_K+hi*1024+r32*16; const lds_cptr vp0=shm3+LDS_V+((lane>>4)&1)*32+(lane&3)*8+(4*hi+((lane&15)>>2))*64;
  const int NT=(q0+QB)/KVBLK-t0;
  if(!pref){DMA_K(0,0);DMA_V(0,0);DMA_K(1,SLOTB);}else{DMA_V(0,0);}
  (void)Qw;
  const float dq2=dkl[q0+wid*QBLK+r32]; const lds_cf4ptr dk4=(lds_cf4ptr)dkl+16*t0;
  float mhat=-dq2,l_reg=0.f;f32x16 o[2];o[0]=f32x16{};o[1]=f32x16{};
  #define BINIT(P0,P1,t,NM) do{ const lds_cf4ptr d4_=dk4+16*(t)+hi; _Pragma("unroll") for(int j_=0;j_<4;++j_){ const f32x4a a_=d4_[2*j_], b_=d4_[8+2*j_]; _Pragma("unroll") for(int i_=0;i_<4;++i_){P0[4*j_+i_]=(NM)-a_[i_];P1[4*j_+i_]=(NM)-b_[i_];} } }while(0)
  #define BLOAD(P0,P1,t) do{ const lds_cf4ptr d4_=dk4+16*(t)+hi; _Pragma("unroll") for(int j_=0;j_<4;++j_){ const f32x4a a_=d4_[2*j_], b_=d4_[8+2*j_]; _Pragma("unroll") for(int i_=0;i_<4;++i_){P0[4*j_+i_]=a_[i_];P1[4*j_+i_]=b_[i_];} } }while(0)
  const int qrel=wid*QBLK+r32;
  #define CMASK(P0,P1,t) do{int jb_=(t)-(NT-4); if(jb_>=0)cmask(P0,P1,jb_,qrel,hi);}while(0)
  bool resc=false;
  #define START(P0,P1) do{ const float rm=rowmax(P0,P1); resc=false; \
    { const float dl=rm; mhat=fadd_s(mhat,dl); \
      _Pragma("unroll") for(int r=0;r<16;++r){P0[r]=fsub_s(P0[r],dl);P1[r]=fsub_s(P1[r],dl);} \
      } \
    _Pragma("unroll") for(int r=0;r<16;++r)P0[r]=__builtin_amdgcn_exp2f(P0[r]); }while(0)
  #define RESC() do{ if(resc){ asm volatile("s_waitcnt lgkmcnt(0)":::"memory"); \
      _Pragma("unroll") for(int d_=0;d_<2;++d_) _Pragma("unroll") for(int r=0;r<16;++r)o[d_][r]*=wsf[crow(r,hi)]; } }while(0)
  f32x16 pA0,pA1,pB0,pB1;
  int sl_prev=0,sl_cur=0,sl_next=SLOTB;
  #define ROT() do{sl_prev=sl_cur;sl_cur=sl_next;sl_next=(sl_next==(NSLOT-1)*SLOTB)?0:sl_next+SLOTB;}while(0)
  if(!pref){DMA_K(2,2*SLOTB);WAIT_BAR(3);}else{WAIT_BAR(1);}
  BINIT(pA0,pA1,0,dq2);
  qkt(pA0,pA1,Kbase,qr,r32,hi);asm volatile("s_nop 15\n\ts_nop 7":"+v"(pA0),"+v"(pA1));CMASK(pA0,pA1,0);
  START(pA0,pA1);
  { const float nm0_=-mhat; BINIT(pB0,pB1,1,nm0_); }
  _Pragma("unroll") for(int r=0;r<16;++r)pA1[r]=__builtin_amdgcn_exp2f(pA1[r]);
  WAIT_BAR(0);
  DMA_K(3,0);DMA_V(1,SLOTB);
  ROT();
  kload8(kf,kp0+sl_cur);
  WAIT_BAR(2);
  s16x4 vlo[8],vhi[8]; u32x4 pw0,pw1,pw2,pw3;
  #define PKW(P,B) cvtpk_s(P[B],P[B+1])
  #define PAF(k) __builtin_bit_cast(bf16x8,pw##k)
  #define VFR(i) (bf16x8){vlo[i][0],vlo[i][1],vlo[i][2],vlo[i][3],vhi[i][0],vhi[i][1],vhi[i][2],vhi[i][3]}
  #define PIN(x) asm volatile("":"+v"(x))
  #define MX3(a,b,c) __builtin_fmaxf(__builtin_fmaxf((a),(b)),(c))
  #define GAPA(MF,A0,A1,A2,A3,W0,W1,PW) do{ MF; sacc+=A0; sacc+=A1; sacc+=A2; sacc+=A3; PIN(sacc); W0; W1; PIN(PW); SBAR(); }while(0)
  #define EX(v) __builtin_amdgcn_exp2f(v)
  #define GAPB(MF,X,B,G,PI) do{ MF; X[B]=EX(X[B]); X[B+1]=EX(X[B+1]); X[B+2]=EX(X[B+2]); X[B+3]=EX(X[B+3]); PIN(X); if(G){ PI[B]=nmh_-PI[B]; PI[B+1]=nmh_-PI[B+1]; PI[B+2]=nmh_-PI[B+2]; PI[B+3]=nmh_-PI[B+3]; PIN(PI); } SBAR(); }while(0)
  #define VRD(i) do{ vlo[i]=vtr(vp_+(((i)>>2)*4096+((i)&3)*1024)); vhi[i]=vtr(vp_+(((i)>>2)*4096+((i)&3)*1024+512)); }while(0)
  #define KRD(G,j) do{ if(G){ kload2(kf,kp0+sl_next,j); SBAR(); } }while(0)
  #define STEP(C0,C1,P0,P1,t,GK,GV,GL) do{ SBAR(); \
    const lds_cptr vp_=vp0+sl_prev; \
    VRD(0); SBAR(); float sacc=(P0[0]+P0[1]); \
    GAPA(C0=__builtin_amdgcn_mfma_f32_32x32x16_bf16(kf[0],qr[0],C0,0,0,0), P0[2],P0[3],P0[4],P0[5],     pw0[0]=PKW(P0,0), pw0[1]=PKW(P0,2), pw0); \
    VRD(4); SBAR(); GAPA(C1=__builtin_amdgcn_mfma_f32_32x32x16_bf16(kf[1],qr[0],C1,0,0,0), P0[6],P0[7],P0[8],P0[9],     pw0[2]=PKW(P0,4), pw0[3]=PKW(P0,6), pw0); \
    VRD(1); SBAR(); GAPA(C0=__builtin_amdgcn_mfma_f32_32x32x16_bf16(kf[2],qr[1],C0,0,0,0),   P0[10],P0[11],P0[12],P0[13], pw1[0]=PKW(P0,8), pw1[1]=PKW(P0,10), pw1); \
    VRD(5); SBAR(); GAPA(C1=__builtin_amdgcn_mfma_f32_32x32x16_bf16(kf[3],qr[1],C1,0,0,0),   P0[14],P0[15],P1[0],P1[1],   pw1[2]=PKW(P0,12),pw1[3]=PKW(P0,14), pw1); \
    VRD(2); SBAR(); GAPA(C0=__builtin_amdgcn_mfma_f32_32x32x16_bf16(kf[4],qr[2],C0,0,0,0),   P1[2],P1[3],P1[4],P1[5],     pw2[0]=PKW(P1,0), pw2[1]=PKW(P1,2), pw2); \
    VRD(6); SBAR(); GAPA(C1=__builtin_amdgcn_mfma_f32_32x32x16_bf16(kf[5],qr[2],C1,0,0,0),   P1[6],P1[7],P1[8],P1[9],     pw2[2]=PKW(P1,4), pw2[3]=PKW(P1,6), pw2); \
    VRD(3); SBAR(); GAPA(C0=__builtin_amdgcn_mfma_f32_32x32x16_bf16(kf[6],qr[3],C0,0,0,0),   P1[10],P1[11],P1[12],P1[13], pw3[0]=PKW(P1,8), pw3[1]=PKW(P1,10), pw3); \
    VRD(7); SBAR(); GAPA(C1=__builtin_amdgcn_mfma_f32_32x32x16_bf16(kf[7],qr[3],C1,0,0,0),   P1[14],P1[15],0.f,0.f,       pw3[2]=PKW(P1,12),pw3[3]=PKW(P1,14), pw3); \
    l_reg+=sacc; \
    if(GK){DMA_K((t)+3,sl_cur);} if(GV){DMA_V((t)+1,sl_next);} \
    CMASK(C0,C1,t); \
    { float a=MX3(C0[0],C0[1],C1[0]),b=MX3(C0[2],C0[3],C1[1]); a=MX3(a,C1[2],C1[3]); \
      _Pragma("unroll") for(int r=4;r<16;r+=4){a=MX3(a,C0[r],C0[r+1]);b=MX3(b,C0[r+2],C0[r+3]);a=MX3(a,C1[r],C1[r+1]);b=MX3(b,C1[r+2],C1[r+3]);} \
      float rm=__builtin_fmaxf(a,b); { auto rr=__builtin_amdgcn_permlane32_swap(__float_as_uint(rm),__float_as_uint(rm),false,false); rm=__builtin_fmaxf(__uint_as_float(rr[0]),__uint_as_float(rr[1])); } \
      resc=false; \
      if(__builtin_expect(__any(rm>(float)THRL),0)){ const float dl=__builtin_fmaxf(rm,0.f); mhat+=dl; \
        _Pragma("unroll") for(int r=0;r<16;++r){C0[r]-=dl;C1[r]-=dl;} \
        const float f=__builtin_amdgcn_exp2f(-dl); l_reg*=f; if(hi==0)wsf[r32]=f; resc=true; } } \
    const float nmh_=-mhat; if(GL){ BLOAD(P0,P1,(t)+1); } SBAR(); \
    GAPB(o[0]=__builtin_amdgcn_mfma_f32_32x32x16_bf16(PAF(0),VFR(0),o[0],0,0,0), C0,0,GL,P0); \
    GAPB(o[1]=__builtin_amdgcn_mfma_f32_32x32x16_bf16(PAF(0),VFR(4),o[1],0,0,0), C0,4,GL,P0); \
    KRD(GL,0); GAPB(o[0]=__builtin_amdgcn_mfma_f32_32x32x16_bf16(PAF(1),VFR(1),o[0],0,0,0), C0,8,GL,P0); \
    KRD(GL,1); GAPB(o[1]=__builtin_amdgcn_mfma_f32_32x32x16_bf16(PAF(1),VFR(5),o[1],0,0,0), C0,12,GL,P0); \
    KRD(GL,2); GAPB(o[0]=__builtin_amdgcn_mfma_f32_32x32x16_bf16(PAF(2),VFR(2),o[0],0,0,0), C1,0,GL,P1); \
    KRD(GL,3); GAPB(o[1]=__builtin_amdgcn_mfma_f32_32x32x16_bf16(PAF(2),VFR(6),o[1],0,0,0), C1,4,GL,P1); \
    GAPB(o[0]=__builtin_amdgcn_mfma_f32_32x32x16_bf16(PAF(3),VFR(3),o[0],0,0,0), C1,8,GL,P1); \
    GAPB(o[1]=__builtin_amdgcn_mfma_f32_32x32x16_bf16(PAF(3),VFR(7),o[1],0,0,0), C1,12,GL,P1); \
    }while(0)
  int t=1;
  #undef CMASK
  #define CMASK(P0,P1,t) do{}while(0)
  for(;t+5<NT;t+=2){
    STEP(pB0,pB1,pA0,pA1,t,true,true,true);     WAIT_BAR(2); RESC(); ROT();
    STEP(pA0,pA1,pB0,pB1,t+1,true,true,true);   WAIT_BAR(2); RESC(); ROT();
  }
  #undef CMASK
  #define CMASK(P0,P1,t) do{int jb_=(t)-(NT-4); if(jb_>=0)cmask(P0,P1,jb_,qrel,hi);}while(0)
  #define ENDW(tt) do{ if((tt)+3<NT){WAIT_BAR(2);} else if((tt)+2<NT){WAIT_BAR(1);} else {WAIT_BAR(0);} }while(0)
  for(;t+1<NT;t+=2){
    STEP(pB0,pB1,pA0,pA1,t,(t+3<NT),(t+1<NT),(t+1<NT));       ENDW(t);   RESC(); ROT();
    STEP(pA0,pA1,pB0,pB1,t+1,(t+4<NT),(t+2<NT),(t+2<NT));     ENDW(t+1); RESC(); ROT();
  }
  if(t0n>=0){
    const bf16*ksn=K+(rowbase+(long)t0n*KVBLK+lane)*DM+h*D+wid*8;
    glds16(ksn,(unsigned)__builtin_amdgcn_readfirstlane(kdst)); glds16(ksn+(long)KVBLK*DM,(unsigned)__builtin_amdgcn_readfirstlane(kdst+SLOTB)); glds16(ksn+2L*KVBLK*DM,(unsigned)__builtin_amdgcn_readfirstlane(kdst+2*SLOTB));
  }
  STEP(pB0,pB1,pA0,pA1,NT-1,false,false,false); RESC();
  if(t0n>=0){ const bf16*Qn=Q+(rowbase+q0-QB+wid*QBLK)*DM+h*D;
    _Pragma("unroll") for(int d0=0;d0<4;++d0)qr[d0]=*reinterpret_cast<const bf16x8*>(&Qn[(long)r32*DM+d0*16+hi*8]); }
  { float sacc=pB0[0]+pB0[1]; _Pragma("unroll") for(int r=2;r<16;++r)sacc+=pB0[r]; _Pragma("unroll") for(int r=0;r<16;++r)sacc+=pB1[r]; l_reg+=sacc;
    pw0=(u32x4){PKW(pB0,0),PKW(pB0,2),PKW(pB0,4),PKW(pB0,6)};pw1=(u32x4){PKW(pB0,8),PKW(pB0,10),PKW(pB0,12),PKW(pB0,14)};pw2=(u32x4){PKW(pB1,0),PKW(pB1,2),PKW(pB1,4),PKW(pB1,6)};pw3=(u32x4){PKW(pB1,8),PKW(pB1,10),PKW(pB1,12),PKW(pB1,14)};
    SBAR(); pv(o,vb0+sl_cur,PAF(0),PAF(1),PAF(2),PAF(3)); }
  #undef PKW
  #undef PAF
  #undef VFR
  #undef PIN
  #undef MX3
  #undef GAPA
  #undef GAPB
  #undef EX
  #undef VRD
  #undef KRD
  #undef STEP
  #undef ENDW
  {auto rr=__builtin_amdgcn_permlane32_swap(__float_as_uint(l_reg),__float_as_uint(l_reg),false,false);l_reg=__uint_as_float(rr[0])+__uint_as_float(rr[1]);}
  if(hi==0)wsf[32+r32]=l_reg;asm volatile("s_waitcnt lgkmcnt(0)":::"memory");
  float rli[16];
  #pragma unroll
  for(int r=0;r<16;++r)rli[r]=__builtin_amdgcn_rcpf(wsf[32+crow(r,hi)]);
  bf16*Ow=O+(rowbase+q0+wid*QBLK)*DM+h*D;
  { bf16*stg=(bf16*)(shm+LDS_OST)+wid*2048;
    #pragma unroll
    for(int r=0;r<16;++r){const int orow=crow(r,hi);
      #pragma unroll
      for(int d0=0;d0<2;++d0)stg[orow*64+d0*32+r32]=__float2bfloat16(o[d0][r]*rli[r]);}
    asm volatile("s_waitcnt lgkmcnt(0)":::"memory");
    #pragma unroll
    for(int i=0;i<4;++i){const int row=i*8+(lane>>3),ch=lane&7; const u32x4 v=*(const u32x4*)(stg+row*64+ch*8); ATTN_STORE16(Ow+(long)row*DM+ch*8,v);} }
  asm volatile("s_waitcnt lgkmcnt(0)\n\ts_barrier":::"memory");
  #undef BINIT
  #undef BLOAD
  #undef DMA_K
  #undef DMA_V
  #undef CMASK
  #undef START
  #undef RESC
  #undef ROT
}
constexpr int ATTN_LDS_BYTES=LDS_BYTES;
#undef SBAR
#undef WAIT_BAR
}

#define LAS __attribute__((address_space(3)))
typedef unsigned short bf16;
typedef unsigned v4u __attribute__((ext_vector_type(4)));
typedef unsigned v2u __attribute__((ext_vector_type(2)));
typedef float f32x4 __attribute__((ext_vector_type(4)));
typedef float f32x16 __attribute__((ext_vector_type(16)));
typedef short bf16x8 __attribute__((ext_vector_type(8)));

constexpr int MP = 65536, MS = 1024, MT = MP + MS, DMODEL = 1024, FF = 2816, SEQL = 4096, PAST = 1024, SSQ_ = 64, KVS = PAST + SSQ_;
constexpr float LOG2E = 1.4426950408889634f;
constexpr size_t MiB = 1u << 20;
constexpr size_t WS_WPOOL = 0, WS_WGU0 = 1 * MiB, WS_WGU1 = 12 * MiB, WS_WDN0 = 23 * MiB, WS_WDN1 = 29 * MiB, WS_WKVQ = 35 * MiB, WS_WO = 42 * MiB,
                 WS_RSTD = 44 * MiB, WS_SSQ = 45 * MiB, WS_DK2 = 50 * MiB, WS_DKS = 54 * MiB, WS_XB = 64 * MiB, WS_PB = 194 * MiB, WS_R1 = 324 * MiB,
                 WS_KB = WS_R1, WS_VB = WS_R1 + 130 * MiB, WS_QB = WS_R1 + 260 * MiB, WS_GN = 56 * MiB, WS_CTL = 57 * MiB, WS_KVQS = 58 * MiB, WS_END = WS_R1 + 390 * MiB;
constexpr int LDS_BYTES = 147456;
constexpr int DK_OFF = 86016;
static_assert(attn_body::ATTN_LDS_BYTES <= DK_OFF && DK_OFF + 16384 <= LDS_BYTES && pg8::STAGE_BYTES <= LDS_BYTES, "LDS map");

__device__ __forceinline__ float wave_sum(float v) {
#pragma unroll
    for (int o = 1; o < 64; o <<= 1) v += __shfl_xor(v, o);
    return v;
}
__device__ __forceinline__ float wave_max(float v) {
#pragma unroll
    for (int o = 1; o < 64; o <<= 1) v = fmaxf(v, __shfl_xor(v, o));
    return v;
}
__device__ __forceinline__ unsigned pk2(float lo, float hi) { return pg8::cvt_pk_bf16(lo, hi); }
__device__ __forceinline__ float bf2f(unsigned short b) { return __uint_as_float((unsigned)b << 16); }
__device__ __forceinline__ int crow(int r, int hi) { return (r & 3) + 8 * (r >> 2) + 4 * hi; }

struct RmOff { int off; __device__ __forceinline__ int operator()(int n) const { return off + n; } };
struct RmGU  { int up;  __device__ __forceinline__ int operator()(int n) const { return 256 * (n >> 7) + (n & 127) + up * 128; } };
struct RmKVQ { int base; __device__ __forceinline__ int operator()(int n) const { const int l = n & 255; return base + (n & ~255) + 128 * ((l >> 5) & 1) + 32 * (l >> 6) + (l & 31); } };

template <class RowMap> __device__ __forceinline__ void transpose_item(const float* W, int K, int N, bf16* WT, const RowMap rm, const float* kgain, const float* nscale, LAS float* scr, int item, int lane) {
    const int nblk = N / 32, kb = item / nblk, nb = item % nblk, k0 = 64 * kb, n0 = 32 * nb;
    const int n4 = (lane & 7) * 4, kr = lane >> 3;
    const f32x4 ns4 = nscale ? *(const f32x4*)(nscale + n0 + n4) : (f32x4){1.f, 1.f, 1.f, 1.f};
    f32x4 v[8];
#pragma unroll
    for (int i = 0; i < 8; ++i) v[i] = *(const f32x4*)(W + (size_t)(k0 + kr + 8 * i) * N + n0 + n4);
#pragma unroll
    for (int i = 0; i < 8; ++i) { const int kk = kr + 8 * i; f32x4 x = v[i] * ns4; if (kgain) x = x * kgain[k0 + kk];
#pragma unroll
        for (int e = 0; e < 4; ++e) scr[kk * 33 + n4 + e] = x[e]; }
    asm volatile("s_waitcnt lgkmcnt(0)" ::: "memory");
    const int c = lane & 7;
#pragma unroll
    for (int j = 0; j < 4; ++j) { const int n = (lane >> 3) + 8 * j; const LAS float* s = scr + (8 * c) * 33 + n;
        v4u o; o.x = pg8::pkbf(s[0 * 33], s[1 * 33]); o.y = pg8::pkbf(s[2 * 33], s[3 * 33]); o.z = pg8::pkbf(s[4 * 33], s[5 * 33]); o.w = pg8::pkbf(s[6 * 33], s[7 * 33]);
        *(v4u*)(WT + (size_t)rm(n0 + n) * K + k0 + 8 * c) = o; }
    asm volatile("s_waitcnt lgkmcnt(0)" ::: "memory");
}

#define XB_TMO      128
#define XB_XCNT(j)  (256  + 64 * (j))
#define XB_XSUB(j)  (1280 + 64 * (j))
#define XB_XGEN(j)  (2304 + 64 * (j))
#define XB_TOP      3328
#define XB_TOPGEN   3392
#define XCD_BAR_WORDS 3456
#define XB_SPIN_CAP (1u << 18)

__device__ __forceinline__ unsigned xb_ld(unsigned* p)              { return __hip_atomic_load(p, __ATOMIC_RELAXED, __HIP_MEMORY_SCOPE_AGENT); }
__device__ __forceinline__ unsigned xb_add(unsigned* p, unsigned v) { return __hip_atomic_fetch_add(p, v, __ATOMIC_RELAXED, __HIP_MEMORY_SCOPE_AGENT); }
__device__ __forceinline__ unsigned xb_xcc_id() { return (unsigned)__builtin_amdgcn_s_getreg((3 << 11) | 20) & 0xFu; }
#define XB_SPIN(cond, bar) do { unsigned _sp = 0; while (cond) { __builtin_amdgcn_s_sleep(1); \
    if ((++_sp & 255u) == 0u) { if (xb_ld(&(bar)[XB_TMO])) break; if (_sp > XB_SPIN_CAP) { atomicAdd(&(bar)[XB_TMO], 1u); break; } } } } while (0)

struct XcdBarrier {
    unsigned* bar; unsigned x;
    volatile LAS unsigned* st;
};

__device__ __forceinline__ XcdBarrier xcd_barrier_post(unsigned* bar, volatile LAS unsigned* st) {
    XcdBarrier b; b.bar = bar; b.x = xb_xcc_id(); b.st = st;
    if (threadIdx.x == 0) (void)xb_add(&bar[XB_XCNT(b.x)], 1u);
    return b;
}
__device__ __forceinline__ void xcd_barrier_complete(unsigned* bar, unsigned x, unsigned& nloc, unsigned& nx) {
    const unsigned G = gridDim.x * gridDim.y * gridDim.z;
    unsigned sum, cnt, mine, sp = 0u;
    for (;;) {
        sum = 0u; cnt = 0u; mine = 0u;
#pragma unroll
        for (unsigned j = 0; j < 16; ++j) { const unsigned c = xb_ld(&bar[XB_XCNT(j)]); sum += c; cnt += (c > 0u) ? 1u : 0u; mine = (j == x) ? c : mine; }
        if (sum == G) break;
        __builtin_amdgcn_s_sleep(1);
        if ((++sp & 255u) == 0u) { if (xb_ld(&bar[XB_TMO])) break; if (sp > XB_SPIN_CAP) { atomicAdd(&bar[XB_TMO], 1u); break; } }
    }
    nloc = mine > 0u ? mine : 1u; nx = cnt > 0u ? cnt : 1u;
}

__device__ __forceinline__ void xcd_barrier(const XcdBarrier& b) {
    asm volatile("s_waitcnt vmcnt(0)" ::: "memory");
    __syncthreads();
    if (threadIdx.x == 0) {
        unsigned* bar = b.bar;
        __builtin_amdgcn_s_waitcnt(0);
        unsigned nloc = b.st[0], nx = b.st[1];
        if (nloc == 0u) { xcd_barrier_complete(bar, b.x, nloc, nx); b.st[0] = nloc; b.st[1] = nx; }
        const unsigned old = xb_add(&bar[XB_XSUB(b.x)], 1u);
        const unsigned gen = old / nloc;
        if (old + 1u == (gen + 1u) * nloc) {
            __builtin_amdgcn_fence(__ATOMIC_RELEASE, "agent");
            asm volatile("s_waitcnt vmcnt(0)" ::: "memory");
            const unsigned og = xb_add(&bar[XB_TOP], 1u);
            const unsigned tg = og / nx;
            if (og + 1u == (tg + 1u) * nx) xb_add(&bar[XB_TOPGEN], 1u);
            else XB_SPIN(xb_ld(&bar[XB_TOPGEN]) == tg, bar);
            __builtin_amdgcn_fence(__ATOMIC_ACQUIRE, "agent");
            xb_add(&bar[XB_XGEN(b.x)], 1u);
            asm volatile("s_waitcnt vmcnt(0)" ::: "memory");
        } else {
            XB_SPIN(xb_ld(&bar[XB_XGEN(b.x)]) == gen, bar);
            __builtin_amdgcn_fence(__ATOMIC_ACQUIRE, "agent");
            asm volatile("s_waitcnt vmcnt(0)" ::: "memory");
        }
    }
    __syncthreads();
}

struct Args { const float* in[22]; float* out; unsigned char* ws; };
enum { I_XP = 0, I_XS, I_SP, I_CK, I_CV, I_CL, I_GMIX, I_GFFN, I_PW, I_PS, I_GKV, I_WK, I_WV, I_WF, I_BF, I_GKN, I_WQ, I_GQN, I_WO, I_WG, I_WU, I_WD };

template <int W> __device__ __forceinline__ void pool_item(const float* xb_, const float* rstd, const float* sp_, int t0, bool smp, f32x4 gm, bf16* pb_, float* ps_, int pst) {
    f32x4 halo[W - 1], mn[16];
    if (t0 > 0) {
#pragma unroll
        for (int i = 0; i < W - 1; ++i) { const int t = t0 - (W - 1) + i; halo[i] = (*(const f32x4*)(xb_ + (size_t)t * 1024) * rstd[t]) * gm; }
    } else if (smp) {
#pragma unroll
        for (int i = 0; i < W - 1; ++i) halo[i] = *(const f32x4*)(sp_ + (size_t)(15 - (W - 1) + i) * 1024);
    } else {
#pragma unroll
        for (int i = 0; i < W - 1; ++i) halo[i] = (f32x4){0.f, 0.f, 0.f, 0.f};
    }
#pragma unroll
    for (int r = 0; r < 16; ++r) mn[r] = (*(const f32x4*)(xb_ + (size_t)(t0 + r) * 1024) * rstd[t0 + r]) * gm;
    f32x4 s = {0.f, 0.f, 0.f, 0.f};
#pragma unroll
    for (int i = 0; i < W - 1; ++i) s += halo[i];
#pragma unroll
    for (int r = 0; r < 16; ++r) {
        const int t = t0 + r; s += mn[r];
        const int cnt = (smp || t + 1 >= W) ? W : t + 1;
        const f32x4 p = s * (1.0f / (float)cnt) - mn[r];
        v2u pw; pw.x = pk2(p[0], p[1]); pw.y = pk2(p[2], p[3]);
        *(v2u*)(pb_ + (size_t)r * 1024) = pw;
        if (t >= pst) *(f32x4*)(ps_ + (size_t)(t - pst) * 1024) = mn[r];
        s -= (r - (W - 1) >= 0) ? mn[r - (W - 1) >= 0 ? r - (W - 1) : 0] : halo[r < W - 1 ? r : 0];
    }
}

template <int W> __device__ __forceinline__ void pool_step(const f32x4 (&prev)[16], const f32x4 (&mn)[16], int t0, bool smp, bf16* pb_, float* ps_, int pst) {
    f32x4 s = {0.f, 0.f, 0.f, 0.f};
#pragma unroll
    for (int i = 0; i < W - 1; ++i) s += prev[16 - (W - 1) + i];
#pragma unroll
    for (int r = 0; r < 16; ++r) {
        const int t = t0 + r; s += mn[r];
        const int cnt = (smp || t + 1 >= W) ? W : t + 1;
        const f32x4 p = s * (1.0f / (float)cnt) - mn[r];
        v2u pw; pw.x = pk2(p[0], p[1]); pw.y = pk2(p[2], p[3]);
        *(v2u*)(pb_ + (size_t)r * 1024) = pw;
        if (t >= pst) *(f32x4*)(ps_ + (size_t)(t - pst) * 1024) = mn[r];
        s -= (r - (W - 1) >= 0) ? mn[r - (W - 1) >= 0 ? r - (W - 1) : 0] : prev[(16 - (W - 1) + r) < 16 ? (16 - (W - 1) + r) : 0];
    }
}

__device__ __forceinline__ void sample_attn(int b, int h, const float* ck, const float* cv, const bf16* KB, const bf16* VB, const bf16* QB, const float* dks, bf16* OB,
                                            LAS unsigned char* lds, int tid, int lane, int wid) {
    constexpr int RS = 144;
    LAS unsigned char* Ks = lds; LAS unsigned char* Vs = lds + 128 * RS; LAS float* comb = (LAS float*)(lds + 2 * 128 * RS);
    const int r32 = lane & 31, hi = lane >> 5, qh = wid & 1, kg = wid >> 1;
    const int qrow = MP + b * 64 + qh * 32 + r32;
    bf16x8 qf[4];
#pragma unroll
    for (int d0 = 0; d0 < 4; ++d0) qf[d0] = *(const bf16x8*)(QB + (size_t)qrow * 1024 + h * 64 + d0 * 16 + hi * 8);
    const int qpos = PAST + qh * 32 + r32; const float dq2 = dks[qpos];
    float m = -1e30f, l = 0.f; f32x16 o0 = {}, o1 = {};
    const int kk = tid >> 2, dseg = (tid & 3) * 16;
    f32x4 kr[4], vr[4];
#define SA_LOAD(c) do { const int j_ = 128 * (c) + kk; \
        if (j_ < PAST) { const f32x4* pk_ = (const f32x4*)(ck + (((size_t)b * PAST + j_) * 16 + h) * 64 + dseg); const f32x4* pv_ = (const f32x4*)(cv + (((size_t)b * PAST + j_) * 16 + h) * 64 + dseg); \
            _Pragma("unroll") for (int i_ = 0; i_ < 4; ++i_) { kr[i_] = pk_[i_]; vr[i_] = pv_[i_]; } } \
        else if (j_ < KVS) { const v4u* pk_ = (const v4u*)(KB + (size_t)(MP + b * 64 + j_ - PAST) * 1024 + h * 64 + dseg); const v4u* pv_ = (const v4u*)(VB + (size_t)(MP + b * 64 + j_ - PAST) * 1024 + h * 64 + dseg); \
            _Pragma("unroll") for (int i_ = 0; i_ < 2; ++i_) { const v4u a_ = pk_[i_], c_ = pv_[i_]; \
                kr[2 * i_] = (f32x4){__uint_as_float(a_.x << 16), __uint_as_float(a_.x & 0xffff0000u), __uint_as_float(a_.y << 16), __uint_as_float(a_.y & 0xffff0000u)}; \
                kr[2 * i_ + 1] = (f32x4){__uint_as_float(a_.z << 16), __uint_as_float(a_.z & 0xffff0000u), __uint_as_float(a_.w << 16), __uint_as_float(a_.w & 0xffff0000u)}; \
                vr[2 * i_] = (f32x4){__uint_as_float(c_.x << 16), __uint_as_float(c_.x & 0xffff0000u), __uint_as_float(c_.y << 16), __uint_as_float(c_.y & 0xffff0000u)}; \
                vr[2 * i_ + 1] = (f32x4){__uint_as_float(c_.z << 16), __uint_as_float(c_.z & 0xffff0000u), __uint_as_float(c_.w << 16), __uint_as_float(c_.w & 0xffff0000u)}; } } \
        else { _Pragma("unroll") for (int i_ = 0; i_ < 4; ++i_) { kr[i_] = (f32x4){0.f, 0.f, 0.f, 0.f}; vr[i_] = (f32x4){0.f, 0.f, 0.f, 0.f}; } } } while (0)
    SA_LOAD(0);
    for (int c = 0; c < 9; ++c) {
        __syncthreads();
        {
            v4u a, bq;
            a.x = pk2(kr[0][0], kr[0][1]); a.y = pk2(kr[0][2], kr[0][3]); a.z = pk2(kr[1][0], kr[1][1]); a.w = pk2(kr[1][2], kr[1][3]);
            bq.x = pk2(kr[2][0], kr[2][1]); bq.y = pk2(kr[2][2], kr[2][3]); bq.z = pk2(kr[3][0], kr[3][1]); bq.w = pk2(kr[3][2], kr[3][3]);
            *(LAS v4u*)(Ks + kk * RS + dseg * 2) = a; *(LAS v4u*)(Ks + kk * RS + dseg * 2 + 16) = bq;
            a.x = pk2(vr[0][0], vr[0][1]); a.y = pk2(vr[0][2], vr[0][3]); a.z = pk2(vr[1][0], vr[1][1]); a.w = pk2(vr[1][2], vr[1][3]);
            bq.x = pk2(vr[2][0], vr[2][1]); bq.y = pk2(vr[2][2], vr[2][3]); bq.z = pk2(vr[3][0], vr[3][1]); bq.w = pk2(vr[3][2], vr[3][3]);
            *(LAS v4u*)(Vs + kk * RS + dseg * 2) = a; *(LAS v4u*)(Vs + kk * RS + dseg * 2 + 16) = bq;
        }
        __syncthreads();
        if (c + 1 < 9) SA_LOAD(c + 1);
        const int kvb = 128 * c + 32 * kg;
        if (kvb < KVS) {
            f32x16 s = {};
#pragma unroll
            for (int d0 = 0; d0 < 4; ++d0) { const bf16x8 kf = *(const LAS bf16x8*)(Ks + (32 * kg + r32) * RS + (d0 * 16 + hi * 8) * 2); s = __builtin_amdgcn_mfma_f32_32x32x16_bf16(kf, qf[d0], s, 0, 0, 0); }
            float mx = -1e30f;
#pragma unroll
            for (int jj = 0; jj < 4; ++jj) { const f32x4 dk = *(const f32x4*)(dks + kvb + 8 * jj + 4 * hi);
#pragma unroll
                for (int e = 0; e < 4; ++e) { const int kv = kvb + 8 * jj + 4 * hi + e; float x = s[4 * jj + e] + dq2 - dk[e]; x = (kv > qpos) ? -1e30f : x; s[4 * jj + e] = x; mx = fmaxf(mx, x); } }
            mx = fmaxf(mx, __shfl_xor(mx, 32));
            const float mn = fmaxf(m, mx), alpha = __builtin_amdgcn_exp2f(m - mn); m = mn;
            float ps = 0.f;
#pragma unroll
            for (int r = 0; r < 16; ++r) { s[r] = __builtin_amdgcn_exp2f(s[r] - mn); ps += s[r]; }
            l = l * alpha + ps; o0 = o0 * alpha; o1 = o1 * alpha;
#pragma unroll
            for (int ks = 0; ks < 2; ++ks) {
                v4u pw; pw.x = pk2(s[8 * ks], s[8 * ks + 1]); pw.y = pk2(s[8 * ks + 2], s[8 * ks + 3]); pw.z = pk2(s[8 * ks + 4], s[8 * ks + 5]); pw.w = pk2(s[8 * ks + 6], s[8 * ks + 7]);
                const bf16x8 pb = __builtin_bit_cast(bf16x8, pw);
#pragma unroll
                for (int dh = 0; dh < 2; ++dh) { bf16x8 va;
#pragma unroll
                    for (int i = 0; i < 8; ++i) va[i] = *(const LAS short*)(Vs + (32 * kg + crow(8 * ks + i, hi)) * RS + (dh * 32 + r32) * 2);
                    if (dh == 0) o0 = __builtin_amdgcn_mfma_f32_32x32x16_bf16(va, pb, o0, 0, 0, 0); else o1 = __builtin_amdgcn_mfma_f32_32x32x16_bf16(va, pb, o1, 0, 0, 0); }
            }
        }
    }
#undef SA_LOAD
    l += __shfl_xor(l, 32);
    LAS float* cw = comb + wid * (32 * 66) + r32 * 66;
#pragma unroll
    for (int r = 0; r < 16; ++r) { cw[crow(r, hi)] = o0[r]; cw[32 + crow(r, hi)] = o1[r]; }
    if (hi == 0) { cw[64] = m; cw[65] = l; }
    __syncthreads();
    {
        const int q64 = tid >> 3, d8 = (tid & 7) * 8, qh2 = q64 >> 5, ql = q64 & 31;
        float M = -1e30f;
#pragma unroll
        for (int g = 0; g < 4; ++g) M = fmaxf(M, comb[(g * 2 + qh2) * (32 * 66) + ql * 66 + 64]);
        float den = 0.f, a8[8];
#pragma unroll
        for (int e = 0; e < 8; ++e) a8[e] = 0.f;
#pragma unroll
        for (int g = 0; g < 4; ++g) { const LAS float* base = comb + (g * 2 + qh2) * (32 * 66) + ql * 66; const float w = __builtin_amdgcn_exp2f(base[64] - M); den += w * base[65];
#pragma unroll
            for (int e = 0; e < 8; ++e) a8[e] += w * base[d8 + e]; }
        const float inv = 1.0f / den;
        v4u w; w.x = pk2(a8[0] * inv, a8[1] * inv); w.y = pk2(a8[2] * inv, a8[3] * inv); w.z = pk2(a8[4] * inv, a8[5] * inv); w.w = pk2(a8[6] * inv, a8[7] * inv);
        *(v4u*)(OB + (size_t)(MP + b * 64 + q64) * 1024 + h * 64 + d8) = w;
    }
    __syncthreads();
}

#ifndef PG_ALIGN
#define PG_ALIGN true
#endif
#ifndef PH_MASK
#define PH_MASK 0xFFFF
#endif
#define RUN(p) (((PH_MASK) >> (p)) & 1)
#ifndef REP_MASK
#define REP_MASK 0
#endif
#define NREP(p) (1 + (((REP_MASK) >> (p)) & 1))

__global__ void __launch_bounds__(512, 2) mega(Args a) {
    extern __shared__ __attribute__((aligned(16))) unsigned char lds_raw[];
    cg::grid_group grid = cg::this_grid();
    LAS unsigned char* lds = (LAS unsigned char*)lds_raw;
    const int G = gridDim.x;
    int vcu;
    {
        LAS int* vs = (LAS int*)(lds_raw + LDS_BYTES - 16);
        if (threadIdx.x == 0) {
            unsigned* cen = (unsigned*)(a.ws + WS_CTL);
            const unsigned xcc = (unsigned)__builtin_amdgcn_s_getreg((3 << 11) | 20) & 7u;
            const unsigned rank = __hip_atomic_fetch_add(cen + 64 * xcc, 1u, __ATOMIC_RELAXED, __HIP_MEMORY_SCOPE_AGENT);
            vs[0] = (G == 256 && rank < 32u) ? (int)(xcc + 8u * rank) : -1;
        }
        __syncthreads();
        vcu = __builtin_amdgcn_readfirstlane(vs[0]);
        if (threadIdx.x == 0) { vs[1] = 0; vs[2] = 0; }
        __syncthreads();
    }
#define PHASE_ENTER() int tid_o = threadIdx.x; asm volatile("" : "+v"(tid_o)); const int tid = tid_o, lane = tid & 63, wave = __builtin_amdgcn_readfirstlane(tid >> 6); (void)lane; (void)wave; \
    int bx_o = blockIdx.x; asm volatile("" : "+s"(bx_o)); const int bx = bx_o; size_t zo_ = 0; asm volatile("" : "+s"(zo_)); unsigned char* ws = a.ws + zo_; float* out = a.out + zo_; \
    const float* xp = a.in[I_XP]; const float* xs = a.in[I_XS]; (void)xp; (void)xs; \
    bf16* WPOOL = (bf16*)(ws + WS_WPOOL); bf16* WKVQ = (bf16*)(ws + WS_WKVQ); bf16* WOT = (bf16*)(ws + WS_WO); \
    float* RSTD = (float*)(ws + WS_RSTD); float* SSQ = (float*)(ws + WS_SSQ); float* DK2 = (float*)(ws + WS_DK2); float* DKS = (float*)(ws + WS_DKS); \
    bf16* XB = (bf16*)(ws + WS_XB); bf16* PB = (bf16*)(ws + WS_PB); bf16* OB = PB; bf16* ACT = (bf16*)(ws + WS_R1); \
    bf16* QB = (bf16*)(ws + WS_QB); bf16* KB = (bf16*)(ws + WS_KB); bf16* VB = (bf16*)(ws + WS_VB); \
    (void)WPOOL; (void)WKVQ; (void)WOT; (void)RSTD; (void)SSQ; (void)DK2; (void)DKS; (void)XB; (void)PB; (void)OB; (void)ACT; (void)QB; (void)KB; (void)VB;
    (void)xcd_barrier_post((unsigned*)(a.ws + WS_CTL + 4096), (volatile LAS unsigned*)(lds_raw + LDS_BYTES - 12));
#define GSYNC() do { size_t zb_ = 0; asm volatile("" : "+s"(zb_)); XcdBarrier xb_; xb_.bar = (unsigned*)(a.ws + WS_CTL + 4096) + zb_; xb_.x = xb_xcc_id(); xb_.st = (volatile LAS unsigned*)(lds_raw + LDS_BYTES - 12); xcd_barrier(xb_); } while (0)
#define GSYNC0() do { asm volatile("s_waitcnt vmcnt(0)" ::: "memory"); grid.sync(); __builtin_amdgcn_fence(__ATOMIC_ACQUIRE, "agent"); asm volatile("s_waitcnt vmcnt(0)" ::: "memory"); } while (0)

    grid.sync();
    for (int rep_ = 0; rep_ < NREP(0); ++rep_) { if (rep_) GSYNC(); PHASE_ENTER();
        LAS float* scr = (LAS float*)(lds + wave * 16384);
        const int gw = bx * 8 + wave, NGW = G * 8;
        constexpr int I_POOL = 4 * 32, I_GU = 16 * 88, I_DN = 44 * 32, I_SQ = 16 * 32;
        constexpr int NITEMS = I_POOL + 4 * I_GU + 2 * I_DN + 4 * I_SQ;
        for (int it = gw; it < NITEMS; it += NGW) {
            int r = it;
            if (r < I_POOL) { const int mtx = r >> 5; transpose_item(a.in[I_PW] + (size_t)mtx * 65536, 256, 256, WPOOL, RmOff{mtx * 256}, nullptr, a.in[I_PS] + mtx * 256, scr, r & 31, lane); continue; } r -= I_POOL;
            if (r < 4 * I_GU) { const int mtx = r / I_GU, l = mtx >> 1, up = mtx & 1; transpose_item((up ? a.in[I_WU] : a.in[I_WG]) + (size_t)l * 1024 * 2816, 1024, 2816, (bf16*)(ws + (l ? WS_WGU1 : WS_WGU0)), RmGU{up}, a.in[I_GFFN] + l * 1024, nullptr, scr, r % I_GU, lane); continue; } r -= 4 * I_GU;
            if (r < 2 * I_DN) { const int l = r / I_DN; transpose_item(a.in[I_WD] + (size_t)l * 2816 * 1024, 2816, 1024, (bf16*)(ws + (l ? WS_WDN1 : WS_WDN0)), RmOff{0}, nullptr, nullptr, scr, r % I_DN, lane); continue; } r -= 2 * I_DN;
            if (r < I_SQ) { transpose_item(a.in[I_WK], 1024, 1024, WKVQ, RmKVQ{0}, a.in[I_GKV], nullptr, scr, r, lane); continue; } r -= I_SQ;
            if (r < I_SQ) { transpose_item(a.in[I_WV], 1024, 1024, WKVQ, RmKVQ{1024}, a.in[I_GKV], nullptr, scr, r, lane); continue; } r -= I_SQ;
            if (r < I_SQ) { transpose_item(a.in[I_WQ], 1024, 1024, WKVQ, RmKVQ{2048}, a.in[I_GMIX] + 1024, nullptr, scr, r, lane); continue; } r -= I_SQ;
            transpose_item(a.in[I_WO], 1024, 1024, WOT, RmOff{0}, nullptr, nullptr, scr, r, lane);
        }
        const int gt = bx * 512 + tid, NT = G * 512;
        for (int i = gt; i < 16 * 1024; i += NT) { const int n = i >> 10, k = i & 1023; WKVQ[(size_t)(3072 + n) * 1024 + k] = (bf16)(pk2(a.in[I_WF][k * 16 + n] * a.in[I_GKV][k], 0.f) & 0xffffu); }
        if (gt < 192) ((float*)(ws + WS_GN))[gt] = gt < 64 ? a.in[I_GKN][gt] : gt < 128 ? 1.0f : a.in[I_GQN][gt - 128] * (0.125f * LOG2E);
        for (int i = gt; i < 240 * 1024 / 8; i += NT) ((v4u*)(WKVQ + (size_t)3088 * 1024))[i] = (v4u){0u, 0u, 0u, 0u};
    }
    __syncthreads();

    for (int rep_ = 0; rep_ < NREP(1); ++rep_) { if (rep_) GSYNC(); PHASE_ENTER();
        const int half = tid >> 8, c4 = (tid & 255) * 4, grp = __builtin_amdgcn_readfirstlane(c4 >> 8), wq = (tid >> 6) & 3;
        const f32x4 gm = *(const f32x4*)(a.in[I_GMIX] + c4);
        LAS float* redb = (LAS float*)lds + half * 64; int par = 0;
        f32x4 prev[16], raw[16]; float rs[16];
#define P1_LOAD(src, t_first) do { _Pragma("unroll") for (int r_ = 0; r_ < 16; ++r_) raw[r_] = *(const f32x4*)((src) + (size_t)((t_first) + r_) * 1024); } while (0)
#define P1_RSTD(valid) do { float ss_[16]; \
            _Pragma("unroll") for (int r_ = 0; r_ < 16; ++r_) { const f32x4 v_ = raw[r_]; ss_[r_] = (valid) ? wave_sum((v_[0] * v_[0] + v_[1] * v_[1]) + (v_[2] * v_[2] + v_[3] * v_[3])) : 0.f; } \
            LAS float* red_ = redb + par * 128; par ^= 1; \
            if (lane == 0) { _Pragma("unroll") for (int r_ = 0; r_ < 16; r_ += 4) *(LAS f32x4*)(red_ + wq * 16 + r_) = (f32x4){ss_[r_], ss_[r_ + 1], ss_[r_ + 2], ss_[r_ + 3]}; } \
            __syncthreads(); \
            _Pragma("unroll") for (int r_ = 0; r_ < 16; ++r_) rs[r_] = __builtin_amdgcn_rsqf(((red_[r_] + red_[16 + r_]) + (red_[32 + r_] + red_[48 + r_])) * (1.0f / 1024.0f) + 1e-6f); } while (0)
#define P1_STEP(t0_, smp_, pb_, ps_, pst_) do { if (grp == 0) pool_step<2>(prev, raw, t0_, smp_, pb_, ps_, pst_); else if (grp == 1) pool_step<4>(prev, raw, t0_, smp_, pb_, ps_, pst_); \
            else if (grp == 2) pool_step<8>(prev, raw, t0_, smp_, pb_, ps_, pst_); else pool_step<16>(prev, raw, t0_, smp_, pb_, ps_, pst_); } while (0)
        for (int run = bx * 2 + half; run < 512; run += G * 2) {
            const int row0 = run * 128, b = row0 >> 12, tr = row0 & 4095;
            const float* xb_ = xp + (size_t)(row0 - tr) * 1024 + c4;
            float* ps_ = out + pg8::O_PSP + (size_t)b * 15 * 1024 + c4;
            if (tr > 0) P1_LOAD(xb_, tr - 16);
            P1_RSTD(tr > 0);
#pragma unroll
            for (int r = 0; r < 16; ++r) prev[r] = (tr > 0) ? (raw[r] * rs[r]) * gm : (f32x4){0.f, 0.f, 0.f, 0.f};
            for (int st = 0; st < 8; ++st) {
                const int t0 = tr + 16 * st;
                P1_LOAD(xb_, t0);
                P1_RSTD(true);
#pragma unroll
                for (int r = 0; r < 16; ++r) raw[r] = (raw[r] * rs[r]) * gm;
                P1_STEP(t0, false, PB + (size_t)(row0 + 16 * st) * 1024 + c4, ps_, 4081);
#pragma unroll
                for (int r = 0; r < 16; ++r) prev[r] = raw[r];
            }
        }
        for (int si = bx * 2 + half; si < 64; si += G * 2) {
            const int b = si >> 2, t0 = 16 * (si & 3);
            const float* xb_ = xs + (size_t)b * 64 * 1024 + c4;
            const float* sp_ = a.in[I_SP] + (size_t)b * 15 * 1024 + c4;
            if (t0 > 0) P1_LOAD(xb_, t0 - 16);
            P1_RSTD(t0 > 0);
            if (t0 > 0) {
#pragma unroll
                for (int r = 0; r < 16; ++r) prev[r] = (raw[r] * rs[r]) * gm;
            } else {
                prev[0] = (f32x4){0.f, 0.f, 0.f, 0.f};
#pragma unroll
                for (int r = 1; r < 16; ++r) prev[r] = *(const f32x4*)(sp_ + (size_t)(r - 1) * 1024);
            }
            P1_LOAD(xb_, t0);
            P1_RSTD(true);
#pragma unroll
            for (int r = 0; r < 16; ++r) raw[r] = (raw[r] * rs[r]) * gm;
            P1_STEP(t0, true, PB + (size_t)(MP + 16 * si) * 1024 + c4, out + pg8::O_PSS + (size_t)b * 15 * 1024 + c4, 49);
        }
#undef P1_LOAD
#undef P1_RSTD
#undef P1_STEP
    }
    GSYNC();
    {
        const unsigned* cen = (const unsigned*)(a.ws + WS_CTL); bool okc = (G == 256);
#pragma unroll
        for (int x = 0; x < 8; ++x) okc = okc && (__hip_atomic_load(cen + 64 * x, __ATOMIC_RELAXED, __HIP_MEMORY_SCOPE_AGENT) == 32u);
        if (!okc) vcu = blockIdx.x;
    }

    for (int rep_ = 0; rep_ < NREP(2); ++rep_) { if (rep_) GSYNC(); PHASE_ENTER();
        pg8::Gemm g{PB, WPOOL, MT, 1024, 256, 1024, 256}; pg8::StaticOrder S; S.init(MP, 1024, G, vcu);
        pg8::EpiRes<true, false, false> E{xp, xs, out, XB, SSQ, nullptr};
        pg8::gemm_phase<pg8::EpiRes<true, false, false>, pg8::StaticOrder, PG_ALIGN, true>(lds, g, S, E);
    }
    GSYNC();

    for (int l = 0; l < 2; ++l) {
        if (l == 1) {
            for (int rep_ = 0; rep_ < NREP(5); ++rep_) { if (rep_) GSYNC(); PHASE_ENTER();
                pg8::Gemm g{XB, WKVQ, MT, 3328, 1024, 1024, 0}; pg8::StaticOrder S; S.init(MP, 3328, G, vcu);
                pg8::EpiKVQ E{SSQ, (const float*)(ws + WS_GN), a.in[I_BF], out, KB, (size_t)(130 * MiB / 2)};
                pg8::gemm_phase<pg8::EpiKVQ, pg8::StaticOrder, PG_ALIGN, true>(lds, g, S, E);
            }
            GSYNC();
            for (int rep_ = 0; rep_ < NREP(7); ++rep_) { if (rep_) GSYNC(); PHASE_ENTER();
                const float mq = wave_max(fabsf(a.in[I_GQN][lane])), mk = wave_max(fabsf(a.in[I_GKN][lane]));
                const float lowc = -(0.125f * LOG2E * 64.f) * mq * mk;
                for (int u = bx; u < 256; u += G) {
                    const int b = u >> 4, h = u & 15;
                    {
                        const float* lp = out + pg8::O_LP + ((size_t)b * 4096 + 8 * tid) * 16 + h; float v[8];
#pragma unroll
                        for (int k = 0; k < 8; ++k) v[k] = lp[(size_t)k * 16];
#pragma unroll
                        for (int k = 1; k < 8; ++k) v[k] += v[k - 1];
                        float inc = v[7];
#pragma unroll
                        for (int o = 1; o < 64; o <<= 1) { const float t = __shfl_up(inc, o); if (lane >= o) inc += t; }
                        LAS float* wt = (LAS float*)(lds + DK_OFF + 16384);
                        if (lane == 63) wt[wave] = inc;
                        __syncthreads();
                        float pre = 0.f;
#pragma unroll
                        for (int w = 0; w < 8; ++w) pre += (w < wave) ? wt[w] : 0.f;
                        const float ex = pre + inc - v[7];
                        LAS f32x4* dstl = (LAS f32x4*)(lds + DK_OFF) + 2 * tid;
                        dstl[0] = (f32x4){(v[0] + ex) * LOG2E, (v[1] + ex) * LOG2E, (v[2] + ex) * LOG2E, (v[3] + ex) * LOG2E};
                        dstl[1] = (f32x4){(v[4] + ex) * LOG2E, (v[5] + ex) * LOG2E, (v[6] + ex) * LOG2E, (v[7] + ex) * LOG2E};
                    }
                    __syncthreads();
                    const LAS float* dl = (const LAS float*)(lds + DK_OFF);
#define ATT_T0(qb_) ((int)__builtin_popcountll(__ballot((lane < 4 * (qb_)) && (dl[64 * lane + 63] > dl[256 * (qb_)] - 2.f * lowc + 45.f))) & ~1)
                    attn_body::bf16x8 qreg[4]; bool pref = false; int t0c = ATT_T0(15);
                    {
                        const attn_body::bf16* Qw = (const attn_body::bf16*)QB + ((size_t)b * 4096 + 15 * 256 + wave * 32 + (lane & 31)) * 1024 + h * 64 + (lane >> 5) * 8;
#pragma unroll
                        for (int d0 = 0; d0 < 4; ++d0) qreg[d0] = *reinterpret_cast<const attn_body::bf16x8*>(Qw + d0 * 16);
                    }
                    for (int qb = 15; qb >= 0; --qb) {
                        const int t0n = qb > 0 ? ATT_T0(qb - 1) : -1;
                        attn_body::attn_unit<8>(b, h, qb, (const attn_body::bf16*)QB, (const attn_body::bf16*)KB, (const attn_body::bf16*)VB, (attn_body::bf16*)OB, (char*)lds_raw,
                                                (const LAS float*)(lds + DK_OFF), lowc, t0c, t0n, pref, qreg);
                        pref = t0n >= 0; t0c = t0n;
                    }
#undef ATT_T0
                    __syncthreads();
                }
            }
            for (int rep_ = 0; rep_ < NREP(7); ++rep_) { if (rep_) GSYNC(); PHASE_ENTER();
                for (int u = bx; u < 256; u += G) {
                    {
                        const int b = u >> 4, h = u & 15; const float* ls = out + pg8::O_LS + (size_t)b * 64 * 16 + h; const float* cl = a.in[I_CL] + (size_t)b * 1024 * 16 + h; float v[4];
#pragma unroll
                        for (int k = 0; k < 4; ++k) { const int j = 4 * tid + k; v[k] = j < PAST ? cl[(size_t)j * 16] : (j < KVS ? ls[(size_t)(j - PAST) * 16] : 0.f); }
#pragma unroll
                        for (int k = 1; k < 4; ++k) v[k] += v[k - 1];
                        float inc = v[3];
#pragma unroll
                        for (int o = 1; o < 64; o <<= 1) { const float t = __shfl_up(inc, o); if (lane >= o) inc += t; }
                        LAS float* wt = (LAS float*)(lds + DK_OFF + 16384);
                        if (lane == 63) wt[wave] = inc;
                        __syncthreads();
                        float pre = 0.f;
#pragma unroll
                        for (int w = 0; w < 8; ++w) pre += (w < wave) ? wt[w] : 0.f;
                        const float ex = pre + inc - v[3];
                        if (4 * tid < KVS) *(f32x4*)(DKS + (size_t)u * KVS + 4 * tid) = (f32x4){(v[0] + ex) * LOG2E, (v[1] + ex) * LOG2E, (v[2] + ex) * LOG2E, (v[3] + ex) * LOG2E};
                        asm volatile("s_waitcnt vmcnt(0)" ::: "memory"); __syncthreads();
                    }
                    sample_attn(u >> 4, u & 15, a.in[I_CK], a.in[I_CV], (bf16*)(ws + WS_KVQS) - (size_t)MP * 1024, (bf16*)(ws + WS_KVQS + 2 * MiB) - (size_t)MP * 1024, (bf16*)(ws + WS_KVQS + 4 * MiB) - (size_t)MP * 1024, DKS + (size_t)u * KVS, OB, lds, tid, lane, wave);
                }
            }
            GSYNC();
            for (int rep_ = 0; rep_ < NREP(8); ++rep_) { if (rep_) GSYNC(); PHASE_ENTER();
                pg8::Gemm g{OB, WOT, MT, 1024, 1024, 1024, 0}; pg8::StaticOrder S; S.init(MP, 1024, G, vcu);
                pg8::EpiRes<true, true, false> E{out, out + (size_t)MP * 1024, out, XB, SSQ, nullptr};
                pg8::gemm_phase<pg8::EpiRes<true, true, false>, pg8::StaticOrder, PG_ALIGN, true>(lds, g, S, E);
            }
            GSYNC();
        }
#define SROLE_NB(v) ((v) < 16 ? 0 : (v) < 104 ? 2 : (v) < 120 ? 5 : ((v) < 172 && l == 0) ? 9 : 0)
        {
            PHASE_ENTER();
            pg8::Gemm g{XB, (bf16*)(ws + (l ? WS_WGU1 : WS_WGU0)), MT, 5632, 1024, 1024, 0}; pg8::StaticOrder base; base.init(MP, 5632, G, vcu);
            pg8::EpiGU E{SSQ, ACT};
            pg8::RangeOrder S{base, 0, SROLE_NB(vcu), -1, 0};
            pg8::gemm_phase<pg8::EpiGU, pg8::RangeOrder, PG_ALIGN, true>(lds, g, S, E);
        }
        if (vcu < 120 || (vcu < 172 && l == 0)) {
            PHASE_ENTER();
            int role, sidx;
            if (vcu < 16) { role = 1; sidx = vcu; } else if (vcu < 104) { role = 2; sidx = vcu - 16; } else if (vcu < 120) { role = 3; sidx = vcu - 104; } else { role = 4; sidx = vcu - 120; }
            unsigned* cnt = (unsigned*)(ws + WS_CTL + 32768) + l * 256;
            if (role > 1) {
                if (tid == 0) { const unsigned need = role == 3 ? 88u : 16u; unsigned sp = 0;
                    while (__hip_atomic_load(cnt + 64 * (role - 2), __ATOMIC_RELAXED, __HIP_MEMORY_SCOPE_AGENT) < need && ++sp < (1u << 22)) __builtin_amdgcn_s_sleep(2);
                    __builtin_amdgcn_fence(__ATOMIC_ACQUIRE, "agent"); asm volatile("s_waitcnt vmcnt(0)" ::: "memory"); }
                __syncthreads();
            }
            if (role == 1) {
                pg8::OneUnit S1{256 + (sidx >> 2), sidx & 3};
                if (l) { pg8::Gemm g2{OB, WOT, MT, 1024, 1024, 1024, 0}; pg8::EpiRes<true, true, false> E3{xp, xs, out, XB, SSQ, nullptr}; pg8::gemm_phase<pg8::EpiRes<true, true, false>, pg8::OneUnit, PG_ALIGN, true>(lds, g2, S1, E3); }
                else { pg8::Gemm g2{PB, WPOOL, MT, 1024, 256, 1024, 256}; pg8::EpiRes<true, false, false> E2{xp, xs, out, XB, SSQ, nullptr}; pg8::gemm_phase<pg8::EpiRes<true, false, false>, pg8::OneUnit, PG_ALIGN, true>(lds, g2, S1, E2); }
            } else if (role == 2) {
                pg8::Gemm g2{XB, (bf16*)(ws + (l ? WS_WGU1 : WS_WGU0)), MT, 5632, 1024, 1024, 0}; pg8::EpiGU E2{SSQ, ACT};
                pg8::OneUnit S1{256 + sidx / 22, sidx % 22};
                pg8::gemm_phase<pg8::EpiGU, pg8::OneUnit, PG_ALIGN, true>(lds, g2, S1, E2);
            } else if (role == 3) {
                pg8::Gemm g2{ACT, (bf16*)(ws + (l ? WS_WDN1 : WS_WDN0)), MT, 1024, 2816, 2816, 0}; pg8::OneUnit S1{256 + (sidx >> 2), sidx & 3};
                pg8::EpiRes<true, true, true> E2{out, out + (size_t)MP * 1024, out, XB, SSQ, nullptr};
                pg8::gemm_phase<pg8::EpiRes<true, true, true>, pg8::OneUnit, PG_ALIGN, true>(lds, g2, S1, E2);
            } else {
                pg8::Gemm g2{XB, WKVQ, MT, 3328, 1024, 1024, 0}; pg8::OneUnit S1{256 + sidx / 13, sidx % 13};
                pg8::EpiKVQ E2{SSQ, (const float*)(ws + WS_GN), a.in[I_BF], out, (bf16*)(ws + WS_KVQS) - (size_t)MP * 1024, (size_t)(2 * MiB / 2)};
                pg8::gemm_phase<pg8::EpiKVQ, pg8::OneUnit, PG_ALIGN, true>(lds, g2, S1, E2);
            }
            asm volatile("s_waitcnt vmcnt(0)" ::: "memory"); __syncthreads();
            if (tid == 0) { __builtin_amdgcn_fence(__ATOMIC_RELEASE, "agent"); asm volatile("s_waitcnt vmcnt(0)" ::: "memory");
                __hip_atomic_fetch_add(cnt + 64 * (role - 1), 1u, __ATOMIC_RELAXED, __HIP_MEMORY_SCOPE_AGENT); }
        }
        {
            PHASE_ENTER();
            pg8::Gemm g{XB, (bf16*)(ws + (l ? WS_WGU1 : WS_WGU0)), MT, 5632, 1024, 1024, 0}; pg8::StaticOrder base; base.init(MP, 5632, G, vcu);
            pg8::EpiGU E{SSQ, ACT};
            const bool dns = vcu >= 104 && vcu < 120, tk = vcu >= 172 && vcu < 188;
            pg8::RangeOrder S{base, SROLE_NB(vcu), dns ? 21 : 22, tk ? vcu - 172 + 104 : -1, 21};
            pg8::gemm_phase<pg8::EpiGU, pg8::RangeOrder, PG_ALIGN, true>(lds, g, S, E);
        }
#undef SROLE_NB
        GSYNC();
        for (int rep_ = 0; rep_ < NREP(4); ++rep_) { if (rep_) GSYNC(); PHASE_ENTER();
            pg8::Gemm g{ACT, (bf16*)(ws + (l ? WS_WDN1 : WS_WDN0)), MT, 1024, 2816, 2816, 0}; pg8::StaticOrder S; S.init(MP, 1024, G, vcu);
            if (l == 0) { pg8::EpiRes<true, true, false> E{out, out + (size_t)MP * 1024, out, XB, SSQ, nullptr}; pg8::gemm_phase<pg8::EpiRes<true, true, false>, pg8::StaticOrder, PG_ALIGN, true>(lds, g, S, E); }
            else { pg8::EpiRes<false, true, true> E{out, out + (size_t)MP * 1024, out, XB, nullptr, nullptr}; pg8::gemm_phase<pg8::EpiRes<false, true, true>, pg8::StaticOrder, PG_ALIGN, true>(lds, g, S, E); }
        }
        if (l == 0) GSYNC();
    }
}

extern "C" void kernel_launch(void* const* d_in, const int* in_sizes, int n_in, void* d_out, int out_size, void* d_ws, size_t ws_size, hipStream_t stream) {
    static int grid = 0;
    if (grid == 0) {
        if (n_in != 22 || (size_t)out_size != pg8::O_END || ws_size < WS_END) { fprintf(stderr, "kernel_launch: unexpected shapes: n_in %d out %d ws %zu (need %zu)\n", n_in, out_size, ws_size, (size_t)WS_END); grid = -1; return; }
        int dev = 0, cus = 0, per_cu = 0;
        (void)hipGetDevice(&dev); (void)hipDeviceGetAttribute(&cus, hipDeviceAttributeMultiprocessorCount, dev);
        if (hipFuncSetAttribute((const void*)mega, hipFuncAttributeMaxDynamicSharedMemorySize, LDS_BYTES) != hipSuccess) fprintf(stderr, "kernel_launch: hipFuncSetAttribute failed\n");
        if (hipOccupancyMaxActiveBlocksPerMultiprocessor(&per_cu, (const void*)mega, 512, LDS_BYTES) != hipSuccess || per_cu < 1) { fprintf(stderr, "kernel_launch: occupancy query says %d\n", per_cu); per_cu = 1; }
        (void)hipGetLastError();
        if (cus <= 0) cus = 256;
        grid = cus;
    }
    if (grid < 0) return;
    if (hipMemsetAsync((char*)d_ws + WS_CTL, 0, 65536, stream) != hipSuccess) { fprintf(stderr, "kernel_launch: memset failed\n"); return; }
    Args a{};
    for (int i = 0; i < 22; ++i) a.in[i] = (const float*)d_in[i];
    a.out = (float*)d_out; a.ws = (unsigned char*)d_ws;
    void* args[] = {&a};
    const hipError_t e = hipLaunchCooperativeKernel((const void*)mega, dim3(grid), dim3(512), args, LDS_BYTES, stream);
    if (e != hipSuccess) fprintf(stderr, "kernel_launch: cooperative launch failed: %s (grid %d)\n", hipGetErrorString(e), grid);
}
```
